# Optimizing an MI355X kernel written in HIP

```python
import math
import jax, jax.numpy as jnp
from jax import lax
import numpy as np

D_MODEL = 1024
BATCH = 1
SEQ = 16384
DEPTH = 1

D_MIX = D_MODEL
MLSTM_WIDTH = D_MIX // 2
N_MLSTM_HEADS = 4
HEAD_DIM = MLSTM_WIDTH // N_MLSTM_HEADS
POOL_WIDTH = D_MIX - MLSTM_WIDTH
POOL_WINDOWS = (2, 4, 8, 16)
N_POOL_GROUPS = len(POOL_WINDOWS)
POOL_GROUP_DIM = POOL_WIDTH // N_POOL_GROUPS
CONV_WIDTH = 4
CHUNK = 64
D_FF = 2816
EPS = 1e-6
OFF_QK = 0
OFF_V = 2 * MLSTM_WIDTH
OFF_O = 3 * MLSTM_WIDTH
OFF_G = 4 * MLSTM_WIDTH
OFF_P = OFF_G + 2 * N_MLSTM_HEADS
D_IN_PROJ = OFF_P + POOL_WIDTH

kernel_name = "hymba_mlstm_pool_macaron"


def rmsnorm(x, g):
    xf = x.astype(jnp.float32)
    y = xf * lax.rsqrt(jnp.mean(xf * xf, axis=-1, keepdims=True) + EPS)
    return (y * g.astype(jnp.float32)).astype(x.dtype)


def swiglu(h, w_gate, w_up, w_down):
    return (jax.nn.silu(h @ w_gate) * (h @ w_up)) @ w_down


def causal_dwconv(u, w, b):
    k_w, c = w.shape
    y = lax.conv_general_dilated(
        u, w[:, None, :].astype(u.dtype), window_strides=(1,),
        padding=[(k_w - 1, 0)], dimension_numbers=('NWC', 'WIO', 'NWC'),
        feature_group_count=c)
    return y + b.astype(u.dtype)


def mlstm_chunkwise(q, k, v, i_pre, f_pre):
    bsz, s, nh, d = q.shape
    nc = s // CHUNK
    to_chunks = lambda t: t.reshape(bsz, nc, CHUNK, nh, d).transpose(0, 3, 1, 2, 4)
    gate_chunks = lambda t: t.reshape(bsz, nc, CHUNK, nh).transpose(0, 3, 1, 2)
    qc = to_chunks(q)
    kc = to_chunks(k) * (d ** -0.5)
    vc = to_chunks(v)
    ig = gate_chunks(i_pre)
    bcum = jnp.cumsum(jax.nn.log_sigmoid(gate_chunks(f_pre)), axis=-1)

    def step(carry, inp):
        c_st, n_st, m_st = carry
        k_c, v_c, b_c, i_c = inp
        g = b_c[..., -1]
        a = g[..., None] - b_c + i_c
        m_new = jnp.maximum(g + m_st, jnp.max(a, axis=-1))
        w = jnp.exp(a - m_new[..., None])
        decay = jnp.exp(g + m_st - m_new)
        c_new = decay[..., None, None] * c_st + jnp.einsum('bhlk,bhlv->bhkv', k_c * w[..., None], v_c)
        n_new = decay[..., None] * n_st + jnp.einsum('bhl,bhlk->bhk', w, k_c)
        return (c_new, n_new, m_new), (c_st, n_st, m_st)

    init = (jnp.zeros((bsz, nh, d, d), jnp.float32),
            jnp.zeros((bsz, nh, d), jnp.float32),
            jnp.zeros((bsz, nh), jnp.float32))
    xs = (jnp.moveaxis(kc, 2, 0), jnp.moveaxis(vc, 2, 0),
          jnp.moveaxis(bcum, 2, 0), jnp.moveaxis(ig, 2, 0))
    _, (c_prev, n_prev, m_prev) = lax.scan(step, init, xs)
    c_prev = jnp.moveaxis(c_prev, 0, 2)
    n_prev = jnp.moveaxis(n_prev, 0, 2)
    m_prev = jnp.moveaxis(m_prev, 0, 2)

    causal = jnp.tril(jnp.ones((CHUNK, CHUNK), dtype=bool))
    inter_log = bcum + m_prev[..., None]
    dlog = bcum[..., :, None] - bcum[..., None, :] + ig[..., None, :]
    dlog = jnp.where(causal, dlog, -jnp.inf)
    m_t = jnp.maximum(inter_log, jnp.max(dlog, axis=-1))
    dw = jnp.exp(dlog - m_t[..., None])
    inter_w = jnp.exp(inter_log - m_t)
    scores = jnp.einsum('bhcld,bhcsd->bhcls', qc, kc) * dw
    num = (jnp.einsum('bhcls,bhcsd->bhcld', scores, vc)
           + inter_w[..., None] * jnp.einsum('bhcld,bhcdv->bhclv', qc, c_prev))
    qn = jnp.sum(scores, axis=-1) + inter_w * jnp.einsum('bhcld,bhcd->bhcl', qc, n_prev)
    den = jnp.maximum(jnp.abs(qn), jnp.exp(-m_t))
    h = num / den[..., None]
    return h.transpose(0, 2, 3, 1, 4).reshape(bsz, s, nh * d)


def multiscale_pool(u, pool_w, pool_scale):
    bsz, s, _ = u.shape
    pos = jnp.arange(1, s + 1, dtype=jnp.int32)
    outs = []
    for gi, win in enumerate(POOL_WINDOWS):
        ug = u[..., gi * POOL_GROUP_DIM:(gi + 1) * POOL_GROUP_DIM].astype(jnp.float32)
        cs = jnp.cumsum(ug, axis=1)
        lag = jnp.pad(cs, ((0, 0), (win, 0), (0, 0)))[:, :s]
        count = jnp.minimum(pos, win).astype(jnp.float32)
        outs.append((cs - lag) / count[None, :, None] - ug)
    pooled = jnp.stack(outs, axis=2)
    mixed = jnp.einsum('bsgc,gcd->bsgd', pooled, pool_w.astype(jnp.float32))
    return mixed.reshape(bsz, s, POOL_WIDTH) * pool_scale.astype(jnp.float32)


def setup_inputs(seed: int = 0) -> dict:
    key = jax.random.key(seed)
    ks = jax.random.split(key, 24)
    nrm = lambda k, shape, scale: jax.random.normal(k, shape, jnp.float32) * scale
    gain = lambda k, shape: 1.0 + 0.1 * jax.random.normal(k, shape, jnp.float32)
    col_scale = jnp.ones((D_IN_PROJ,), jnp.float32).at[OFF_G:OFF_P].set(0.1)
    w_in = nrm(ks[5], (DEPTH, D_MODEL, D_IN_PROJ), D_MODEL ** -0.5) * col_scale
    b_i = nrm(ks[6], (DEPTH, N_MLSTM_HEADS), 0.1)
    b_f = jnp.linspace(3.0, 6.0, N_MLSTM_HEADS, dtype=jnp.float32)[None, :] + nrm(ks[7], (DEPTH, N_MLSTM_HEADS), 0.1)
    return {
        "x": nrm(ks[0], (BATCH, SEQ, D_MODEL), 1.0),
        "ffn1_norm": gain(ks[1], (DEPTH, D_MODEL)),
        "ffn1_w_gate": nrm(ks[2], (DEPTH, D_MODEL, D_FF), D_MODEL ** -0.5),
        "ffn1_w_up": nrm(ks[3], (DEPTH, D_MODEL, D_FF), D_MODEL ** -0.5),
        "ffn1_w_down": nrm(ks[4], (DEPTH, D_FF, D_MODEL), D_FF ** -0.5),
        "mix_norm": gain(ks[8], (DEPTH, D_MODEL)),
        "w_in": w_in,
        "b_gates": jnp.concatenate([b_i, b_f], axis=-1),
        "conv_w": nrm(ks[9], (DEPTH, CONV_WIDTH, 2 * MLSTM_WIDTH), CONV_WIDTH ** -0.5),
        "conv_b": nrm(ks[10], (DEPTH, 2 * MLSTM_WIDTH), 0.01),
        "mh_norm": gain(ks[11], (DEPTH, MLSTM_WIDTH)),
        "pool_w": nrm(ks[12], (DEPTH, N_POOL_GROUPS, POOL_GROUP_DIM, POOL_GROUP_DIM), POOL_GROUP_DIM ** -0.5),
        "pool_scale": gain(ks[13], (DEPTH, POOL_WIDTH)),
        "w_out": nrm(ks[14], (DEPTH, D_MIX, D_MODEL), D_MIX ** -0.5),
        "ffn2_norm": gain(ks[15], (DEPTH, D_MODEL)),
        "ffn2_w_gate": nrm(ks[16], (DEPTH, D_MODEL, D_FF), D_MODEL ** -0.5),
        "ffn2_w_up": nrm(ks[17], (DEPTH, D_MODEL, D_FF), D_MODEL ** -0.5),
        "ffn2_w_down": nrm(ks[18], (DEPTH, D_FF, D_MODEL), D_FF ** -0.5),
        "final_norm": gain(ks[19], (D_MODEL,)),
    }


def reference(x, ffn1_norm, ffn1_w_gate, ffn1_w_up, ffn1_w_down, mix_norm, w_in, b_gates,
              conv_w, conv_b, mh_norm, pool_w, pool_scale, w_out, ffn2_norm, ffn2_w_gate,
              ffn2_w_up, ffn2_w_down, final_norm):
    bsz, s, _ = x.shape
    for l in range(DEPTH):
        x = x + 0.5 * swiglu(rmsnorm(x, ffn1_norm[l]), ffn1_w_gate[l], ffn1_w_up[l], ffn1_w_down[l])

        h = rmsnorm(x, mix_norm[l])
        proj = h @ w_in[l]
        qk = jax.nn.silu(causal_dwconv(proj[..., OFF_QK:OFF_V], conv_w[l], conv_b[l]))
        q = qk[..., :MLSTM_WIDTH].astype(jnp.float32).reshape(bsz, s, N_MLSTM_HEADS, HEAD_DIM)
        k = qk[..., MLSTM_WIDTH:].astype(jnp.float32).reshape(bsz, s, N_MLSTM_HEADS, HEAD_DIM)
        v = proj[..., OFF_V:OFF_O].astype(jnp.float32).reshape(bsz, s, N_MLSTM_HEADS, HEAD_DIM)
        o_gate = jax.nn.sigmoid(proj[..., OFF_O:OFF_G].astype(jnp.float32))
        gates = proj[..., OFF_G:OFF_P].astype(jnp.float32) + b_gates[l].astype(jnp.float32)
        i_pre = gates[..., :N_MLSTM_HEADS]
        f_pre = gates[..., N_MLSTM_HEADS:]

        hm = mlstm_chunkwise(q, k, v, i_pre, f_pre).reshape(bsz, s, N_MLSTM_HEADS, HEAD_DIM)
        hm = hm * lax.rsqrt(jnp.mean(hm * hm, axis=-1, keepdims=True) + EPS)
        hm = o_gate * (hm.reshape(bsz, s, MLSTM_WIDTH) * mh_norm[l].astype(jnp.float32))

        hp = multiscale_pool(proj[..., OFF_P:], pool_w[l], pool_scale[l])

        mix = jnp.concatenate([hm, hp], axis=-1).astype(x.dtype) @ w_out[l]
        x = x + mix

        x = x + 0.5 * swiglu(rmsnorm(x, ffn2_norm[l]), ffn2_w_gate[l], ffn2_w_up[l], ffn2_w_down[l])
    return rmsnorm(x, final_norm)
```

```cpp
#include <hip/hip_runtime.h>
#include <hip/hip_cooperative_groups.h>
#include <cstdio>
#include <cstdint>
namespace cg = cooperative_groups;

#define LAS __attribute__((address_space(3)))
typedef unsigned short bf16;
typedef short bf16x8 __attribute__((ext_vector_type(8)));
typedef float f32x4 __attribute__((ext_vector_type(4)));
typedef unsigned u32x4 __attribute__((ext_vector_type(4)));
typedef unsigned u32x2 __attribute__((ext_vector_type(2)));

constexpr int S = 16384, DM = 1024, DFF = 2816, NPROJ = 2816  , DINP = 2568;
constexpr int NCH = 256, CL = 64, NH = 4, HD = 128;
constexpr float EPS = 1e-6f;

constexpr size_t MiB = 1u << 20;
constexpr size_t WS_SS0 = 0 * MiB, WS_SS1 = 1 * MiB, WS_SS2 = 2 * MiB, WS_SS3 = 3 * MiB;
constexpr size_t WS_GATES = 4 * MiB;
constexpr size_t WS_DN = 4 * MiB + 512 * 1024;
constexpr size_t WS_BAR = 5 * MiB + 512 * 1024;
constexpr size_t WS_PCNT = WS_BAR + 16384;
constexpr size_t WS_SC = 5 * MiB;
constexpr size_t WS_WGU1 = 6 * MiB;
constexpr size_t WS_WD1 = 17 * MiB;
constexpr size_t WS_WGU2 = 23 * MiB;
constexpr size_t WS_WD2 = 34 * MiB;
constexpr size_t WS_WIN = 40 * MiB;
constexpr size_t WS_WOUT = 46 * MiB;
constexpr size_t WS_HB = 48 * MiB;
constexpr size_t WS_MIX = 136 * MiB;
constexpr size_t WS_XB = 168 * MiB;
constexpr size_t WS_END = 200 * MiB;

constexpr int LDS_RTAB = 131072 + 256;
constexpr int LDS_BYTES = 131072 + 256 + 1024;

namespace pg8 {
#define PG8_LAS __attribute__((address_space(3)))
typedef unsigned short bf16_t;
constexpr int BM = 256, BK = 64, HALF = 128, HTB = HALF * BK * 2, STAGE_BYTES = 8 * HTB, NXCD = 8, WGM = 8;

__host__ __device__ __forceinline__ int lds_byte(int r, int c) { const int st = (r >> 4) * 2 + (c >> 5), rr = r & 15, cc = c & 31, ob = rr * 64 + cc * 2; return st * 1024 + (ob ^ (((ob >> 9) & 1) << 5)); }
__host__ __device__ __forceinline__ void stage_rc(int b, int& R, int& C) { const int st = b / 1024, sb = b % 1024, swz = sb ^ (((sb >> 9) & 1) << 5); R = (st >> 1) * 16 + swz / 64; C = (st & 1) * 32 + (swz % 64) / 2; }
__host__ __device__ __forceinline__ int perm32(int rho) { const int n = rho >> 4, i = rho & 15; return 8 * (i >> 2) + 4 * n + (i & 3); }

struct Unit { int pm, pn; };
struct Gemm { const bf16_t* A; const bf16_t* Bt; int M, N, K; };

struct StaticOrder {
    int nM, nN, nwg, G, c;
    __host__ __device__ void init(int M, int N, int G_, int c_) { nM = M / BM; nN = N / BM; nwg = nM * nN; G = G_; c = c_; }
    __host__ __device__ bool next(int i, Unit& u) const {
        const long L = (long)i * G + c; if (L >= nwg) return false;
        int wgid = (int)L; { const int q = nwg / NXCD, r = nwg % NXCD, xcd = wgid % NXCD, off = wgid / NXCD; wgid = (xcd < r ? xcd * (q + 1) : r * (q + 1) + (xcd - r) * q) + off; }
        const int nig = WGM * nN, gid = wgid / nig, fm = gid * WGM, gsz = (nM - fm) < WGM ? (nM - fm) : WGM;
        u.pm = fm + ((wgid % nig) % gsz); u.pn = (wgid % nig) / gsz; return true;
    }
    __device__ __forceinline__ void a_ready(const Unit&) const {}
    __device__ __forceinline__ void done(const Unit&) const {}
};

__device__ __forceinline__ unsigned cvt_pk_bf16(float lo, float hi) { unsigned r; asm volatile("v_cvt_pk_bf16_f32 %0, %1, %2" : "=v"(r) : "v"(lo), "v"(hi)); return r; }

__device__ __forceinline__ float row_rstd(const float* ss, int row) {
    const f32x4* p = (const f32x4*)(ss + (size_t)row * 16);
    const f32x4 a = p[0], b = p[1], c = p[2], d = p[3];
    const float s = (((a[0] + a[1]) + (a[2] + a[3])) + ((b[0] + b[1]) + (b[2] + b[3]))) + (((c[0] + c[1]) + (c[2] + c[3])) + ((d[0] + d[1]) + (d[2] + d[3])));
    return 1.0f / sqrtf(s * (1.0f / 1024.0f) + 1e-6f);
}
__device__ __forceinline__ float silu_f(float g) { return g * __builtin_amdgcn_rcpf(1.0f + __expf(-g)); }
typedef float f32x2 __attribute__((ext_vector_type(2)));
__device__ __forceinline__ f32x2 swiglu_pk(f32x2 g, f32x2 u, float c, float r2) {
    const f32x2 t = g * c;
    f32x2 e; e.x = __builtin_amdgcn_exp2f(t.x); e.y = __builtin_amdgcn_exp2f(t.y);
    const f32x2 d = e + 1.0f;
    f32x2 s; s.x = __builtin_amdgcn_rcpf(d.x); s.y = __builtin_amdgcn_rcpf(d.y);
    return (g * u) * (s * r2);
}

struct EpiSwiGLU {
    static constexpr bool PERM = true, AFTER_DRAIN = false;
    bf16_t* H; int ldh; const float* ss; const PG8_LAS float* rtab; int rt_pm;
    __device__ __forceinline__ void operator()(const f32x4 (&acc)[2][2][4][2], const Unit& u, int wr, int wc, int fr, int fq) const {
        const int row0 = u.pm * BM + wr * 64 + fr, col0 = u.pn * HALF + wc * 32 + 8 * fq; const bool tab = (u.pm == rt_pm);
#pragma unroll
        for (int ai = 0; ai < 2; ++ai)
#pragma unroll
            for (int m = 0; m < 4; ++m) {
                const int row = row0 + ai * HALF + m * 16; const float r = tab ? rtab[row - u.pm * BM] : row_rstd(ss, row);
                const float c = r * -1.4426950408889634f, r2 = r * r;
                const f32x4 G0 = acc[ai][0][m][0], G1 = acc[ai][0][m][1], U0 = acc[ai][1][m][0], U1 = acc[ai][1][m][1];
                const f32x2 h0 = swiglu_pk((f32x2){G0[0], G0[1]}, (f32x2){U0[0], U0[1]}, c, r2), h1 = swiglu_pk((f32x2){G0[2], G0[3]}, (f32x2){U0[2], U0[3]}, c, r2);
                const f32x2 h2 = swiglu_pk((f32x2){G1[0], G1[1]}, (f32x2){U1[0], U1[1]}, c, r2), h3 = swiglu_pk((f32x2){G1[2], G1[3]}, (f32x2){U1[2], U1[3]}, c, r2);
                u32x4 w;
                w.x = cvt_pk_bf16(h0.x, h0.y); w.y = cvt_pk_bf16(h1.x, h1.y); w.z = cvt_pk_bf16(h2.x, h2.y); w.w = cvt_pk_bf16(h3.x, h3.y);
                *(u32x4*)(H + (size_t)row * ldh + col0) = w;
            }
    }
};
struct EpiProj {
    static constexpr bool PERM = true, AFTER_DRAIN = false;
    bf16_t* P; int ldp; const float* ss; float* gates; const float* bg; int gate_tile; const PG8_LAS float* rtab; int rt_pm;
    __device__ __forceinline__ void operator()(const f32x4 (&acc)[2][2][4][2], const Unit& u, int wr, int wc, int fr, int fq) const {
        const int row0 = u.pm * BM + wr * 64 + fr, col0 = u.pn * BM + wc * 32 + 8 * fq; const bool tab = (u.pm == rt_pm);
        if (u.pn < gate_tile) {
#pragma unroll
            for (int ai = 0; ai < 2; ++ai)
#pragma unroll
                for (int m = 0; m < 4; ++m) {
                    const int row = row0 + ai * HALF + m * 16; const float r = tab ? rtab[row - u.pm * BM] : row_rstd(ss, row);
#pragma unroll
                    for (int bj = 0; bj < 2; ++bj) {
                        const f32x4 v0 = acc[ai][bj][m][0] * r, v1 = acc[ai][bj][m][1] * r;
                        u32x4 w; w.x = cvt_pk_bf16(v0[0], v0[1]); w.y = cvt_pk_bf16(v0[2], v0[3]); w.z = cvt_pk_bf16(v1[0], v1[1]); w.w = cvt_pk_bf16(v1[2], v1[3]);
                        *(u32x4*)(P + (size_t)row * ldp + col0 + bj * HALF) = w;
                    }
                }
        } else if (wc == 0 && fq == 0) {
            const f32x4 b0 = *(const f32x4*)bg, b1 = *(const f32x4*)(bg + 4);
#pragma unroll
            for (int ai = 0; ai < 2; ++ai)
#pragma unroll
                for (int m = 0; m < 4; ++m) {
                    const int row = row0 + ai * HALF + m * 16; const float r = tab ? rtab[row - u.pm * BM] : row_rstd(ss, row);
                    *(f32x4*)(gates + (size_t)row * 8) = acc[ai][0][m][0] * r + b0;
                    *(f32x4*)(gates + (size_t)row * 8 + 4) = acc[ai][0][m][1] * r + b1;
                }
        }
    }
};
__device__ __forceinline__ void bf8_to_f32(const u32x4 v, f32x4& lo, f32x4& hi) {
    lo = (f32x4){__uint_as_float(v.x << 16), __uint_as_float(v.x & 0xffff0000u), __uint_as_float(v.y << 16), __uint_as_float(v.y & 0xffff0000u)};
    hi = (f32x4){__uint_as_float(v.z << 16), __uint_as_float(v.z & 0xffff0000u), __uint_as_float(v.w << 16), __uint_as_float(v.w & 0xffff0000u)};
}
template <bool XI_BF16> struct EpiResid {
    static constexpr bool PERM = true, AFTER_DRAIN = false;
    const float* xi; bf16_t* xb; float* ssout; float scale;
    __device__ __forceinline__ void operator()(const f32x4 (&acc)[2][2][4][2], const Unit& u, int wr, int wc, int fr, int fq) const {
        const int row0 = u.pm * BM + wr * 64 + fr, col0 = u.pn * BM + wc * 32 + 8 * fq;
        const __amdgpu_buffer_rsrc_t xrsrc = __builtin_amdgcn_make_buffer_rsrc(xb, 0, 0x7fffffff, 0x00020000);
#pragma unroll
        for (int ai = 0; ai < 2; ++ai) {
        u32x4 xin[1][4][2];
        if (XI_BF16) {
#pragma unroll
                for (int m = 0; m < 4; ++m)
#pragma unroll
                    for (int bj = 0; bj < 2; ++bj) xin[0][m][bj] = *(const u32x4*)(xb + (size_t)(row0 + ai * HALF + m * 16) * DM + col0 + bj * HALF);
        }
#pragma unroll
            for (int m = 0; m < 4; ++m) {
                const int row = row0 + ai * HALF + m * 16; const size_t off = (size_t)row * DM + col0; float q = 0.f;
#pragma unroll
                for (int bj = 0; bj < 2; ++bj) {
                    const size_t o2 = off + bj * HALF; f32x4 b0, b1;
                    if (XI_BF16) bf8_to_f32(xin[0][m][bj], b0, b1); else { b0 = *(const f32x4*)(xi + o2); b1 = *(const f32x4*)(xi + o2 + 4); }
                    const f32x4 o0 = b0 + acc[ai][bj][m][0] * scale, o1 = b1 + acc[ai][bj][m][1] * scale;
                    u32x4 w; w.x = cvt_pk_bf16(o0[0], o0[1]); w.y = cvt_pk_bf16(o0[2], o0[3]); w.z = cvt_pk_bf16(o1[0], o1[1]); w.w = cvt_pk_bf16(o1[2], o1[3]);
                    __builtin_amdgcn_raw_buffer_store_b128(w, xrsrc, (unsigned)(o2 * 2), 0,   16);
                    q += ((o0[0] * o0[0] + o0[1] * o0[1]) + (o0[2] * o0[2] + o0[3] * o0[3])) + ((o1[0] * o1[0] + o1[1] * o1[1]) + (o1[2] * o1[2] + o1[3] * o1[3]));
                }
                q += __shfl_xor(q, 16); q += __shfl_xor(q, 32);
                if (fq == 0) ssout[(size_t)row * 16 + u.pn * 4 + wc] = q;
                if (!XI_BF16) asm volatile("" ::: "memory");
            }
            asm volatile("" ::: "memory");
        }
    }
};
struct EpiFinal {
    static constexpr bool PERM = true, AFTER_DRAIN = false;
    const bf16_t* xb; float* out; float* ss; unsigned* cnt; const float* gf; float scale;
    __device__ __forceinline__ void operator()(f32x4 (&acc)[2][2][4][2], const Unit& u, int wr, int wc, int fr, int fq) const {
        const int row0 = u.pm * BM + wr * 64 + fr, col0 = u.pn * BM + wc * 32 + 8 * fq;
#pragma unroll
        for (int ai = 0; ai < 2; ++ai) {
        u32x4 xin[4][2];
#pragma unroll
            for (int m = 0; m < 4; ++m)
#pragma unroll
                for (int bj = 0; bj < 2; ++bj) xin[m][bj] = *(const u32x4*)(xb + (size_t)(row0 + ai * HALF + m * 16) * DM + col0 + bj * HALF);
#pragma unroll
            for (int m = 0; m < 4; ++m) {
                const int row = row0 + ai * HALF + m * 16; float q = 0.f;
#pragma unroll
                for (int bj = 0; bj < 2; ++bj) {
                    f32x4 b0, b1; bf8_to_f32(xin[m][bj], b0, b1);
                    const f32x4 o0 = b0 + acc[ai][bj][m][0] * scale, o1 = b1 + acc[ai][bj][m][1] * scale;
                    acc[ai][bj][m][0] = o0; acc[ai][bj][m][1] = o1;
                    q += ((o0[0] * o0[0] + o0[1] * o0[1]) + (o0[2] * o0[2] + o0[3] * o0[3])) + ((o1[0] * o1[0] + o1[1] * o1[1]) + (o1[2] * o1[2] + o1[3] * o1[3]));
                }
                q += __shfl_xor(q, 16); q += __shfl_xor(q, 32);
                if (fq == 0) __hip_atomic_store((unsigned*)(ss + (size_t)row * 16 + u.pn * 4 + wc), __float_as_uint(q), __ATOMIC_RELAXED, __HIP_MEMORY_SCOPE_AGENT);
            }
            asm volatile("" ::: "memory");
        }
        asm volatile("s_waitcnt vmcnt(0)" ::: "memory");
        unsigned* pc = cnt + 64 * u.pm;
        if ((threadIdx.x & 63) == 0) __hip_atomic_fetch_add(pc, 1u, __ATOMIC_RELAXED, __HIP_MEMORY_SCOPE_AGENT);
        { unsigned sp = 0; while ((unsigned)__builtin_amdgcn_readfirstlane(__hip_atomic_load(pc, __ATOMIC_RELAXED, __HIP_MEMORY_SCOPE_AGENT)) < 32u) { __builtin_amdgcn_s_sleep(2); if (++sp > (1u << 20)) break; } }
        __builtin_amdgcn_fence(__ATOMIC_ACQUIRE, "agent");
        f32x4 gv[2][2];
#pragma unroll
        for (int bj = 0; bj < 2; ++bj) { gv[bj][0] = *(const f32x4*)(gf + col0 + bj * HALF); gv[bj][1] = *(const f32x4*)(gf + col0 + bj * HALF + 4); }
        f32x4 ptv[2][4];
#pragma unroll
        for (int ai = 0; ai < 2; ++ai)
#pragma unroll
            for (int m = 0; m < 4; ++m) ptv[ai][m] = *(const f32x4*)(ss + (size_t)(row0 + ai * HALF + m * 16) * 16 + fq * 4);
#pragma unroll
        for (int ai = 0; ai < 2; ++ai)
#pragma unroll
            for (int m = 0; m < 4; ++m) {
                const int row = row0 + ai * HALF + m * 16; const size_t off = (size_t)row * DM + col0;
                const f32x4 pt = ptv[ai][m];
                float s = (pt[0] + pt[1]) + (pt[2] + pt[3]); s += __shfl_xor(s, 16); s += __shfl_xor(s, 32);
                const float r = 1.0f / sqrtf(s * (1.0f / 1024.0f) + 1e-6f);
#pragma unroll
                for (int bj = 0; bj < 2; ++bj) { *(f32x4*)(out + off + bj * HALF) = acc[ai][bj][m][0] * r * gv[bj][0]; *(f32x4*)(out + off + bj * HALF + 4) = acc[ai][bj][m][1] * r * gv[bj][1]; }
            }
    }
};

template <class Epi, class Sched, bool ALIGN_EPI = false, bool SP2 = false>
__device__ __forceinline__ void gemm_phase(PG8_LAS unsigned char* lds, const Gemm g, const Sched& S, const Epi& E) {
    const int tid = threadIdx.x, wid = __builtin_amdgcn_readfirstlane(tid >> 6), lane = tid & 63, wr = wid >> 2, wc = wid & 3, fr = lane & 15, fq = lane >> 4;
    const int K = g.K, nt = K / BK;
    unsigned voffA[2], voffB[2];
#pragma unroll
    for (int i = 0; i < 2; ++i) { int R, C; stage_rc(tid * 16 + i * 8192, R, C); const int Rb = Epi::PERM ? ((R & ~31) + perm32(R & 31)) : R;
        voffA[i] = (unsigned)(R * K + C) * 2u; voffB[i] = (unsigned)(Rb * K + C) * 2u; }
    const size_t kstep = (size_t)(BK * 2);
    const size_t hstep = (size_t)HALF * K * 2;
    const size_t tstep = 2 * hstep;
    const unsigned ldsw = (unsigned)wid * 1024u;
    const int aoff = lds_byte(wr * 64 + fr, fq * 8), boff = lds_byte(wc * 32 + fr, fq * 8);
#define PG8_SA(b, h) (((b) * 2 + (h)) * HTB)
#define PG8_SB(b, h) ((4 + (b) * 2 + (h)) * HTB)
#define PG8_STAGE(bufoff, gbase, voff) do { _Pragma("unroll") for (int _i = 0; _i < 2; ++_i) \
        __builtin_amdgcn_global_load_lds((const unsigned*)((const char*)(gbase) + (voff)[_i]), (PG8_LAS unsigned*)(lds + (bufoff) + ldsw + _i * 8192), 16, 0, 0); } while (0)
#define PG8_LDA(dst, b, h) do { _Pragma("unroll") for (int m = 0; m < 4; ++m) _Pragma("unroll") for (int k = 0; k < 2; ++k) dst[m][k] = *(const PG8_LAS bf16x8*)(lds + PG8_SA(b, h) + aoff + m * 2048 + k * 1024); } while (0)
#define PG8_LDB(dst, b, h) do { _Pragma("unroll") for (int n = 0; n < 2; ++n) _Pragma("unroll") for (int k = 0; k < 2; ++k) dst[n][k] = *(const PG8_LAS bf16x8*)(lds + PG8_SB(b, h) + boff + n * 2048 + k * 1024); } while (0)
#define PG8_MMA(ai, bj, At, Bt) do { __builtin_amdgcn_s_setprio(1); _Pragma("unroll") for (int m = 0; m < 4; ++m) _Pragma("unroll") for (int n = 0; n < 2; ++n) _Pragma("unroll") for (int k = 0; k < 2; ++k) \
        acc[ai][bj][m][n] = __builtin_amdgcn_mfma_f32_16x16x32_bf16(Bt[n][k], At[m][k], acc[ai][bj][m][n], 0, 0, 0); __builtin_amdgcn_s_setprio(0); } while (0)
#define PG8_WAIT_V(n) asm volatile("s_waitcnt vmcnt(" #n ")" ::: "memory")
#define PG8_WAIT_L(n) asm volatile("s_waitcnt lgkmcnt(" #n ")" ::: "memory")
#define PG8_BAR __builtin_amdgcn_s_barrier()
#define PG8_SCHED __builtin_amdgcn_sched_barrier(0)
    Unit cur, nxt; int ui = 0;
    if (!S.next(0, cur)) return;
    f32x4 acc[2][2][4][2];
#pragma unroll
    for (int a = 0; a < 2; ++a)
#pragma unroll
        for (int b = 0; b < 2; ++b)
#pragma unroll
            for (int m = 0; m < 4; ++m)
#pragma unroll
                for (int n = 0; n < 2; ++n) acc[a][b][m][n] = (f32x4){0.f, 0.f, 0.f, 0.f};
    bf16x8 At[4][2], B0[2][2], B1[2][2];
    const char* cA = (const char*)g.A + (size_t)cur.pm * tstep; const char* cB = (const char*)g.Bt + (size_t)cur.pn * tstep;
    S.a_ready(cur);
    if constexpr (SP2) {
        PG8_STAGE(PG8_SB(0, 0), cB, voffB); PG8_STAGE(PG8_SB(0, 1), cB + hstep, voffB); PG8_STAGE(PG8_SA(0, 0), cA, voffA); PG8_STAGE(PG8_SA(0, 1), cA + hstep, voffA);
        if (wr == 1) PG8_BAR;
        PG8_WAIT_V(2); PG8_BAR;
        PG8_STAGE(PG8_SB(1, 0), cB + kstep, voffB); PG8_STAGE(PG8_SA(1, 0), cA + kstep, voffA); PG8_STAGE(PG8_SB(1, 1), cB + hstep + kstep, voffB);
        PG8_WAIT_V(6); PG8_BAR;
    } else {
        PG8_STAGE(PG8_SB(0, 0), cB, voffB); PG8_STAGE(PG8_SA(0, 0), cA, voffA); PG8_STAGE(PG8_SB(0, 1), cB + hstep, voffB); PG8_STAGE(PG8_SA(0, 1), cA + hstep, voffA);
        if (wr == 1) PG8_BAR;
        PG8_WAIT_V(4); PG8_BAR;
        PG8_STAGE(PG8_SB(1, 0), cB + kstep, voffB); PG8_STAGE(PG8_SA(1, 0), cA + kstep, voffA); PG8_STAGE(PG8_SB(1, 1), cB + hstep + kstep, voffB);
        PG8_WAIT_V(6); PG8_BAR;
    }
    for (;;) {
        const bool has_next = S.next(ui + 1, nxt);
        const char* nA = has_next ? (const char*)g.A + (size_t)nxt.pm * tstep : cA; const char* nB = has_next ? (const char*)g.Bt + (size_t)nxt.pn * tstep : cB;
        for (int t = 0; t < nt; t += 2) {
            const bool last = (t == nt - 2);
            const char* a1 = cA + (size_t)(t + 1) * kstep;
            const char* a2 = last ? nA : cA + (size_t)(t + 2) * kstep; const char* b2 = last ? nB : cB + (size_t)(t + 2) * kstep;
            const char* a3 = a2 + kstep; const char* b3 = b2 + kstep;
            if (last && has_next) S.a_ready(nxt);
            if constexpr (SP2) {
            PG8_LDB(B0, 0, 0); PG8_LDB(B1, 0, 1); PG8_SCHED; PG8_LDA(At, 0, 0); PG8_STAGE(PG8_SA(1, 1), a1 + hstep, voffA);
            PG8_WAIT_V(8); PG8_WAIT_L(0); PG8_BAR; PG8_MMA(0, 0, At, B0); PG8_MMA(0, 1, At, B1); PG8_BAR; PG8_SCHED;
            PG8_LDA(At, 0, 1); PG8_STAGE(PG8_SB(0, 0), b2, voffB); PG8_STAGE(PG8_SB(0, 1), b2 + hstep, voffB); PG8_STAGE(PG8_SA(0, 0), a2, voffA);
            PG8_WAIT_V(8); PG8_WAIT_L(0); PG8_BAR; PG8_MMA(1, 0, At, B0); PG8_MMA(1, 1, At, B1); PG8_BAR; PG8_SCHED;
            PG8_LDB(B0, 1, 0); PG8_LDB(B1, 1, 1); PG8_SCHED; PG8_LDA(At, 1, 0); PG8_STAGE(PG8_SA(0, 1), a2 + hstep, voffA);
            PG8_WAIT_V(8); PG8_WAIT_L(0); PG8_BAR; PG8_MMA(0, 0, At, B0); PG8_MMA(0, 1, At, B1); PG8_BAR; PG8_SCHED;
            PG8_LDA(At, 1, 1); PG8_STAGE(PG8_SB(1, 0), b3, voffB); PG8_STAGE(PG8_SB(1, 1), b3 + hstep, voffB); PG8_STAGE(PG8_SA(1, 0), a3, voffA);
            PG8_WAIT_V(8); PG8_WAIT_L(0); PG8_BAR; PG8_MMA(1, 0, At, B0); PG8_MMA(1, 1, At, B1); PG8_BAR; PG8_SCHED;
            } else {
            PG8_LDB(B0, 0, 0); PG8_SCHED; PG8_LDA(At, 0, 0); PG8_STAGE(PG8_SA(1, 1), a1 + hstep, voffA);
            PG8_WAIT_L(8); PG8_BAR; PG8_WAIT_L(0); PG8_MMA(0, 0, At, B0); PG8_BAR; PG8_SCHED;
            PG8_LDB(B1, 0, 1); PG8_STAGE(PG8_SB(0, 0), b2, voffB);
            PG8_BAR; PG8_WAIT_L(0); PG8_MMA(0, 1, At, B1); PG8_BAR;
            PG8_LDA(At, 0, 1); PG8_STAGE(PG8_SA(0, 0), a2, voffA);
            PG8_BAR; PG8_WAIT_L(0); PG8_MMA(1, 0, At, B0); PG8_BAR; PG8_SCHED;
            PG8_STAGE(PG8_SB(0, 1), b2 + hstep, voffB);
            PG8_WAIT_V(6); PG8_BAR; PG8_MMA(1, 1, At, B1); PG8_BAR;
            PG8_LDB(B0, 1, 0); PG8_SCHED; PG8_LDA(At, 1, 0); PG8_STAGE(PG8_SA(0, 1), a2 + hstep, voffA);
            PG8_WAIT_L(8); PG8_BAR; PG8_WAIT_L(0); PG8_MMA(0, 0, At, B0); PG8_BAR; PG8_SCHED;
            PG8_LDB(B1, 1, 1); PG8_STAGE(PG8_SB(1, 0), b3, voffB);
            PG8_BAR; PG8_WAIT_L(0); PG8_MMA(0, 1, At, B1); PG8_BAR;
            PG8_LDA(At, 1, 1); PG8_STAGE(PG8_SA(1, 0), a3, voffA);
            PG8_BAR; PG8_WAIT_L(0); PG8_MMA(1, 0, At, B0); PG8_BAR; PG8_SCHED;
            PG8_STAGE(PG8_SB(1, 1), b3 + hstep, voffB);
            PG8_WAIT_V(6); PG8_BAR; PG8_MMA(1, 1, At, B1); PG8_BAR;
            }
        }
        if constexpr (ALIGN_EPI) { if (wr == 0) PG8_BAR; }
        if constexpr (!Epi::AFTER_DRAIN) { E(acc, cur, wr, wc, fr, fq); S.done(cur); }
        if (!has_next) break;
#pragma unroll
        for (int a = 0; a < 2; ++a)
#pragma unroll
            for (int b = 0; b < 2; ++b)
#pragma unroll
                for (int m = 0; m < 4; ++m)
#pragma unroll
                    for (int n = 0; n < 2; ++n) acc[a][b][m][n] = (f32x4){0.f, 0.f, 0.f, 0.f};
        cur = nxt; cA = nA; cB = nB; ++ui;
        if constexpr (ALIGN_EPI) { if (wr == 1) PG8_BAR; }
    }
    PG8_WAIT_V(0);
    if constexpr (!ALIGN_EPI) { if (wr == 0) PG8_BAR; }
    PG8_BAR;
#undef PG8_SA
#undef PG8_SB
#undef PG8_STAGE
#undef PG8_LDA
#undef PG8_LDB
#undef PG8_MMA
#undef PG8_WAIT_V
#undef PG8_WAIT_L
#undef PG8_BAR
#undef PG8_SCHED
}
}

#define LDS_WAIT() asm volatile("s_waitcnt lgkmcnt(0)" ::: "memory")
__device__ __forceinline__ unsigned f2bf(float f) { unsigned u = __builtin_bit_cast(unsigned, f); return (u + 0x7fffu + ((u >> 16) & 1u)) >> 16; }
__device__ __forceinline__ unsigned pk2(float lo, float hi) { return f2bf(lo) | (f2bf(hi) << 16); }
__device__ __forceinline__ float bf2f(unsigned b) { return __uint_as_float(b << 16); }
__device__ __forceinline__ float wave_sum(float v) {
#pragma unroll
    for (int o = 1; o < 64; o <<= 1) v += __shfl_xor(v, o);
    return v;
}
__device__ __forceinline__ float wave_max(float v) {
#pragma unroll
    for (int o = 1; o < 64; o <<= 1) v = fmaxf(v, __shfl_xor(v, o));
    return v;
}
__device__ __forceinline__ float wave_incl_sum(float v, int lane) {
#pragma unroll
    for (int o = 1; o < 64; o <<= 1) { const float t = __shfl_up(v, o); if (lane >= o) v += t; }
    return v;
}
__device__ __forceinline__ float wave_incl_max(float v, int lane) {
#pragma unroll
    for (int o = 1; o < 64; o <<= 1) { const float t = __shfl_up(v, o); if (lane >= o) v = fmaxf(v, t); }
    return v;
}
__device__ __forceinline__ float log_sigmoid_f(float x) { return fminf(x, 0.f) - log1pf(expf(-fabsf(x))); }

__device__ __forceinline__ void p0_item(const float* W, int ldw, int src_col0, bf16* WT, int K, int dst_row0, int k0, const float* gk, LAS float* scr, int lane) {
    {
        float wv[32]; const float* wp = W + (size_t)(k0 + (lane >> 5)) * ldw + src_col0 + (lane & 31);
#pragma unroll
        for (int i = 0; i < 32; ++i) wv[i] = __builtin_nontemporal_load(wp + (size_t)(2 * i) * ldw);
        if (gk) {
            const float* gp = gk + k0 + (lane >> 5);
#pragma unroll
            for (int i = 0; i < 32; ++i) wv[i] *= gp[2 * i];
        }
#pragma unroll
        for (int i = 0; i < 32; ++i) scr[(2 * i + (lane >> 5)) * 33 + (lane & 31)] = wv[i];
    }
    LDS_WAIT(); asm volatile("" ::: "memory");
    const int c = lane & 7;
#pragma unroll
    for (int j = 0; j < 4; ++j) { const int n = (lane >> 3) + 8 * j; const LAS float* s = scr + (8 * c) * 33 + n;
        u32x4 o; o.x = pk2(s[0 * 33], s[1 * 33]); o.y = pk2(s[2 * 33], s[3 * 33]); o.z = pk2(s[4 * 33], s[5 * 33]); o.w = pk2(s[6 * 33], s[7 * 33]);
        *(u32x4*)(WT + (size_t)(dst_row0 + n) * K + k0 + 8 * c) = o; }
    LDS_WAIT(); asm volatile("" ::: "memory");
}

struct Params {
    const float* x; const float* n1; const float* wg1; const float* wu1; const float* wd1;
    const float* nmix; const float* win; const float* bg; const float* convw; const float* convb; const float* mhn;
    const float* poolw; const float* pools; const float* wout; const float* n2; const float* wg2; const float* wu2; const float* wd2; const float* nf;
    float* out; unsigned char* ws;
};

__device__ __forceinline__ void cvt_gu(const Params& p, int set, LAS float* scr, int lane, int gw, int NGW) {
    constexpr int I_GU = 16 * 88;
    bf16* WT = (bf16*)(p.ws + (set ? WS_WGU2 : WS_WGU1)); const float* gk = set ? p.n2 : p.n1;
    for (int it = gw; it < 2 * I_GU; it += NGW) {
        const int up = it / I_GU, r = it - up * I_GU, kb = r / 88, nb = r % 88, n0 = 32 * nb;
        const float* W = set ? (up ? p.wu2 : p.wg2) : (up ? p.wu1 : p.wg1);
        p0_item(W, DFF, n0, WT, DM, (n0 >> 7) * 256 + (n0 & 127) + up * 128, 64 * kb, gk, scr, lane);
    }
}
__device__ __forceinline__ void cvt_down(const Params& p, int set, LAS float* scr, int lane, int gw, int NGW) {
    for (int it = gw; it < 44 * 32; it += NGW) { const int kb = it / 32, nb = it % 32;
        p0_item(set ? p.wd2 : p.wd1, DM, 32 * nb, (bf16*)(p.ws + (set ? WS_WD2 : WS_WD1)), DFF, 32 * nb, 64 * kb, nullptr, scr, lane); }
}
__device__ __forceinline__ void cvt_in(const Params& p, LAS float* scr, int lane, int gw, int NGW) {
    bf16* WIN = (bf16*)(p.ws + WS_WIN);
    for (int it = gw; it < 16 * 64 + 16 * 16; it += NGW) {
        if (it < 16 * 64) { const int kb = it / 64, nb = it % 64; p0_item(p.win, DINP, 32 * nb, WIN, DM, 32 * nb, 64 * kb, p.nmix, scr, lane); }
        else { const int r = it - 16 * 64, kb = r / 16, nb = r % 16; p0_item(p.win, DINP, 2056 + 32 * nb, WIN, DM, 2048 + 32 * nb, 64 * kb, p.nmix, scr, lane); }
    }
    for (int wi = gw; wi < 512; wi += NGW) {
        const int idx = wi * 64 + lane, rr = idx >> 7, kc = (idx & 127) * 8;
        u32x4 o = (u32x4){0u, 0u, 0u, 0u};
        if (rr < 8) {
            float v[8];
#pragma unroll
            for (int e = 0; e < 8; ++e) v[e] = p.win[(size_t)(kc + e) * DINP + 2048 + rr] * p.nmix[kc + e];
            o.x = pk2(v[0], v[1]); o.y = pk2(v[2], v[3]); o.z = pk2(v[4], v[5]); o.w = pk2(v[6], v[7]);
        }
        *(u32x4*)(WIN + (size_t)(2560 + rr) * DM + kc) = o;
    }
}
__device__ __forceinline__ void cvt_out(const Params& p, LAS float* scr, int lane, int gw, int NGW) {
    bf16* WOUT = (bf16*)(p.ws + WS_WOUT);
    for (int it = gw; it < 8 * 32; it += NGW) { const int kb = it / 32, nb = it % 32; p0_item(p.wout, DM, 32 * nb, WOUT, DM, 32 * nb, 64 * kb, nullptr, scr, lane); }
    for (int wi = gw; wi < 1024; wi += NGW) {
        const int nblk = wi & 15, cgp = (wi >> 4) & 15, g = wi >> 8, n = nblk * 64 + lane, c0 = cgp * 8;
        float a[8];
#pragma unroll
        for (int e = 0; e < 8; ++e) a[e] = 0.f;
        const float* pw = p.poolw + (size_t)(g * 128 + c0) * 128; const float* ps = p.pools + g * 128; const float* wo = p.wout + (size_t)(512 + g * 128) * DM + n;
        for (int d0 = 0; d0 < 128; d0 += 16) {
            float wv[16];
#pragma unroll
            for (int dd = 0; dd < 16; ++dd) wv[dd] = wo[(size_t)(d0 + dd) * DM];
#pragma unroll
            for (int dd = 0; dd < 16; ++dd) { const float w = wv[dd] * ps[d0 + dd];
#pragma unroll
                for (int e = 0; e < 8; ++e) a[e] += pw[e * 128 + d0 + dd] * w; }
        }
        u32x4 o; o.x = pk2(a[0], a[1]); o.y = pk2(a[2], a[3]); o.z = pk2(a[4], a[5]); o.w = pk2(a[6], a[7]);
        *(u32x4*)(WOUT + (size_t)n * DM + 512 + g * 128 + c0) = o;
    }
}
__device__ __forceinline__ void p0_prologue(const Params& p, LAS unsigned char* lds, int G) {
    const int tid = threadIdx.x, lane = tid & 63, wave = __builtin_amdgcn_readfirstlane(tid >> 6);
    LAS float* scr = (LAS float*)(lds + wave * 8448);
    const int gw = blockIdx.x * 8 + wave, NGW = G * 8;
    cvt_gu(p, 0, scr, lane, gw, NGW);
    bf16* XB = (bf16*)(p.ws + WS_XB); float* SS0 = (float*)(p.ws + WS_SS0);
    for (int m0 = gw * 4; m0 < S; m0 += NGW * 4) {
        f32x4 v[4][4];
#pragma unroll
        for (int rr = 0; rr < 4; ++rr) { const f32x4* xr = (const f32x4*)(p.x + (size_t)(m0 + rr) * DM) + lane;
#pragma unroll
            for (int j = 0; j < 4; ++j) v[rr][j] = __builtin_nontemporal_load(xr + 64 * j); }
#pragma unroll
        for (int rr = 0; rr < 4; ++rr) {
            float s = 0.f;
#pragma unroll
            for (int j = 0; j < 4; ++j) s += (v[rr][j][0] * v[rr][j][0] + v[rr][j][1] * v[rr][j][1]) + (v[rr][j][2] * v[rr][j][2] + v[rr][j][3] * v[rr][j][3]);
            s = wave_sum(s);
            u32x2* o8 = (u32x2*)(XB + (size_t)(m0 + rr) * DM) + lane;
#pragma unroll
            for (int j = 0; j < 4; ++j) { u32x2 w; w.x = pk2(v[rr][j][0], v[rr][j][1]); w.y = pk2(v[rr][j][2], v[rr][j][3]); o8[64 * j] = w; }
            if (lane < 16) SS0[(size_t)(m0 + rr) * 16 + lane] = lane == 0 ? s : 0.f;
        }
    }
}
__device__ __forceinline__ bool slack_rank(int nwg, int G, int& gw, int& NGW) {
    const int imax = (nwg - 1) / G, cb = nwg - imax * G;
    if ((int)blockIdx.x < cb || cb >= G) return false;
    gw = ((int)blockIdx.x - cb) * 8 + (int)__builtin_amdgcn_readfirstlane(threadIdx.x >> 6); NGW = (G - cb) * 8; return true;
}

constexpr int L_QS = 0, L_KS = 17408, L_VT = 34816, L_CT = 53248, L_PS = 88064, L_OS = 97280, L_SM = 114688;
constexpr int QP = 136, TP = 72;

__device__ __forceinline__ int tsw(int row, int col) { return row * TP + (col ^ (((row >> 3) & 7) << 3)); }
__device__ __forceinline__ void unpack8(const u32x4 v, float (&f)[8]) {
    f[0] = __uint_as_float(v.x << 16); f[1] = __uint_as_float(v.x & 0xffff0000u); f[2] = __uint_as_float(v.y << 16); f[3] = __uint_as_float(v.y & 0xffff0000u);
    f[4] = __uint_as_float(v.z << 16); f[5] = __uint_as_float(v.z & 0xffff0000u); f[6] = __uint_as_float(v.w << 16); f[7] = __uint_as_float(v.w & 0xffff0000u);
}
__device__ __forceinline__ void conv8(const bf16* proj, int t, int ch, const float* cw, const float* cb, float sc, float (&o)[8]) {
    { const f32x4 b0 = *(const f32x4*)(cb + ch), b1 = *(const f32x4*)(cb + ch + 4);
      o[0] = b0[0]; o[1] = b0[1]; o[2] = b0[2]; o[3] = b0[3]; o[4] = b1[0]; o[5] = b1[1]; o[6] = b1[2]; o[7] = b1[3]; }
#pragma unroll
    for (int w = 0; w < 4; ++w) {
        const int tr = t - 3 + w;
        if (tr >= 0) {
            const u32x4 raw = *(const u32x4*)(proj + (size_t)tr * NPROJ + ch); float xv[8]; unpack8(raw, xv);
            const f32x4 w0 = *(const f32x4*)(cw + w * 1024 + ch), w1 = *(const f32x4*)(cw + w * 1024 + ch + 4);
            o[0] += w0[0] * xv[0]; o[1] += w0[1] * xv[1]; o[2] += w0[2] * xv[2]; o[3] += w0[3] * xv[3];
            o[4] += w1[0] * xv[4]; o[5] += w1[1] * xv[5]; o[6] += w1[2] * xv[6]; o[7] += w1[3] * xv[7];
        }
    }
#pragma unroll
    for (int e = 0; e < 8; ++e) o[e] = o[e] * sc * __builtin_amdgcn_rcpf(1.0f + __expf(-o[e]));
}
__device__ __forceinline__ void conv4x8(const bf16* proj, int t, int ch, const float* cw, const float* cb, float sc, float (&o)[4][8]) {
    u32x4 raw[7];
#pragma unroll
    for (int i = 0; i < 7; ++i) { const int tr = t - 3 + i; raw[i] = tr >= 0 ? *(const u32x4*)(proj + (size_t)tr * NPROJ + ch) : (u32x4){0u, 0u, 0u, 0u}; }
    { const f32x4 b0 = *(const f32x4*)(cb + ch), b1 = *(const f32x4*)(cb + ch + 4);
#pragma unroll
      for (int j = 0; j < 4; ++j) { o[j][0] = b0[0]; o[j][1] = b0[1]; o[j][2] = b0[2]; o[j][3] = b0[3]; o[j][4] = b1[0]; o[j][5] = b1[1]; o[j][6] = b1[2]; o[j][7] = b1[3]; } }
#pragma unroll
    for (int w = 0; w < 4; ++w) {
        const f32x4 w0 = *(const f32x4*)(cw + w * 1024 + ch), w1 = *(const f32x4*)(cw + w * 1024 + ch + 4);
        const float wv[8] = {w0[0], w0[1], w0[2], w0[3], w1[0], w1[1], w1[2], w1[3]};
#pragma unroll
        for (int j = 0; j < 4; ++j) { float xv[8]; unpack8(raw[j + w], xv);
#pragma unroll
            for (int e = 0; e < 8; ++e) o[j][e] += wv[e] * xv[e]; }
    }
#pragma unroll
    for (int j = 0; j < 4; ++j)
#pragma unroll
        for (int e = 0; e < 8; ++e) o[j][e] = o[j][e] * sc * __builtin_amdgcn_rcpf(1.0f + __expf(-o[j][e]));
}
__device__ __forceinline__ u32x4 pack8(const float (&v)[8]) { u32x4 o; o.x = pk2(v[0], v[1]); o.y = pk2(v[2], v[3]); o.z = pk2(v[4], v[5]); o.w = pk2(v[6], v[7]); return o; }

__device__ __forceinline__ void m1_phase(const Params& p, unsigned char* ldsg, int G) {
    const int tid = threadIdx.x, lane = tid & 63, wave = __builtin_amdgcn_readfirstlane(tid >> 6), fr = lane & 15, fq = lane >> 4;
    const int half = wave >> 2, hw = wave & 3, htid = tid & 255;
    unsigned char* ws = p.ws;
    const bf16* PROJ = (const bf16*)(ws + WS_HB); const float* GATES = (const float*)(ws + WS_GATES);
    bf16* DCB = (bf16*)p.out; bf16* QKC = (bf16*)((unsigned char*)p.out + 32 * MiB); float* DN = (float*)(ws + WS_DN); float* GARR = (float*)(ws + WS_SC); float* AMAXARR = GARR + 1024;
    bf16* KT = (bf16*)(ldsg + half * 40960); bf16* VT = KT + 128 * TP; float* sW = (float*)(ldsg + half * 40960 + 36864);
    for (int r = blockIdx.x; r < NCH * NH / 2; r += G) {
        const int c = r >> 1, h = 2 * (r & 1) + half, u = c * 4 + h, t0 = c * CL;
        if (hw == 0) {
            const float ig = GATES[(size_t)(t0 + lane) * 8 + h], fp = GATES[(size_t)(t0 + lane) * 8 + 4 + h];
            const float b = wave_incl_sum(log_sigmoid_f(fp), lane);
            const float g = __shfl(b, 63);
            const float a = g - b + ig;
            const float amax = wave_max(a);
            sW[lane] = expf(a - amax);
            if (lane == 0) { GARR[h * NCH + c] = g; AMAXARR[h * NCH + c] = amax; }
        }
        const int rg = htid >> 4, cgp = htid & 15, l0 = 4 * rg;
        float kk[4][8];
        {
            float qv[4][8];
            conv4x8(PROJ, t0 + l0, h * HD + cgp * 8, p.convw, p.convb, 1.0f, qv);
#pragma unroll
            for (int j = 0; j < 4; ++j) *(u32x4*)(QKC + (size_t)(t0 + l0 + j) * DM + h * HD + cgp * 8) = pack8(qv[j]);
        }
        asm volatile("" ::: "memory");
        conv4x8(PROJ, t0 + l0, 512 + h * HD + cgp * 8, p.convw, p.convb, 0.08838834764831845f, kk);
#pragma unroll
        for (int j = 0; j < 4; ++j) *(u32x4*)(QKC + (size_t)(t0 + l0 + j) * DM + 512 + h * HD + cgp * 8) = pack8(kk[j]);
        {
            u32x4 rv[4];
#pragma unroll
            for (int j = 0; j < 4; ++j) rv[j] = *(const u32x4*)(PROJ + (size_t)(t0 + l0 + j) * NPROJ + 1024 + h * HD + cgp * 8);
#pragma unroll
            for (int e = 0; e < 8; ++e) {
                const unsigned sh = (e & 1) * 16;
                u32x2 o; o.x = ((rv[0][e >> 1] >> sh) & 0xffffu) | (((rv[1][e >> 1] >> sh) & 0xffffu) << 16); o.y = ((rv[2][e >> 1] >> sh) & 0xffffu) | (((rv[3][e >> 1] >> sh) & 0xffffu) << 16);
                *(u32x2*)(VT + tsw(cgp * 8 + e, l0)) = o;
            }
        }
        __syncthreads();
        {
            const f32x4 w4 = *(const f32x4*)(sW + l0);
#pragma unroll
            for (int e = 0; e < 8; ++e) { u32x2 o; o.x = pk2(kk[0][e] * w4[0], kk[1][e] * w4[1]); o.y = pk2(kk[2][e] * w4[2], kk[3][e] * w4[3]); *(u32x2*)(KT + tsw(cgp * 8 + e, l0)) = o; }
        }
        __syncthreads();
        {
            bf16x8 av[2][2];
#pragma unroll
            for (int mi = 0; mi < 2; ++mi)
#pragma unroll
                for (int ks = 0; ks < 2; ++ks) av[mi][ks] = *(const bf16x8*)(VT + tsw(16 * (2 * hw + mi) + fr, ks * 32 + fq * 8));
#pragma unroll
            for (int nt = 0; nt < 8; ++nt) {
                bf16x8 bk[2];
#pragma unroll
                for (int ks = 0; ks < 2; ++ks) bk[ks] = *(const bf16x8*)(KT + tsw(16 * nt + fr, ks * 32 + fq * 8));
#pragma unroll
                for (int mi = 0; mi < 2; ++mi) {
                    f32x4 acc = (f32x4){0.f, 0.f, 0.f, 0.f};
#pragma unroll
                    for (int ks = 0; ks < 2; ++ks) acc = __builtin_amdgcn_mfma_f32_16x16x32_bf16(bk[ks], av[mi][ks], acc, 0, 0, 0);
                    u32x2 o; o.x = pk2(acc[0], acc[1]); o.y = pk2(acc[2], acc[3]);
                    { const int vd = 16 * (2 * hw + mi) + fr; *(u32x2*)(DCB + ((size_t)((h * 64 + (vd >> 1)) * NCH + c) << 8) + (vd & 1) * 128 + 16 * nt + fq * 4) = o; }
                }
            }
            if (htid < 128) { float s = 0.f;
#pragma unroll 8
                for (int l = 0; l < 64; ++l) s += bf2f(KT[htid * TP + l]);
                DN[(size_t)(h * NCH + c) * 128 + htid] = s; }
        }
        __syncthreads();
    }
    bf16* MIX = (bf16*)(ws + WS_MIX);
    for (int rb = blockIdx.x; rb < S / 64; rb += G) {
        const int cg8 = tid & 63, rg = tid >> 6, ch0 = cg8 * 8, gi = ch0 >> 7, win = 2 << gi, tq = rb * 64 + rg * 8;
        const bf16* up = PROJ + 2048 + ch0;
        u32x4 slot[23];
#pragma unroll
        for (int s = 0; s < 23; ++s) { const int row = tq - 15 + s; slot[s] = (s + win >= 16 && row >= 0) ? *(const u32x4*)(up + (size_t)row * NPROJ) : (u32x4){0u, 0u, 0u, 0u}; }
        float sum[8];
#pragma unroll
        for (int e = 0; e < 8; ++e) sum[e] = 0.f;
#pragma unroll
        for (int s = 0; s < 15; ++s) { float xv[8]; unpack8(slot[s], xv); const bool in = (s + win > 15);
#pragma unroll
            for (int e = 0; e < 8; ++e) sum[e] += in ? xv[e] : 0.f; }
#pragma unroll
        for (int i = 0; i < 8; ++i) {
            float ut[8]; unpack8(slot[15 + i], ut);
#pragma unroll
            for (int e = 0; e < 8; ++e) sum[e] += ut[e];
            const int t = tq + i; const float inv = 1.0f / (float)((t + 1) < win ? (t + 1) : win);
            float o[8];
#pragma unroll
            for (int e = 0; e < 8; ++e) o[e] = sum[e] * inv - ut[e];
            *(u32x4*)(MIX + (size_t)t * DM + 512 + ch0) = pack8(o);
            if (i < 7) {
                u32x4 d;
#pragma unroll
                for (int q = 0; q < 4; ++q) d[q] = gi == 0 ? slot[14 + i][q] : gi == 1 ? slot[12 + i][q] : gi == 2 ? slot[8 + i][q] : slot[i][q];
                float dv[8]; unpack8(d, dv);
#pragma unroll
                for (int e = 0; e < 8; ++e) sum[e] -= dv[e];
            }
        }
    }
}

__device__ __forceinline__ void m2_phase(const Params& p, unsigned char* ldsg, int G) {
    const int tid = threadIdx.x, lane = tid & 63, wave = __builtin_amdgcn_readfirstlane(tid >> 6);
    unsigned char* ws = p.ws;
    bf16* DCB = (bf16*)p.out; float* DN = (float*)(ws + WS_DN); const float* GARR = (const float*)(ws + WS_SC); const float* AMAXARR = GARR + 1024; float* MPREV = (float*)(ws + WS_SC) + 2048;
    float* sA = (float*)ldsg; float* sB = sA + 256; float* sAseg = sA + 512; float* sTot = sA + 1024;
    for (int it = blockIdx.x; it < 256; it += G) {
        const int h = it >> 6, slice = it & 63, c0 = 32 * wave;
        u32x2 x[32];
        char* ub = (char*)DCB + (((size_t)((h * 64 + slice) * NCH + c0) << 8) * 2);
        const unsigned loff = (unsigned)lane * 8u;
#pragma unroll
        for (int i = 0; i < 32; ++i) x[i] = *(const u32x2*)(ub + (size_t)i * 512 + loff);
        if (wave == 0) {
            const f32x4 g4 = *(const f32x4*)(GARR + h * NCH + 4 * lane), a4 = *(const f32x4*)(AMAXARR + h * NCH + 4 * lane);
            const float tot = (g4[0] + g4[1]) + (g4[2] + g4[3]);
            const float inc = wave_incl_sum(tot, lane); const float pbase = inc - tot;
            float P[5]; P[0] = pbase; P[1] = P[0] + g4[0]; P[2] = P[1] + g4[1]; P[3] = P[2] + g4[2]; P[4] = P[3] + g4[3];
            float z[4];
#pragma unroll
            for (int i = 0; i < 4; ++i) z[i] = a4[i] - P[i + 1];
            const float zl = fmaxf(fmaxf(z[0], z[1]), fmaxf(z[2], z[3]));
            const float zi = wave_incl_max(zl, lane); float zprev = __shfl_up(zi, 1); if (lane == 0) zprev = 0.f; zprev = fmaxf(zprev, 0.f);
            float Z = zprev;
#pragma unroll
            for (int i = 0; i < 4; ++i) {
                const float m = P[i] + Z; const float Zn = fmaxf(Z, z[i]); const float mn = P[i + 1] + Zn;
                sA[4 * lane + i] = expf(g4[i] + m - mn); sB[4 * lane + i] = expf(a4[i] - mn);
                if (slice == 0) MPREV[h * NCH + 4 * lane + i] = m;
                Z = Zn;
            }
        }
        __syncthreads();
        {
            float l0 = 0.f, l1 = 0.f, l2 = 0.f, l3 = 0.f, ap = 1.f;
#pragma unroll
            for (int i = 0; i < 32; ++i) { const float a = sA[c0 + i], b = sB[c0 + i];
                l0 = a * l0 + b * __uint_as_float(x[i].x << 16); l1 = a * l1 + b * __uint_as_float(x[i].x & 0xffff0000u);
                l2 = a * l2 + b * __uint_as_float(x[i].y << 16); l3 = a * l3 + b * __uint_as_float(x[i].y & 0xffff0000u); ap *= a; }
            *(f32x4*)(sTot + wave * 256 + lane * 4) = (f32x4){l0, l1, l2, l3};
            if (lane == 0) sAseg[wave] = ap;
        }
        __syncthreads();
        {
            float l0 = 0.f, l1 = 0.f, l2 = 0.f, l3 = 0.f;
            for (int j = 0; j < wave; ++j) { const float a = sAseg[j]; const f32x4 tv = *(const f32x4*)(sTot + j * 256 + lane * 4);
                l0 = a * l0 + tv[0]; l1 = a * l1 + tv[1]; l2 = a * l2 + tv[2]; l3 = a * l3 + tv[3]; }
#pragma unroll
            for (int i = 0; i < 32; ++i) { const float a = sA[c0 + i], b = sB[c0 + i];
                u32x2 o; o.x = pk2(l0, l1); o.y = pk2(l2, l3); *(u32x2*)(ub + (size_t)i * 512 + loff) = o;
                l0 = a * l0 + b * __uint_as_float(x[i].x << 16); l1 = a * l1 + b * __uint_as_float(x[i].x & 0xffff0000u);
                l2 = a * l2 + b * __uint_as_float(x[i].y << 16); l3 = a * l3 + b * __uint_as_float(x[i].y & 0xffff0000u); }
        }
        if (slice == 0) {
            __syncthreads();
            typedef float f32x2 __attribute__((ext_vector_type(2)));
            char* nb = (char*)DN + ((size_t)(h * NCH + c0) * 128) * 4;
            f32x2 y[32];
#pragma unroll
            for (int i = 0; i < 32; ++i) y[i] = *(const f32x2*)(nb + (size_t)i * 512 + loff);
            f32x2 l = (f32x2){0.f, 0.f};
#pragma unroll
            for (int i = 0; i < 32; ++i) l = l * sA[c0 + i] + y[i] * sB[c0 + i];
            *(f32x2*)(sTot + wave * 256 + lane * 2) = l;
            __syncthreads();
            l = (f32x2){0.f, 0.f};
            for (int j = 0; j < wave; ++j) l = l * sAseg[j] + *(const f32x2*)(sTot + j * 256 + lane * 2);
#pragma unroll
            for (int i = 0; i < 32; ++i) { *(f32x2*)(nb + (size_t)i * 512 + loff) = l; l = l * sA[c0 + i] + y[i] * sB[c0 + i]; }
        }
        __syncthreads();
    }
}

__device__ __forceinline__ void m3_phase(const Params& p, unsigned char* ldsg, int G) {
    const int tid = threadIdx.x, lane = tid & 63, wave = __builtin_amdgcn_readfirstlane(tid >> 6), fr = lane & 15, fq = lane >> 4;
    unsigned char* ws = p.ws;
    const bf16* PROJ = (const bf16*)(ws + WS_HB); const float* GATES = (const float*)(ws + WS_GATES); const bf16* QKC = (const bf16*)((const unsigned char*)p.out + 32 * MiB);
    const bf16* CPB = (const bf16*)p.out; const float* DN = (const float*)(ws + WS_DN); const float* MPREV = (const float*)(ws + WS_SC) + 2048;
    bf16* MIX = (bf16*)(ws + WS_MIX);
    bf16* Qs = (bf16*)(ldsg + L_QS); bf16* Ks = (bf16*)(ldsg + L_KS); bf16* VT = (bf16*)(ldsg + L_VT); bf16* CTs = (bf16*)(ldsg + L_CT); bf16* Ps = (bf16*)(ldsg + L_PS); bf16* Os = (bf16*)(ldsg + L_OS);
    float* sU = (float*)(ldsg + L_SM); float* sM = sU + 64; float* sIW = sU + 128; float* sEMT = sU + 192; float* sRS = sU + 256; float* sQN = sU + 320; float* sHS = sU + 384; float* sN = sU + 448;
    for (int u = blockIdx.x; u < NCH * NH; u += G) {
        const int c = u >> 2, h = u & 3, t0 = c * CL;
        {
            const int r = tid >> 4, cgp = tid & 15;
            u32x4 gq[2], gk[2], gv[2], go[2], gc[4];
#pragma unroll
            for (int pass = 0; pass < 2; ++pass) { const size_t t = t0 + r + 32 * pass;
                gq[pass] = *(const u32x4*)(QKC + t * DM + h * HD + cgp * 8); gk[pass] = *(const u32x4*)(QKC + t * DM + 512 + h * HD + cgp * 8);
                gv[pass] = *(const u32x4*)(PROJ + t * NPROJ + 1024 + h * HD + cgp * 8); go[pass] = *(const u32x4*)(PROJ + t * NPROJ + 1536 + h * HD + cgp * 8); }
#pragma unroll
            for (int i = 0; i < 4; ++i) { const int idx = tid + 512 * i; gc[i] = *(const u32x4*)(CPB + ((size_t)((h * 64 + (idx >> 5)) * NCH + c) << 8) + (idx & 31) * 8); }
            if (wave == 0) {
                const float ig = GATES[(size_t)(t0 + lane) * 8 + h], fp = GATES[(size_t)(t0 + lane) * 8 + 4 + h];
                const float b = wave_incl_sum(log_sigmoid_f(fp), lane);
                const float uu = ig - b;
                const float U = wave_incl_max(uu, lane);
                const float mp = MPREV[h * NCH + c];
                const float M = fmaxf(mp, U);
                sU[lane] = uu; sM[lane] = M; sIW[lane] = expf(mp - M); sEMT[lane] = expf(-(b + M)); sRS[lane] = 0.f; sHS[lane] = 0.f;
            } else if (wave == 1) {
                sN[lane] = DN[(size_t)(h * NCH + c) * 128 + lane]; sN[lane + 64] = DN[(size_t)(h * NCH + c) * 128 + 64 + lane];
            }
#pragma unroll
            for (int pass = 0; pass < 2; ++pass) { const int l = r + 32 * pass;
                *(u32x4*)(Qs + l * QP + cgp * 8) = gq[pass]; *(u32x4*)(Ks + l * QP + cgp * 8) = gk[pass]; *(u32x4*)(Os + l * QP + cgp * 8) = go[pass];
#pragma unroll
                for (int e = 0; e < 8; ++e) VT[tsw(cgp * 8 + e, l)] = (bf16)(gv[pass][e >> 1] >> ((e & 1) * 16)); }
#pragma unroll
            for (int i = 0; i < 4; ++i) { const int idx = tid + 512 * i, vd = idx >> 4, kc = (idx & 15) * 8; *(u32x4*)(CTs + vd * QP + kc) = gc[i]; }
        }
        __syncthreads();
        {
            const int l = tid >> 3, part = tid & 7; float s = 0.f;
#pragma unroll
            for (int e = 0; e < 16; ++e) s += bf2f(Qs[l * QP + part * 16 + e]) * sN[part * 16 + e];
            s += __shfl_xor(s, 1); s += __shfl_xor(s, 2); s += __shfl_xor(s, 4);
            if (part == 0) sQN[l] = s;
        }
        const int lt = wave >> 1;
        {
            bf16x8 aq[4];
#pragma unroll
            for (int ks = 0; ks < 4; ++ks) aq[ks] = *(const bf16x8*)(Qs + (16 * lt + fr) * QP + ks * 32 + fq * 8);
            float rs[4] = {0.f, 0.f, 0.f, 0.f};
#pragma unroll
            for (int si = 0; si < 2; ++si) {
                const int st = 2 * (wave & 1) + si;
                f32x4 acc = (f32x4){0.f, 0.f, 0.f, 0.f};
#pragma unroll
                for (int ks = 0; ks < 4; ++ks) { const bf16x8 b = *(const bf16x8*)(Ks + (16 * st + fr) * QP + ks * 32 + fq * 8); acc = __builtin_amdgcn_mfma_f32_16x16x32_bf16(aq[ks], b, acc, 0, 0, 0); }
                const int s = 16 * st + fr; const float us = sU[s];
#pragma unroll
                for (int j = 0; j < 4; ++j) { const int l = 16 * lt + fq * 4 + j; const float val = (s <= l) ? acc[j] * expf(us - sM[l]) : 0.f; Ps[l * TP + s] = (bf16)f2bf(val); rs[j] += val; }
            }
#pragma unroll
            for (int j = 0; j < 4; ++j) { float v = rs[j]; v += __shfl_xor(v, 1); v += __shfl_xor(v, 2); v += __shfl_xor(v, 4); v += __shfl_xor(v, 8); if (fr == 0) atomicAdd(&sRS[16 * lt + fq * 4 + j], v); }
        }
        __syncthreads();
        {
            f32x4 a1[4], a2[4];
#pragma unroll
            for (int n = 0; n < 4; ++n) { a1[n] = (f32x4){0.f, 0.f, 0.f, 0.f}; a2[n] = (f32x4){0.f, 0.f, 0.f, 0.f}; }
#pragma unroll
            for (int ks = 0; ks < 2; ++ks) { const bf16x8 a = *(const bf16x8*)(Ps + (16 * lt + fr) * TP + ks * 32 + fq * 8);
#pragma unroll
                for (int n = 0; n < 4; ++n) { const int nt = 4 * (wave & 1) + n; const bf16x8 b = *(const bf16x8*)(VT + tsw(16 * nt + fr, ks * 32 + fq * 8)); a1[n] = __builtin_amdgcn_mfma_f32_16x16x32_bf16(a, b, a1[n], 0, 0, 0); } }
#pragma unroll
            for (int ks = 0; ks < 4; ++ks) { const bf16x8 a = *(const bf16x8*)(Qs + (16 * lt + fr) * QP + ks * 32 + fq * 8);
#pragma unroll
                for (int n = 0; n < 4; ++n) { const int nt = 4 * (wave & 1) + n; const bf16x8 b = *(const bf16x8*)(CTs + (16 * nt + fr) * QP + ks * 32 + fq * 8); a2[n] = __builtin_amdgcn_mfma_f32_16x16x32_bf16(a, b, a2[n], 0, 0, 0); } }
#pragma unroll
            for (int j = 0; j < 4; ++j) {
                const int l = 16 * lt + fq * 4 + j; const float iw = sIW[l]; const float qn = sRS[l] + iw * sQN[l];
                const float den = fmaxf(fabsf(qn), sEMT[l]); const float inv = 1.0f / den; float hs = 0.f;
#pragma unroll
                for (int n = 0; n < 4; ++n) { const float v = (a1[n][j] + iw * a2[n][j]) * inv; hs += v * v; Ks[l * QP + 16 * (4 * (wave & 1) + n) + fr] = (bf16)f2bf(v); }
                hs += __shfl_xor(hs, 1); hs += __shfl_xor(hs, 2); hs += __shfl_xor(hs, 4); hs += __shfl_xor(hs, 8);
                if (fr == 0) atomicAdd(&sHS[l], hs);
            }
        }
        __syncthreads();
        {
            const int r = tid >> 4, cgp = tid & 15;
            const f32x4 n0 = *(const f32x4*)(p.mhn + h * HD + cgp * 8), n1 = *(const f32x4*)(p.mhn + h * HD + cgp * 8 + 4);
            const float nn[8] = {n0[0], n0[1], n0[2], n0[3], n1[0], n1[1], n1[2], n1[3]};
#pragma unroll
            for (int pass = 0; pass < 2; ++pass) { const int l = r + 32 * pass; const float rinv = 1.0f / sqrtf(sHS[l] * (1.0f / 128.0f) + EPS);
                float hv[8], ov[8], o[8]; unpack8(*(const u32x4*)(Ks + l * QP + cgp * 8), hv); unpack8(*(const u32x4*)(Os + l * QP + cgp * 8), ov);
#pragma unroll
                for (int e = 0; e < 8; ++e) o[e] = hv[e] * rinv * nn[e] * __builtin_amdgcn_rcpf(1.0f + __expf(-ov[e]));
                *(u32x4*)(MIX + (size_t)(t0 + l) * DM + h * HD + cgp * 8) = pack8(o); }
        }
        __syncthreads();
    }
}

#define XB_TMO      128
#define XB_XCNT(j)  (256  + 64 * (j))
#define XB_XSUB(j)  (1280 + 64 * (j))
#define XB_XGEN(j)  (2304 + 64 * (j))
#define XB_TOP      3328
#define XB_TOPGEN   3392
#define XCD_BAR_WORDS 3456
#define XB_SPIN_CAP (1u << 18)
__device__ __forceinline__ unsigned xb_ld(unsigned* p)              { return __hip_atomic_load(p, __ATOMIC_RELAXED, __HIP_MEMORY_SCOPE_AGENT); }
__device__ __forceinline__ unsigned xb_add(unsigned* p, unsigned v) { return __hip_atomic_fetch_add(p, v, __ATOMIC_RELAXED, __HIP_MEMORY_SCOPE_AGENT); }
__device__ __forceinline__ unsigned xb_xcc_id() { return (unsigned)__builtin_amdgcn_s_getreg((3 << 11) | 20) & 0xFu; }
#define XB_SPIN(cond, bar) do { unsigned _sp = 0; while (cond) { __builtin_amdgcn_s_sleep(1); \
    if ((++_sp & 255u) == 0u) { if (xb_ld(&(bar)[XB_TMO])) break; if (_sp > XB_SPIN_CAP) { atomicAdd(&(bar)[XB_TMO], 1u); break; } } } } while (0)
struct XcdBarrier { unsigned* bar; unsigned x; volatile LAS unsigned* st; };
__device__ __forceinline__ XcdBarrier xcd_barrier_post(unsigned* bar, volatile LAS unsigned* st) {
    XcdBarrier b; b.bar = bar; b.x = xb_xcc_id(); b.st = st;
    if (threadIdx.x == 0) (void)xb_add(&bar[XB_XCNT(b.x)], 1u);
    return b;
}
__device__ __forceinline__ void xcd_barrier_complete(unsigned* bar, unsigned x, unsigned& nloc, unsigned& nx) {
    const unsigned G = gridDim.x * gridDim.y * gridDim.z;
    unsigned sum, cnt, mine, sp = 0u;
    for (;;) {
        sum = 0u; cnt = 0u; mine = 0u;
#pragma unroll
        for (unsigned j = 0; j < 16; ++j) { const unsigned c = xb_ld(&bar[XB_XCNT(j)]); sum += c; cnt += (c > 0u) ? 1u : 0u; mine = (j == x) ? c : mine; }
        if (sum == G) break;
        __builtin_amdgcn_s_sleep(1);
        if ((++sp & 255u) == 0u) { if (xb_ld(&bar[XB_TMO])) break; if (sp > XB_SPIN_CAP) { atomicAdd(&bar[XB_TMO], 1u); break; } }
    }
    nloc = mine > 0u ? mine : 1u; nx = cnt > 0u ? cnt : 1u;
}
__device__ __forceinline__ void xcd_barrier(const XcdBarrier& b) {
    asm volatile("s_waitcnt vmcnt(0)" ::: "memory");
    __syncthreads();
    if (threadIdx.x == 0) {
        unsigned* bar = b.bar;
        __builtin_amdgcn_s_waitcnt(0);
        unsigned nloc = b.st[0], nx = b.st[1];
        if (nloc == 0u) { xcd_barrier_complete(bar, b.x, nloc, nx); b.st[0] = nloc; b.st[1] = nx; }
        const unsigned old = xb_add(&bar[XB_XSUB(b.x)], 1u);
        const unsigned gen = old / nloc;
        if (old + 1u == (gen + 1u) * nloc) {
            __builtin_amdgcn_fence(__ATOMIC_RELEASE, "agent");
            asm volatile("s_waitcnt vmcnt(0)" ::: "memory");
            const unsigned og = xb_add(&bar[XB_TOP], 1u);
            const unsigned tg = og / nx;
            if (og + 1u == (tg + 1u) * nx) xb_add(&bar[XB_TOPGEN], 1u);
            else XB_SPIN(xb_ld(&bar[XB_TOPGEN]) == tg, bar);
            __builtin_amdgcn_fence(__ATOMIC_ACQUIRE, "agent");
            xb_add(&bar[XB_XGEN(b.x)], 1u);
            asm volatile("s_waitcnt vmcnt(0)" ::: "memory");
        } else {
            XB_SPIN(xb_ld(&bar[XB_XGEN(b.x)]) == gen, bar);
            __builtin_amdgcn_fence(__ATOMIC_ACQUIRE, "agent");
            asm volatile("s_waitcnt vmcnt(0)" ::: "memory");
        }
    }
    __syncthreads();
}

__device__ __forceinline__ int fill_rtab(const pg8::StaticOrder& so, const float* ss, LAS float* rtab) {
    pg8::Unit u0; int pm0 = -1;
    if (so.next(0, u0)) { pm0 = u0.pm; if (threadIdx.x < 256) rtab[threadIdx.x] = pg8::row_rstd(ss, pm0 * 256 + (int)threadIdx.x); }
    __syncthreads();
    return pm0;
}
__global__ void __launch_bounds__(512, 2) fwd_megakernel(Params p) {
    extern __shared__ __attribute__((aligned(16))) unsigned char lds[];
    cg::grid_group grid = cg::this_grid();
    LAS unsigned char* ldsl = (LAS unsigned char*)lds;
    const int G = gridDim.x;
    unsigned char* ws = p.ws;
    bf16* XB = (bf16*)(ws + WS_XB); bf16* HB = (bf16*)(ws + WS_HB); bf16* MIX = (bf16*)(ws + WS_MIX);
    float* SS0 = (float*)(ws + WS_SS0); float* SS1 = (float*)(ws + WS_SS1); float* SS2 = (float*)(ws + WS_SS2); float* SS3 = (float*)(ws + WS_SS3);

    unsigned* barw = (unsigned*)(ws + WS_BAR);
    LAS float* rtab = (LAS float*)(ldsl + LDS_RTAB);
    volatile LAS unsigned* bst = (volatile LAS unsigned*)(ldsl + 131072);
    if (threadIdx.x < 2) bst[threadIdx.x] = 0u;
    if (p.ws == nullptr) grid.sync();
    {
        unsigned* flag = barw + 16384 - 64;
        constexpr unsigned MAGIC = 0x600DF1A6u;
        if (blockIdx.x == 0) {
            for (int i = threadIdx.x; i < 16384 - 64; i += 512) barw[i] = 0u;
            __threadfence(); __syncthreads();
            if (threadIdx.x == 0) { asm volatile("s_waitcnt vmcnt(0)" ::: "memory"); __hip_atomic_store(flag, MAGIC, __ATOMIC_RELEASE, __HIP_MEMORY_SCOPE_AGENT); }
        } else if (threadIdx.x == 0) {
            unsigned sp = 0; while (__hip_atomic_load(flag, __ATOMIC_RELAXED, __HIP_MEMORY_SCOPE_AGENT) != MAGIC) { __builtin_amdgcn_s_sleep(1); if (++sp > (1u << 22)) break; }
            __builtin_amdgcn_fence(__ATOMIC_ACQUIRE, "agent");
        }
        __syncthreads();
    }
    const XcdBarrier xb = xcd_barrier_post(barw, bst);
#define GSYNC() xcd_barrier(xb)
    p0_prologue(p, ldsl, G);
    GSYNC();
    if (blockIdx.x == 0 && threadIdx.x == 0) __hip_atomic_store(barw + 16384 - 64, 0u, __ATOMIC_RELAXED, __HIP_MEMORY_SCOPE_AGENT);
    { pg8::Gemm g{XB, (const bf16*)(ws + WS_WGU1), S, 2 * DFF, DM}; pg8::StaticOrder so; so.init(S, 2 * DFF, G, (int)blockIdx.x);
      const int pm0 = fill_rtab(so, SS0, rtab); pg8::EpiSwiGLU E{HB, DFF, SS0, rtab, pm0}; pg8::gemm_phase<pg8::EpiSwiGLU, pg8::StaticOrder, true, true>(ldsl, g, so, E); }
    { int sgw, sng; if (slack_rank((S / 256) * (2 * DFF / 256), G, sgw, sng)) { LAS float* scr = (LAS float*)(ldsl + (threadIdx.x >> 6) * 8448); const int lane = threadIdx.x & 63;
        cvt_down(p, 0, scr, lane, sgw, sng); cvt_in(p, scr, lane, sgw, sng); cvt_out(p, scr, lane, sgw, sng); } }
    GSYNC();
    { pg8::Gemm g{HB, (const bf16*)(ws + WS_WD1), S, DM, DFF}; pg8::StaticOrder so; so.init(S, DM, G, (int)blockIdx.x);
      pg8::EpiResid<true> E{nullptr, XB, SS1, 0.5f}; pg8::gemm_phase<pg8::EpiResid<true>, pg8::StaticOrder, true, true>(ldsl, g, so, E); }
    GSYNC();
    { pg8::Gemm g{XB, (const bf16*)(ws + WS_WIN), S, NPROJ, DM}; pg8::StaticOrder so; so.init(S, NPROJ, G, (int)blockIdx.x);
      const int pm0 = fill_rtab(so, SS1, rtab); pg8::EpiProj E{HB, NPROJ, SS1, (float*)(ws + WS_GATES), p.bg, 10, rtab, pm0}; pg8::gemm_phase<pg8::EpiProj, pg8::StaticOrder, true, true>(ldsl, g, so, E); }
    { int sgw, sng; if (slack_rank((S / 256) * (NPROJ / 256), G, sgw, sng)) { LAS float* scr = (LAS float*)(ldsl + (threadIdx.x >> 6) * 8448); cvt_gu(p, 1, scr, threadIdx.x & 63, sgw, sng); } }
    GSYNC();
    m1_phase(p, lds, G);
    GSYNC();
    m2_phase(p, lds, G);
    GSYNC();
    m3_phase(p, lds, G);
    GSYNC();
    { pg8::Gemm g{MIX, (const bf16*)(ws + WS_WOUT), S, DM, DM}; pg8::StaticOrder so; so.init(S, DM, G, (int)blockIdx.x);
      pg8::EpiResid<true> E{nullptr, XB, SS2, 1.0f}; pg8::gemm_phase<pg8::EpiResid<true>, pg8::StaticOrder, true, true>(ldsl, g, so, E); }
    GSYNC();
    { pg8::Gemm g{XB, (const bf16*)(ws + WS_WGU2), S, 2 * DFF, DM}; pg8::StaticOrder so; so.init(S, 2 * DFF, G, (int)blockIdx.x);
      const int pm0 = fill_rtab(so, SS2, rtab); pg8::EpiSwiGLU E{HB, DFF, SS2, rtab, pm0}; pg8::gemm_phase<pg8::EpiSwiGLU, pg8::StaticOrder, true, true>(ldsl, g, so, E); }
    { int sgw, sng; if (slack_rank((S / 256) * (2 * DFF / 256), G, sgw, sng)) cvt_down(p, 1, (LAS float*)(ldsl + (threadIdx.x >> 6) * 8448), threadIdx.x & 63, sgw, sng); }
    GSYNC();
    { pg8::Gemm g{HB, (const bf16*)(ws + WS_WD2), S, DM, DFF}; pg8::StaticOrder so; so.init(S, DM, G, (int)blockIdx.x);
      pg8::EpiFinal E{XB, p.out, SS3, (unsigned*)(ws + WS_PCNT), p.nf, 0.5f}; pg8::gemm_phase<pg8::EpiFinal, pg8::StaticOrder, true, true>(ldsl, g, so, E); }
}

extern "C" void kernel_launch(void* const* d_in, const int* in_sizes, int n_in, void* d_out, int out_size, void* d_ws, size_t ws_size, hipStream_t stream) {
    static int grid_blocks = 0;
    if (grid_blocks == 0) {
        if (n_in != 19 || out_size != S * DM || ws_size < WS_END) { fprintf(stderr, "kernel_launch: unexpected problem (n_in %d, out %d, ws %zu)\n", n_in, out_size, ws_size); grid_blocks = -1; return; }
        int dev = 0, cus = 0, per_cu = 0;
        (void)hipGetDevice(&dev);
        (void)hipDeviceGetAttribute(&cus, hipDeviceAttributeMultiprocessorCount, dev);
        if (hipFuncSetAttribute((const void*)fwd_megakernel, hipFuncAttributeMaxDynamicSharedMemorySize, LDS_BYTES) != hipSuccess) { fprintf(stderr, "kernel_launch: hipFuncSetAttribute failed\n"); grid_blocks = -1; return; }
        if (hipOccupancyMaxActiveBlocksPerMultiprocessor(&per_cu, (const void*)fwd_megakernel, 512, LDS_BYTES) != hipSuccess || per_cu < 1) { fprintf(stderr, "kernel_launch: occupancy query gave %d\n", per_cu); per_cu = 1; }
        (void)hipGetLastError();
        grid_blocks = cus * 1;
        if (grid_blocks <= 0) grid_blocks = 256;
    }
    if (grid_blocks < 0) return;
    Params p{};
    p.x = (const float*)d_in[0]; p.n1 = (const float*)d_in[1]; p.wg1 = (const float*)d_in[2]; p.wu1 = (const float*)d_in[3]; p.wd1 = (const float*)d_in[4];
    p.nmix = (const float*)d_in[5]; p.win = (const float*)d_in[6]; p.bg = (const float*)d_in[7]; p.convw = (const float*)d_in[8]; p.convb = (const float*)d_in[9]; p.mhn = (const float*)d_in[10];
    p.poolw = (const float*)d_in[11]; p.pools = (const float*)d_in[12]; p.wout = (const float*)d_in[13]; p.n2 = (const float*)d_in[14]; p.wg2 = (const float*)d_in[15]; p.wu2 = (const float*)d_in[16]; p.wd2 = (const float*)d_in[17]; p.nf = (const float*)d_in[18];
    p.out = (float*)d_out; p.ws = (unsigned char*)d_ws;
    void* args[] = {&p};
    hipError_t e = hipLaunchCooperativeKernel((const void*)fwd_megakernel, dim3(grid_blocks), dim3(512), args, LDS_BYTES, stream);
    if (e != hipSuccess) fprintf(stderr, "cooperative launch failed: %s (grid %d)\n", hipGetErrorString(e), grid_blocks);
}
```

```cpp
#include <hip/hip_runtime.h>
#include <hip/hip_cooperative_groups.h>
#include <cstdio>
#include <cstdint>
namespace cg = cooperative_groups;

#define LAS __attribute__((address_space(3)))
typedef unsigned short bf16;
typedef short bf16x8 __attribute__((ext_vector_type(8)));
typedef float f32x4 __attribute__((ext_vector_type(4)));
typedef unsigned u32x4 __attribute__((ext_vector_type(4)));
typedef unsigned u32x2 __attribute__((ext_vector_type(2)));

constexpr int S = 16384, DM = 1024, DFF = 2816, NPROJ = 2816  , DINP = 2568;
constexpr int NCH = 256, CL = 64, NH = 4, HD = 128;
constexpr float EPS = 1e-6f;

constexpr size_t MiB = 1u << 20;
constexpr size_t WS_SS0 = 0 * MiB, WS_SS1 = 1 * MiB, WS_SS2 = 2 * MiB, WS_SS3 = 3 * MiB;
constexpr size_t WS_GATES = 4 * MiB;
constexpr size_t WS_DN = 4 * MiB + 512 * 1024;
constexpr size_t WS_BAR = 5 * MiB + 512 * 1024;
constexpr size_t WS_PCNT = WS_BAR + 16384;
constexpr size_t WS_SC = 5 * MiB;
constexpr size_t WS_WGU1 = 6 * MiB;
constexpr size_t WS_WD1 = 17 * MiB;
constexpr size_t WS_WGU2 = 23 * MiB;
constexpr size_t WS_WD2 = 34 * MiB;
constexpr size_t WS_WIN = 40 * MiB;
constexpr size_t WS_WOUT = 46 * MiB;
constexpr size_t WS_HB = 48 * MiB;
constexpr size_t WS_MIX = 136 * MiB;
constexpr size_t WS_XB = 168 * MiB;
constexpr size_t WS_END = 200 * MiB;

constexpr int LDS_RTAB = 131072 + 256;
constexpr int LDS_BYTES = 131072 + 256 + 1024;

namespace pg8 {
#define PG8_LAS __attribute__((address_space(3)))
typedef unsigned short bf16_t;
constexpr int BM = 256, BK = 64, HALF = 128, HTB = HALF * BK * 2, STAGE_BYTES = 8 * HTB, NXCD = 8, WGM = 8;

__host__ __device__ __forceinline__ int lds_byte(int r, int c) { const int st = (r >> 4) * 2 + (c >> 5), rr = r & 15, cc = c & 31, ob = rr * 64 + cc * 2; return st * 1024 + (ob ^ (((ob >> 9) & 1) << 5)); }
__host__ __device__ __forceinline__ void stage_rc(int b, int& R, int& C) { const int st = b / 1024, sb = b % 1024, swz = sb ^ (((sb >> 9) & 1) << 5); R = (st >> 1) * 16 + swz / 64; C = (st & 1) * 32 + (swz % 64) / 2; }
__host__ __device__ __forceinline__ int perm32(int rho) { const int n = rho >> 4, i = rho & 15; return 8 * (i >> 2) + 4 * n + (i & 3); }

struct Unit { int pm, pn; };
struct Gemm { const bf16_t* A; const bf16_t* Bt; int M, N, K; };

struct StaticOrder {
    int nM, nN, nwg, G, c;
    __host__ __device__ void init(int M, int N, int G_, int c_) { nM = M / BM; nN = N / BM; nwg = nM * nN; G = G_; c = c_; }
    __host__ __device__ bool next(int i, Unit& u) const {
        const long L = (long)i * G + c; if (L >= nwg) return false;
        int wgid = (int)L; { const int q = nwg / NXCD, r = nwg % NXCD, xcd = wgid % NXCD, off = wgid / NXCD; wgid = (xcd < r ? xcd * (q + 1) : r * (q + 1) + (xcd - r) * q) + off; }
        const int nig = WGM * nN, gid = wgid / nig, fm = gid * WGM, gsz = (nM - fm) < WGM ? (nM - fm) : WGM;
        u.pm = fm + ((wgid % nig) % gsz); u.pn = (wgid % nig) / gsz; return true;
    }
    __device__ __forceinline__ void a_ready(const Unit&) const {}
    __device__ __forceinline__ void done(const Unit&) const {}
};

__device__ __forceinline__ unsigned cvt_pk_bf16(float lo, float hi) { unsigned r; asm volatile("v_cvt_pk_bf16_f32 %0, %1, %2" : "=v"(r) : "v"(lo), "v"(hi)); return r; }

__device__ __forceinline__ float row_rstd(const float* ss, int row) {
    const f32x4* p = (const f32x4*)(ss + (size_t)row * 16);
    const f32x4 a = p[0], b = p[1], c = p[2], d = p[3];
    const float s = (((a[0] + a[1]) + (a[2] + a[3])) + ((b[0] + b[1]) + (b[2] + b[3]))) + (((c[0] + c[1]) + (c[2] + c[3])) + ((d[0] + d[1]) + (d[2] + d[3])));
    return 1.0f / sqrtf(s * (1.0f / 1024.0f) + 1e-6f);
}
__device__ __forceinline__ float silu_f(float g) { return g * __builtin_amdgcn_rcpf(1.0f + __expf(-g)); }
typedef float f32x2 __attribute__((ext_vector_type(2)));
__device__ __forceinline__ f32x2 swiglu_pk(f32x2 g, f32x2 u, float c, float r2) {
    const f32x2 t = g * c;
    f32x2 e; e.x = __builtin_amdgcn_exp2f(t.x); e.y = __builtin_amdgcn_exp2f(t.y);
    const f32x2 d = e + 1.0f;
    f32x2 s; s.x = __builtin_amdgcn_rcpf(d.x); s.y = __builtin_amdgcn_rcpf(d.y);
    return (g * u) * (s * r2);
}

struct EpiSwiGLU {
    static constexpr bool PERM = true, AFTER_DRAIN = false;
    bf16_t* H; int ldh; const float* ss; const PG8_LAS float* rtab; int rt_pm;
    __device__ __forceinline__ void operator()(const f32x4 (&acc)[2][2][4][2], const Unit& u, int wr, int wc, int fr, int fq) const {
        const int row0 = u.pm * BM + wr * 64 + fr, col0 = u.pn * HALF + wc * 32 + 8 * fq; const bool tab = (u.pm == rt_pm);
#pragma unroll
        for (int ai = 0; ai < 2; ++ai)
#pragma unroll
            for (int m = 0; m < 4; ++m) {
                const int row = row0 + ai * HALF + m * 16; const float r = tab ? rtab[row - u.pm * BM] : row_rstd(ss, row);
                const float c = r * -1.4426950408889634f, r2 = r * r;
                const f32x4 G0 = acc[ai][0][m][0], G1 = acc[ai][0][m][1], U0 = acc[ai][1][m][0], U1 = acc[ai][1][m][1];
                const f32x2 h0 = swiglu_pk((f32x2){G0[0], G0[1]}, (f32x2){U0[0], U0[1]}, c, r2), h1 = swiglu_pk((f32x2){G0[2], G0[3]}, (f32x2){U0[2], U0[3]}, c, r2);
                const f32x2 h2 = swiglu_pk((f32x2){G1[0], G1[1]}, (f32x2){U1[0], U1[1]}, c, r2), h3 = swiglu_pk((f32x2){G1[2], G1[3]}, (f32x2){U1[2], U1[3]}, c, r2);
                u32x4 w;
                w.x = cvt_pk_bf16(h0.x, h0.y); w.y = cvt_pk_bf16(h1.x, h1.y); w.z = cvt_pk_bf16(h2.x, h2.y); w.w = cvt_pk_bf16(h3.x, h3.y);
                *(u32x4*)(H + (size_t)row * ldh + col0) = w;
            }
    }
};
struct EpiProj {
    static constexpr bool PERM = true, AFTER_DRAIN = false;
    bf16_t* P; int ldp; const float* ss; float* gates; const float* bg; int gate_tile; const PG8_LAS float* rtab; int rt_pm;
    __device__ __forceinline__ void operator()(const f32x4 (&acc)[2][2][4][2], const Unit& u, int wr, int wc, int fr, int fq) const {
        const int row0 = u.pm * BM + wr * 64 + fr, col0 = u.pn * BM + wc * 32 + 8 * fq; const bool tab = (u.pm == rt_pm);
        if (u.pn < gate_tile) {
#pragma unroll
            for (int ai = 0; ai < 2; ++ai)
#pragma unroll
                for (int m = 0; m < 4; ++m) {
                    const int row = row0 + ai * HALF + m * 16; const float r = tab ? rtab[row - u.pm * BM] : row_rstd(ss, row);
#pragma unroll
                    for (int bj = 0; bj < 2; ++bj) {
                        const f32x4 v0 = acc[ai][bj][m][0] * r, v1 = acc[ai][bj][m][1] * r;
                        u32x4 w; w.x = cvt_pk_bf16(v0[0], v0[1]); w.y = cvt_pk_bf16(v0[2], v0[3]); w.z = cvt_pk_bf16(v1[0], v1[1]); w.w = cvt_pk_bf16(v1[2], v1[3]);
                        *(u32x4*)(P + (size_t)row * ldp + col0 + bj * HALF) = w;
                    }
                }
        } else if (wc == 0 && fq == 0) {
            const f32x4 b0 = *(const f32x4*)bg, b1 = *(const f32x4*)(bg + 4);
#pragma unroll
            for (int ai = 0; ai < 2; ++ai)
#pragma unroll
                for (int m = 0; m < 4; ++m) {
                    const int row = row0 + ai * HALF + m * 16; const float r = tab ? rtab[row - u.pm * BM] : row_rstd(ss, row);
                    *(f32x4*)(gates + (size_t)row * 8) = acc[ai][0][m][0] * r + b0;
                    *(f32x4*)(gates + (size_t)row * 8 + 4) = acc[ai][0][m][1] * r + b1;
                }
        }
    }
};
__device__ __forceinline__ void bf8_to_f32(const u32x4 v, f32x4& lo, f32x4& hi) {
    lo = (f32x4){__uint_as_float(v.x << 16), __uint_as_float(v.x & 0xffff0000u), __uint_as_float(v.y << 16), __uint_as_float(v.y & 0xffff0000u)};
    hi = (f32x4){__uint_as_float(v.z << 16), __uint_as_float(v.z & 0xffff0000u), __uint_as_float(v.w << 16), __uint_as_float(v.w & 0xffff0000u)};
}
template <bool XI_BF16> struct EpiResid {
    static constexpr bool PERM = true, AFTER_DRAIN = false;
    const float* xi; bf16_t* xb; float* ssout; float scale;
    __device__ __forceinline__ void operator()(const f32x4 (&acc)[2][2][4][2], const Unit& u, int wr, int wc, int fr, int fq) const {
        const int row0 = u.pm * BM + wr * 64 + fr, col0 = u.pn * BM + wc * 32 + 8 * fq;
#pragma unroll
        for (int ai = 0; ai < 2; ++ai) {
        u32x4 xin[1][4][2];
        if (XI_BF16) {
#pragma unroll
                for (int m = 0; m < 4; ++m)
#pragma unroll
                    for (int bj = 0; bj < 2; ++bj) xin[0][m][bj] = *(const u32x4*)(xb + (size_t)(row0 + ai * HALF + m * 16) * DM + col0 + bj * HALF);
        }
#pragma unroll
            for (int m = 0; m < 4; ++m) {
                const int row = row0 + ai * HALF + m * 16; const size_t off = (size_t)row * DM + col0; float q = 0.f;
#pragma unroll
                for (int bj = 0; bj < 2; ++bj) {
                    const size_t o2 = off + bj * HALF; f32x4 b0, b1;
                    if (XI_BF16) bf8_to_f32(xin[0][m][bj], b0, b1); else { b0 = *(const f32x4*)(xi + o2); b1 = *(const f32x4*)(xi + o2 + 4); }
                    const f32x4 o0 = b0 + acc[ai][bj][m][0] * scale, o1 = b1 + acc[ai][bj][m][1] * scale;
                    u32x4 w; w.x = cvt_pk_bf16(o0[0], o0[1]); w.y = cvt_pk_bf16(o0[2], o0[3]); w.z = cvt_pk_bf16(o1[0], o1[1]); w.w = cvt_pk_bf16(o1[2], o1[3]);
                    *(u32x4*)(xb + o2) = w;
                    q += ((o0[0] * o0[0] + o0[1] * o0[1]) + (o0[2] * o0[2] + o0[3] * o0[3])) + ((o1[0] * o1[0] + o1[1] * o1[1]) + (o1[2] * o1[2] + o1[3] * o1[3]));
                }
                q += __shfl_xor(q, 16); q += __shfl_xor(q, 32);
                if (fq == 0) ssout[(size_t)row * 16 + u.pn * 4 + wc] = q;
                if (!XI_BF16) asm volatile("" ::: "memory");
            }
            asm volatile("" ::: "memory");
        }
    }
};
struct EpiFinal {
    static constexpr bool PERM = true, AFTER_DRAIN = false;
    const bf16_t* xb; float* out; float* ss; unsigned* cnt; const float* gf; float scale;
    __device__ __forceinline__ void operator()(f32x4 (&acc)[2][2][4][2], const Unit& u, int wr, int wc, int fr, int fq) const {
        const int row0 = u.pm * BM + wr * 64 + fr, col0 = u.pn * BM + wc * 32 + 8 * fq;
#pragma unroll
        for (int ai = 0; ai < 2; ++ai) {
        u32x4 xin[4][2];
#pragma unroll
            for (int m = 0; m < 4; ++m)
#pragma unroll
                for (int bj = 0; bj < 2; ++bj) xin[m][bj] = *(const u32x4*)(xb + (size_t)(row0 + ai * HALF + m * 16) * DM + col0 + bj * HALF);
#pragma unroll
            for (int m = 0; m < 4; ++m) {
                const int row = row0 + ai * HALF + m * 16; float q = 0.f;
#pragma unroll
                for (int bj = 0; bj < 2; ++bj) {
                    f32x4 b0, b1; bf8_to_f32(xin[m][bj], b0, b1);
                    const f32x4 o0 = b0 + acc[ai][bj][m][0] * scale, o1 = b1 + acc[ai][bj][m][1] * scale;
                    acc[ai][bj][m][0] = o0; acc[ai][bj][m][1] = o1;
                    q += ((o0[0] * o0[0] + o0[1] * o0[1]) + (o0[2] * o0[2] + o0[3] * o0[3])) + ((o1[0] * o1[0] + o1[1] * o1[1]) + (o1[2] * o1[2] + o1[3] * o1[3]));
                }
                q += __shfl_xor(q, 16); q += __shfl_xor(q, 32);
                if (fq == 0) __hip_atomic_store((unsigned*)(ss + (size_t)row * 16 + u.pn * 4 + wc), __float_as_uint(q), __ATOMIC_RELAXED, __HIP_MEMORY_SCOPE_AGENT);
            }
            asm volatile("" ::: "memory");
        }
        asm volatile("s_waitcnt vmcnt(0)" ::: "memory");
        unsigned* pc = cnt + 64 * u.pm;
        if ((threadIdx.x & 63) == 0) __hip_atomic_fetch_add(pc, 1u, __ATOMIC_RELAXED, __HIP_MEMORY_SCOPE_AGENT);
        { unsigned sp = 0; while ((unsigned)__builtin_amdgcn_readfirstlane(__hip_atomic_load(pc, __ATOMIC_RELAXED, __HIP_MEMORY_SCOPE_AGENT)) < 32u) { __builtin_amdgcn_s_sleep(2); if (++sp > (1u << 20)) break; } }
        __builtin_amdgcn_fence(__ATOMIC_ACQUIRE, "agent");
        f32x4 gv[2][2];
#pragma unroll
        for (int bj = 0; bj < 2; ++bj) { gv[bj][0] = *(const f32x4*)(gf + col0 + bj * HALF); gv[bj][1] = *(const f32x4*)(gf + col0 + bj * HALF + 4); }
        f32x4 ptv[2][4];
#pragma unroll
        for (int ai = 0; ai < 2; ++ai)
#pragma unroll
            for (int m = 0; m < 4; ++m) ptv[ai][m] = *(const f32x4*)(ss + (size_t)(row0 + ai * HALF + m * 16) * 16 + fq * 4);
#pragma unroll
        for (int ai = 0; ai < 2; ++ai)
#pragma unroll
            for (int m = 0; m < 4; ++m) {
                const int row = row0 + ai * HALF + m * 16; const size_t off = (size_t)row * DM + col0;
                const f32x4 pt = ptv[ai][m];
                float s = (pt[0] + pt[1]) + (pt[2] + pt[3]); s += __shfl_xor(s, 16); s += __shfl_xor(s, 32);
                const float r = 1.0f / sqrtf(s * (1.0f / 1024.0f) + 1e-6f);
#pragma unroll
                for (int bj = 0; bj < 2; ++bj) { *(f32x4*)(out + off + bj * HALF) = acc[ai][bj][m][0] * r * gv[bj][0]; *(f32x4*)(out + off + bj * HALF + 4) = acc[ai][bj][m][1] * r * gv[bj][1]; }
            }
    }
};

template <class Epi, class Sched, bool ALIGN_EPI = false, bool SP2 = false>
__device__ __forceinline__ void gemm_phase(PG8_LAS unsigned char* lds, const Gemm g, const Sched& S, const Epi& E) {
    const int tid = threadIdx.x, wid = __builtin_amdgcn_readfirstlane(tid >> 6), lane = tid & 63, wr = wid >> 2, wc = wid & 3, fr = lane & 15, fq = lane >> 4;
    const int K = g.K, nt = K / BK;
    unsigned voffA[2], voffB[2];
#pragma unroll
    for (int i = 0; i < 2; ++i) { int R, C; stage_rc(tid * 16 + i * 8192, R, C); const int Rb = Epi::PERM ? ((R & ~31) + perm32(R & 31)) : R;
        voffA[i] = (unsigned)(R * K + C) * 2u; voffB[i] = (unsigned)(Rb * K + C) * 2u; }
    const size_t kstep = (size_t)(BK * 2);
    const size_t hstep = (size_t)HALF * K * 2;
    const size_t tstep = 2 * hstep;
    const unsigned ldsw = (unsigned)wid * 1024u;
    const int aoff = lds_byte(wr * 64 + fr, fq * 8), boff = lds_byte(wc * 32 + fr, fq * 8);
#define PG8_SA(b, h) (((b) * 2 + (h)) * HTB)
#define PG8_SB(b, h) ((4 + (b) * 2 + (h)) * HTB)
#define PG8_STAGE(bufoff, gbase, voff) do { _Pragma("unroll") for (int _i = 0; _i < 2; ++_i) \
        __builtin_amdgcn_global_load_lds((const unsigned*)((const char*)(gbase) + (voff)[_i]), (PG8_LAS unsigned*)(lds + (bufoff) + ldsw + _i * 8192), 16, 0, 0); } while (0)
#define PG8_LDA(dst, b, h) do { _Pragma("unroll") for (int m = 0; m < 4; ++m) _Pragma("unroll") for (int k = 0; k < 2; ++k) dst[m][k] = *(const PG8_LAS bf16x8*)(lds + PG8_SA(b, h) + aoff + m * 2048 + k * 1024); } while (0)
#define PG8_LDB(dst, b, h) do { _Pragma("unroll") for (int n = 0; n < 2; ++n) _Pragma("unroll") for (int k = 0; k < 2; ++k) dst[n][k] = *(const PG8_LAS bf16x8*)(lds + PG8_SB(b, h) + boff + n * 2048 + k * 1024); } while (0)
#define PG8_MMA(ai, bj, At, Bt) do { __builtin_amdgcn_s_setprio(1); _Pragma("unroll") for (int m = 0; m < 4; ++m) _Pragma("unroll") for (int n = 0; n < 2; ++n) _Pragma("unroll") for (int k = 0; k < 2; ++k) \
        acc[ai][bj][m][n] = __builtin_amdgcn_mfma_f32_16x16x32_bf16(Bt[n][k], At[m][k], acc[ai][bj][m][n], 0, 0, 0); __builtin_amdgcn_s_setprio(0); } while (0)
#define PG8_WAIT_V(n) asm volatile("s_waitcnt vmcnt(" #n ")" ::: "memory")
#define PG8_WAIT_L(n) asm volatile("s_waitcnt lgkmcnt(" #n ")" ::: "memory")
#define PG8_BAR __builtin_amdgcn_s_barrier()
#define PG8_SCHED __builtin_amdgcn_sched_barrier(0)
    Unit cur, nxt; int ui = 0;
    if (!S.next(0, cur)) return;
    f32x4 acc[2][2][4][2];
#pragma unroll
    for (int a = 0; a < 2; ++a)
#pragma unroll
        for (int b = 0; b < 2; ++b)
#pragma unroll
            for (int m = 0; m < 4; ++m)
#pragma unroll
                for (int n = 0; n < 2; ++n) acc[a][b][m][n] = (f32x4){0.f, 0.f, 0.f, 0.f};
    bf16x8 At[4][2], B0[2][2], B1[2][2];
    const char* cA = (const char*)g.A + (size_t)cur.pm * tstep; const char* cB = (const char*)g.Bt + (size_t)cur.pn * tstep;
    S.a_ready(cur);
    if constexpr (SP2) {
        PG8_STAGE(PG8_SB(0, 0), cB, voffB); PG8_STAGE(PG8_SB(0, 1), cB + hstep, voffB); PG8_STAGE(PG8_SA(0, 0), cA, voffA); PG8_STAGE(PG8_SA(0, 1), cA + hstep, voffA);
        if (wr == 1) PG8_BAR;
        PG8_WAIT_V(2); PG8_BAR;
        PG8_STAGE(PG8_SB(1, 0), cB + kstep, voffB); PG8_STAGE(PG8_SA(1, 0), cA + kstep, voffA); PG8_STAGE(PG8_SB(1, 1), cB + hstep + kstep, voffB);
        PG8_WAIT_V(6); PG8_BAR;
    } else {
        PG8_STAGE(PG8_SB(0, 0), cB, voffB); PG8_STAGE(PG8_SA(0, 0), cA, voffA); PG8_STAGE(PG8_SB(0, 1), cB + hstep, voffB); PG8_STAGE(PG8_SA(0, 1), cA + hstep, voffA);
        if (wr == 1) PG8_BAR;
        PG8_WAIT_V(4); PG8_BAR;
        PG8_STAGE(PG8_SB(1, 0), cB + kstep, voffB); PG8_STAGE(PG8_SA(1, 0), cA + kstep, voffA); PG8_STAGE(PG8_SB(1, 1), cB + hstep + kstep, voffB);
        PG8_WAIT_V(6); PG8_BAR;
    }
    for (;;) {
        const bool has_next = S.next(ui + 1, nxt);
        const char* nA = has_next ? (const char*)g.A + (size_t)nxt.pm * tstep : cA; const char* nB = has_next ? (const char*)g.Bt + (size_t)nxt.pn * tstep : cB;
        for (int t = 0; t < nt; t += 2) {
            const bool last = (t == nt - 2);
            const char* a1 = cA + (size_t)(t + 1) * kstep;
            const char* a2 = last ? nA : cA + (size_t)(t + 2) * kstep; const char* b2 = last ? nB : cB + (size_t)(t + 2) * kstep;
            const char* a3 = a2 + kstep; const char* b3 = b2 + kstep;
            if (last && has_next) S.a_ready(nxt);
            if constexpr (SP2) {
            PG8_LDB(B0, 0, 0); PG8_LDB(B1, 0, 1); PG8_SCHED; PG8_LDA(At, 0, 0); PG8_STAGE(PG8_SA(1, 1), a1 + hstep, voffA);
            PG8_WAIT_V(8); PG8_WAIT_L(0); PG8_BAR; PG8_MMA(0, 0, At, B0); PG8_MMA(0, 1, At, B1); PG8_BAR; PG8_SCHED;
            PG8_LDA(At, 0, 1); PG8_STAGE(PG8_SB(0, 0), b2, voffB); PG8_STAGE(PG8_SB(0, 1), b2 + hstep, voffB); PG8_STAGE(PG8_SA(0, 0), a2, voffA);
            PG8_WAIT_V(8); PG8_WAIT_L(0); PG8_BAR; PG8_MMA(1, 0, At, B0); PG8_MMA(1, 1, At, B1); PG8_BAR; PG8_SCHED;
            PG8_LDB(B0, 1, 0); PG8_LDB(B1, 1, 1); PG8_SCHED; PG8_LDA(At, 1, 0); PG8_STAGE(PG8_SA(0, 1), a2 + hstep, voffA);
            PG8_WAIT_V(8); PG8_WAIT_L(0); PG8_BAR; PG8_MMA(0, 0, At, B0); PG8_MMA(0, 1, At, B1); PG8_BAR; PG8_SCHED;
            PG8_LDA(At, 1, 1); PG8_STAGE(PG8_SB(1, 0), b3, voffB); PG8_STAGE(PG8_SB(1, 1), b3 + hstep, voffB); PG8_STAGE(PG8_SA(1, 0), a3, voffA);
            PG8_WAIT_V(8); PG8_WAIT_L(0); PG8_BAR; PG8_MMA(1, 0, At, B0); PG8_MMA(1, 1, At, B1); PG8_BAR; PG8_SCHED;
            } else {
            PG8_LDB(B0, 0, 0); PG8_SCHED; PG8_LDA(At, 0, 0); PG8_STAGE(PG8_SA(1, 1), a1 + hstep, voffA);
            PG8_WAIT_L(8); PG8_BAR; PG8_WAIT_L(0); PG8_MMA(0, 0, At, B0); PG8_BAR; PG8_SCHED;
            PG8_LDB(B1, 0, 1); PG8_STAGE(PG8_SB(0, 0), b2, voffB);
            PG8_BAR; PG8_WAIT_L(0); PG8_MMA(0, 1, At, B1); PG8_BAR;
            PG8_LDA(At, 0, 1); PG8_STAGE(PG8_SA(0, 0), a2, voffA);
            PG8_BAR; PG8_WAIT_L(0); PG8_MMA(1, 0, At, B0); PG8_BAR; PG8_SCHED;
            PG8_STAGE(PG8_SB(0, 1), b2 + hstep, voffB);
            PG8_WAIT_V(6); PG8_BAR; PG8_MMA(1, 1, At, B1); PG8_BAR;
            PG8_LDB(B0, 1, 0); PG8_SCHED; PG8_LDA(At, 1, 0); PG8_STAGE(PG8_SA(0, 1), a2 + hstep, voffA);
            PG8_WAIT_L(8); PG8_BAR; PG8_WAIT_L(0); PG8_MMA(0, 0, At, B0); PG8_BAR; PG8_SCHED;
            PG8_LDB(B1, 1, 1); PG8_STAGE(PG8_SB(1, 0), b3, voffB);
            PG8_BAR; PG8_WAIT_L(0); PG8_MMA(0, 1, At, B1); PG8_BAR;
            PG8_LDA(At, 1, 1); PG8_STAGE(PG8_SA(1, 0), a3, voffA);
            PG8_BAR; PG8_WAIT_L(0); PG8_MMA(1, 0, At, B0); PG8_BAR; PG8_SCHED;
            PG8_STAGE(PG8_SB(1, 1), b3 + hstep, voffB);
            PG8_WAIT_V(6); PG8_BAR; PG8_MMA(1, 1, At, B1); PG8_BAR;
            }
        }
        if constexpr (ALIGN_EPI) { if (wr == 0) PG8_BAR; }
        if constexpr (!Epi::AFTER_DRAIN) { E(acc, cur, wr, wc, fr, fq); S.done(cur); }
        if (!has_next) break;
#pragma unroll
        for (int a = 0; a < 2; ++a)
#pragma unroll
            for (int b = 0; b < 2; ++b)
#pragma unroll
                for (int m = 0; m < 4; ++m)
#pragma unroll
                    for (int n = 0; n < 2; ++n) acc[a][b][m][n] = (f32x4){0.f, 0.f, 0.f, 0.f};
        cur = nxt; cA = nA; cB = nB; ++ui;
        if constexpr (ALIGN_EPI) { if (wr == 1) PG8_BAR; }
    }
    PG8_WAIT_V(0);
    if constexpr (!ALIGN_EPI) { if (wr == 0) PG8_BAR; }
    PG8_BAR;
#undef PG8_SA
#undef PG8_SB
#undef PG8_STAGE
#undef PG8_LDA
#undef PG8_LDB
#undef PG8_MMA
#undef PG8_WAIT_V
#undef PG8_WAIT_L
#undef PG8_BAR
#undef PG8_SCHED
}
}

#define LDS_WAIT() asm volatile("s_waitcnt lgkmcnt(0)" ::: "memory")
__device__ __forceinline__ unsigned f2bf(float f) { unsigned u = __builtin_bit_cast(unsigned, f); return (u + 0x7fffu + ((u >> 16) & 1u)) >> 16; }
__device__ __forceinline__ unsigned pk2(float lo, float hi) { return f2bf(lo) | (f2bf(hi) << 16); }
__device__ __forceinline__ float bf2f(unsigned b) { return __uint_as_float(b << 16); }
__device__ __forceinline__ float wave_sum(float v) {
#pragma unroll
    for (int o = 1; o < 64; o <<= 1) v += __shfl_xor(v, o);
    return v;
}
__device__ __forceinline__ float wave_max(float v) {
#pragma unroll
    for (int o = 1; o < 64; o <<= 1) v = fmaxf(v, __shfl_xor(v, o));
    return v;
}
__device__ __forceinline__ float wave_incl_sum(float v, int lane) {
#pragma unroll
    for (int o = 1; o < 64; o <<= 1) { const float t = __shfl_up(v, o); if (lane >= o) v += t; }
    return v;
}
__device__ __forceinline__ float wave_incl_max(float v, int lane) {
#pragma unroll
    for (int o = 1; o < 64; o <<= 1) { const float t = __shfl_up(v, o); if (lane >= o) v = fmaxf(v, t); }
    return v;
}
__device__ __forceinline__ float log_sigmoid_f(float x) { return fminf(x, 0.f) - log1pf(expf(-fabsf(x))); }

__device__ __forceinline__ void p0_item(const float* W, int ldw, int src_col0, bf16* WT, int K, int dst_row0, int k0, const float* gk, LAS float* scr, int lane) {
    {
        float wv[32]; const float* wp = W + (size_t)(k0 + (lane >> 5)) * ldw + src_col0 + (lane & 31);
#pragma unroll
        for (int i = 0; i < 32; ++i) wv[i] = __builtin_nontemporal_load(wp + (size_t)(2 * i) * ldw);
        if (gk) {
            const float* gp = gk + k0 + (lane >> 5);
#pragma unroll
            for (int i = 0; i < 32; ++i) wv[i] *= gp[2 * i];
        }
#pragma unroll
        for (int i = 0; i < 32; ++i) scr[(2 * i + (lane >> 5)) * 33 + (lane & 31)] = wv[i];
    }
    LDS_WAIT(); asm volatile("" ::: "memory");
    const int c = lane & 7;
#pragma unroll
    for (int j = 0; j < 4; ++j) { const int n = (lane >> 3) + 8 * j; const LAS float* s = scr + (8 * c) * 33 + n;
        u32x4 o; o.x = pk2(s[0 * 33], s[1 * 33]); o.y = pk2(s[2 * 33], s[3 * 33]); o.z = pk2(s[4 * 33], s[5 * 33]); o.w = pk2(s[6 * 33], s[7 * 33]);
        *(u32x4*)(WT + (size_t)(dst_row0 + n) * K + k0 + 8 * c) = o; }
    LDS_WAIT(); asm volatile("" ::: "memory");
}

struct Params {
    const float* x; const float* n1; const float* wg1; const float* wu1; const float* wd1;
    const float* nmix; const float* win; const float* bg; const float* convw; const float* convb; const float* mhn;
    const float* poolw; const float* pools; const float* wout; const float* n2; const float* wg2; const float* wu2; const float* wd2; const float* nf;
    float* out; unsigned char* ws;
};

__device__ __forceinline__ void cvt_gu(const Params& p, int set, LAS float* scr, int lane, int gw, int NGW) {
    constexpr int I_GU = 16 * 88;
    bf16* WT = (bf16*)(p.ws + (set ? WS_WGU2 : WS_WGU1)); const float* gk = set ? p.n2 : p.n1;
    for (int it = gw; it < 2 * I_GU; it += NGW) {
        const int up = it / I_GU, r = it - up * I_GU, kb = r / 88, nb = r % 88, n0 = 32 * nb;
        const float* W = set ? (up ? p.wu2 : p.wg2) : (up ? p.wu1 : p.wg1);
        p0_item(W, DFF, n0, WT, DM, (n0 >> 7) * 256 + (n0 & 127) + up * 128, 64 * kb, gk, scr, lane);
    }
}
__device__ __forceinline__ void cvt_down(const Params& p, int set, LAS float* scr, int lane, int gw, int NGW) {
    for (int it = gw; it < 44 * 32; it += NGW) { const int kb = it / 32, nb = it % 32;
        p0_item(set ? p.wd2 : p.wd1, DM, 32 * nb, (bf16*)(p.ws + (set ? WS_WD2 : WS_WD1)), DFF, 32 * nb, 64 * kb, nullptr, scr, lane); }
}
__device__ __forceinline__ void cvt_in(const Params& p, LAS float* scr, int lane, int gw, int NGW) {
    bf16* WIN = (bf16*)(p.ws + WS_WIN);
    for (int it = gw; it < 16 * 64 + 16 * 16; it += NGW) {
        if (it < 16 * 64) { const int kb = it / 64, nb = it % 64; p0_item(p.win, DINP, 32 * nb, WIN, DM, 32 * nb, 64 * kb, p.nmix, scr, lane); }
        else { const int r = it - 16 * 64, kb = r / 16, nb = r % 16; p0_item(p.win, DINP, 2056 + 32 * nb, WIN, DM, 2048 + 32 * nb, 64 * kb, p.nmix, scr, lane); }
    }
    for (int wi = gw; wi < 512; wi += NGW) {
        const int idx = wi * 64 + lane, rr = idx >> 7, kc = (idx & 127) * 8;
        u32x4 o = (u32x4){0u, 0u, 0u, 0u};
        if (rr < 8) {
            float v[8];
#pragma unroll
            for (int e = 0; e < 8; ++e) v[e] = p.win[(size_t)(kc + e) * DINP + 2048 + rr] * p.nmix[kc + e];
            o.x = pk2(v[0], v[1]); o.y = pk2(v[2], v[3]); o.z = pk2(v[4], v[5]); o.w = pk2(v[6], v[7]);
        }
        *(u32x4*)(WIN + (size_t)(2560 + rr) * DM + kc) = o;
    }
}
__device__ __forceinline__ void cvt_out(const Params& p, LAS float* scr, int lane, int gw, int NGW) {
    bf16* WOUT = (bf16*)(p.ws + WS_WOUT);
    for (int it = gw; it < 8 * 32; it += NGW) { const int kb = it / 32, nb = it % 32; p0_item(p.wout, DM, 32 * nb, WOUT, DM, 32 * nb, 64 * kb, nullptr, scr, lane); }
    for (int wi = gw; wi < 1024; wi += NGW) {
        const int nblk = wi & 15, cgp = (wi >> 4) & 15, g = wi >> 8, n = nblk * 64 + lane, c0 = cgp * 8;
        float a[8];
#pragma unroll
        for (int e = 0; e < 8; ++e) a[e] = 0.f;
        const float* pw = p.poolw + (size_t)(g * 128 + c0) * 128; const float* ps = p.pools + g * 128; const float* wo = p.wout + (size_t)(512 + g * 128) * DM + n;
        for (int d0 = 0; d0 < 128; d0 += 32) {
            float wv[32];
#pragma unroll
            for (int dd = 0; dd < 32; ++dd) wv[dd] = wo[(size_t)(d0 + dd) * DM];
#pragma unroll
            for (int dd = 0; dd < 32; ++dd) { const float w = wv[dd] * ps[d0 + dd];
#pragma unroll
                for (int e = 0; e < 8; ++e) a[e] += pw[e * 128 + d0 + dd] * w; }
        }
        u32x4 o; o.x = pk2(a[0], a[1]); o.y = pk2(a[2], a[3]); o.z = pk2(a[4], a[5]); o.w = pk2(a[6], a[7]);
        *(u32x4*)(WOUT + (size_t)n * DM + 512 + g * 128 + c0) = o;
    }
}
__device__ __forceinline__ void slack1_items(const Params& p, LAS float* scr, int lane, int gw, int NGW) {
    constexpr int N_D = 44 * 32, N_IN = 16 * 64 + 16 * 16, N_G = 512, N_O = 8 * 32, N_F = 1024;
    bf16* WIN = (bf16*)(p.ws + WS_WIN); bf16* WOUT = (bf16*)(p.ws + WS_WOUT);
    for (int it0 = gw; it0 < N_D + N_IN + N_G + N_O + N_F; it0 += NGW) {
        int it = it0;
        if (it < N_D) { const int kb = it / 32, nb = it % 32; p0_item(p.wd1, DM, 32 * nb, (bf16*)(p.ws + WS_WD1), DFF, 32 * nb, 64 * kb, nullptr, scr, lane); continue; }
        it -= N_D;
        if (it < N_IN) {
            if (it < 16 * 64) { const int kb = it / 64, nb = it % 64; p0_item(p.win, DINP, 32 * nb, WIN, DM, 32 * nb, 64 * kb, p.nmix, scr, lane); }
            else { const int r = it - 16 * 64, kb = r / 16, nb = r % 16; p0_item(p.win, DINP, 2056 + 32 * nb, WIN, DM, 2048 + 32 * nb, 64 * kb, p.nmix, scr, lane); }
            continue;
        }
        it -= N_IN;
        if (it < N_G) {
            const int idx = it * 64 + lane, rr = idx >> 7, kc = (idx & 127) * 8;
            u32x4 o = (u32x4){0u, 0u, 0u, 0u};
            if (rr < 8) {
                float v[8];
#pragma unroll
                for (int e = 0; e < 8; ++e) v[e] = p.win[(size_t)(kc + e) * DINP + 2048 + rr] * p.nmix[kc + e];
                o.x = pk2(v[0], v[1]); o.y = pk2(v[2], v[3]); o.z = pk2(v[4], v[5]); o.w = pk2(v[6], v[7]);
            }
            *(u32x4*)(WIN + (size_t)(2560 + rr) * DM + kc) = o;
            continue;
        }
        it -= N_G;
        if (it < N_O) { const int kb = it / 32, nb = it % 32; p0_item(p.wout, DM, 32 * nb, WOUT, DM, 32 * nb, 64 * kb, nullptr, scr, lane); continue; }
        it -= N_O;
        {
            const int wi = it, nblk = wi & 15, cgp = (wi >> 4) & 15, g = wi >> 8, n = nblk * 64 + lane, c0 = cgp * 8;
            float a[8];
#pragma unroll
            for (int e = 0; e < 8; ++e) a[e] = 0.f;
            const float* pw = p.poolw + (size_t)(g * 128 + c0) * 128; const float* ps = p.pools + g * 128; const float* wo = p.wout + (size_t)(512 + g * 128) * DM + n;
            for (int d0 = 0; d0 < 128; d0 += 32) {
                float wv[32];
#pragma unroll
                for (int dd = 0; dd < 32; ++dd) wv[dd] = wo[(size_t)(d0 + dd) * DM];
#pragma unroll
                for (int dd = 0; dd < 32; ++dd) { const float w = wv[dd] * ps[d0 + dd];
#pragma unroll
                    for (int e = 0; e < 8; ++e) a[e] += pw[e * 128 + d0 + dd] * w; }
            }
            u32x4 o; o.x = pk2(a[0], a[1]); o.y = pk2(a[2], a[3]); o.z = pk2(a[4], a[5]); o.w = pk2(a[6], a[7]);
            *(u32x4*)(WOUT + (size_t)n * DM + 512 + g * 128 + c0) = o;
        }
    }
}
__device__ __forceinline__ void p0_prologue(const Params& p, LAS unsigned char* lds, int G) {
    const int tid = threadIdx.x, lane = tid & 63, wave = __builtin_amdgcn_readfirstlane(tid >> 6);
    LAS float* scr = (LAS float*)(lds + wave * 8448);
    const int gw = blockIdx.x * 8 + wave, NGW = G * 8;
    cvt_gu(p, 0, scr, lane, gw, NGW);
    bf16* XB = (bf16*)(p.ws + WS_XB); float* SS0 = (float*)(p.ws + WS_SS0);
    for (int m0 = gw * 4; m0 < S; m0 += NGW * 4) {
        f32x4 v[4][4];
#pragma unroll
        for (int rr = 0; rr < 4; ++rr) { const f32x4* xr = (const f32x4*)(p.x + (size_t)(m0 + rr) * DM) + lane;
#pragma unroll
            for (int j = 0; j < 4; ++j) v[rr][j] = __builtin_nontemporal_load(xr + 64 * j); }
#pragma unroll
        for (int rr = 0; rr < 4; ++rr) {
            float s = 0.f;
#pragma unroll
            for (int j = 0; j < 4; ++j) s += (v[rr][j][0] * v[rr][j][0] + v[rr][j][1] * v[rr][j][1]) + (v[rr][j][2] * v[rr][j][2] + v[rr][j][3] * v[rr][j][3]);
            s = wave_sum(s);
            u32x2* o8 = (u32x2*)(XB + (size_t)(m0 + rr) * DM) + lane;
#pragma unroll
            for (int j = 0; j < 4; ++j) { u32x2 w; w.x = pk2(v[rr][j][0], v[rr][j][1]); w.y = pk2(v[rr][j][2], v[rr][j][3]); o8[64 * j] = w; }
            if (lane < 16) SS0[(size_t)(m0 + rr) * 16 + lane] = lane == 0 ? s : 0.f;
        }
    }
}
__device__ __forceinline__ bool slack_rank(int nwg, int G, int& gw, int& NGW) {
    const int imax = (nwg - 1) / G, cb = nwg - imax * G;
    if ((int)blockIdx.x < cb || cb >= G) return false;
    gw = ((int)blockIdx.x - cb) * 8 + (int)__builtin_amdgcn_readfirstlane(threadIdx.x >> 6); NGW = (G - cb) * 8; return true;
}

constexpr int L_QS = 0, L_KS = 17408, L_VT = 34816, L_CT = 53248, L_PS = 88064, L_OS = 97280, L_SM = 114688;
constexpr int QP = 136, TP = 72;

__device__ __forceinline__ int tsw(int row, int col) { return row * TP + (col ^ (((row >> 3) & 7) << 3)); }
__device__ __forceinline__ void unpack8(const u32x4 v, float (&f)[8]) {
    f[0] = __uint_as_float(v.x << 16); f[1] = __uint_as_float(v.x & 0xffff0000u); f[2] = __uint_as_float(v.y << 16); f[3] = __uint_as_float(v.y & 0xffff0000u);
    f[4] = __uint_as_float(v.z << 16); f[5] = __uint_as_float(v.z & 0xffff0000u); f[6] = __uint_as_float(v.w << 16); f[7] = __uint_as_float(v.w & 0xffff0000u);
}
__device__ __forceinline__ void conv8(const bf16* proj, int t, int ch, const float* cw, const float* cb, float sc, float (&o)[8]) {
    { const f32x4 b0 = *(const f32x4*)(cb + ch), b1 = *(const f32x4*)(cb + ch + 4);
      o[0] = b0[0]; o[1] = b0[1]; o[2] = b0[2]; o[3] = b0[3]; o[4] = b1[0]; o[5] = b1[1]; o[6] = b1[2]; o[7] = b1[3]; }
#pragma unroll
    for (int w = 0; w < 4; ++w) {
        const int tr = t - 3 + w;
        if (tr >= 0) {
            const u32x4 raw = *(const u32x4*)(proj + (size_t)tr * NPROJ + ch); float xv[8]; unpack8(raw, xv);
            const f32x4 w0 = *(const f32x4*)(cw + w * 1024 + ch), w1 = *(const f32x4*)(cw + w * 1024 + ch + 4);
            o[0] += w0[0] * xv[0]; o[1] += w0[1] * xv[1]; o[2] += w0[2] * xv[2]; o[3] += w0[3] * xv[3];
            o[4] += w1[0] * xv[4]; o[5] += w1[1] * xv[5]; o[6] += w1[2] * xv[6]; o[7] += w1[3] * xv[7];
        }
    }
#pragma unroll
    for (int e = 0; e < 8; ++e) o[e] = o[e] * sc * __builtin_amdgcn_rcpf(1.0f + __expf(-o[e]));
}
__device__ __forceinline__ void conv4x8(const bf16* proj, int t, int ch, const float* cw, const float* cb, float sc, float (&o)[4][8]) {
    u32x4 raw[7];
#pragma unroll
    for (int i = 0; i < 7; ++i) { const int tr = t - 3 + i; raw[i] = tr >= 0 ? *(const u32x4*)(proj + (size_t)tr * NPROJ + ch) : (u32x4){0u, 0u, 0u, 0u}; }
    { const f32x4 b0 = *(const f32x4*)(cb + ch), b1 = *(const f32x4*)(cb + ch + 4);
#pragma unroll
      for (int j = 0; j < 4; ++j) { o[j][0] = b0[0]; o[j][1] = b0[1]; o[j][2] = b0[2]; o[j][3] = b0[3]; o[j][4] = b1[0]; o[j][5] = b1[1]; o[j][6] = b1[2]; o[j][7] = b1[3]; } }
#pragma unroll
    for (int w = 0; w < 4; ++w) {
        const f32x4 w0 = *(const f32x4*)(cw + w * 1024 + ch), w1 = *(const f32x4*)(cw + w * 1024 + ch + 4);
        const float wv[8] = {w0[0], w0[1], w0[2], w0[3], w1[0], w1[1], w1[2], w1[3]};
#pragma unroll
        for (int j = 0; j < 4; ++j) { float xv[8]; unpack8(raw[j + w], xv);
#pragma unroll
            for (int e = 0; e < 8; ++e) o[j][e] += wv[e] * xv[e]; }
    }
#pragma unroll
    for (int j = 0; j < 4; ++j)
#pragma unroll
        for (int e = 0; e < 8; ++e) o[j][e] = o[j][e] * sc * __builtin_amdgcn_rcpf(1.0f + __expf(-o[j][e]));
}
__device__ __forceinline__ u32x4 pack8(const float (&v)[8]) { u32x4 o; o.x = pk2(v[0], v[1]); o.y = pk2(v[2], v[3]); o.z = pk2(v[4], v[5]); o.w = pk2(v[6], v[7]); return o; }

__device__ __forceinline__ void m1_phase(const Params& p, unsigned char* ldsg, int G) {
    const int tid = threadIdx.x, lane = tid & 63, wave = __builtin_amdgcn_readfirstlane(tid >> 6), fr = lane & 15, fq = lane >> 4;
    const int half = wave >> 2, hw = wave & 3, htid = tid & 255;
    unsigned char* ws = p.ws;
    const bf16* PROJ = (const bf16*)(ws + WS_HB); const float* GATES = (const float*)(ws + WS_GATES);
    bf16* DCB = (bf16*)p.out; bf16* QKC = (bf16*)((unsigned char*)p.out + 32 * MiB); float* DN = (float*)(ws + WS_DN); float* GARR = (float*)(ws + WS_SC); float* AMAXARR = GARR + 1024;
    bf16* KT = (bf16*)(ldsg + half * 40960); bf16* VT = KT + 128 * TP; float* sW = (float*)(ldsg + half * 40960 + 36864);
    for (int r = blockIdx.x; r < NCH * NH / 2; r += G) {
        const int c = r >> 1, h = 2 * (r & 1) + half, u = c * 4 + h, t0 = c * CL;
        if (hw == 0) {
            const float ig = GATES[(size_t)(t0 + lane) * 8 + h], fp = GATES[(size_t)(t0 + lane) * 8 + 4 + h];
            const float b = wave_incl_sum(log_sigmoid_f(fp), lane);
            const float g = __shfl(b, 63);
            const float a = g - b + ig;
            const float amax = wave_max(a);
            sW[lane] = expf(a - amax);
            if (lane == 0) { GARR[h * NCH + c] = g; AMAXARR[h * NCH + c] = amax; }
        }
        const int rg = htid >> 4, cgp = htid & 15, l0 = 4 * rg;
        float kk[4][8];
        {
            float qv[4][8];
            conv4x8(PROJ, t0 + l0, h * HD + cgp * 8, p.convw, p.convb, 1.0f, qv);
#pragma unroll
            for (int j = 0; j < 4; ++j) *(u32x4*)(QKC + (size_t)(t0 + l0 + j) * DM + h * HD + cgp * 8) = pack8(qv[j]);
        }
        asm volatile("" ::: "memory");
        conv4x8(PROJ, t0 + l0, 512 + h * HD + cgp * 8, p.convw, p.convb, 0.08838834764831845f, kk);
#pragma unroll
        for (int j = 0; j < 4; ++j) *(u32x4*)(QKC + (size_t)(t0 + l0 + j) * DM + 512 + h * HD + cgp * 8) = pack8(kk[j]);
        {
            u32x4 rv[4];
#pragma unroll
            for (int j = 0; j < 4; ++j) rv[j] = *(const u32x4*)(PROJ + (size_t)(t0 + l0 + j) * NPROJ + 1024 + h * HD + cgp * 8);
#pragma unroll
            for (int e = 0; e < 8; ++e) {
                const unsigned sh = (e & 1) * 16;
                u32x2 o; o.x = ((rv[0][e >> 1] >> sh) & 0xffffu) | (((rv[1][e >> 1] >> sh) & 0xffffu) << 16); o.y = ((rv[2][e >> 1] >> sh) & 0xffffu) | (((rv[3][e >> 1] >> sh) & 0xffffu) << 16);
                *(u32x2*)(VT + tsw(cgp * 8 + e, l0)) = o;
            }
        }
        __syncthreads();
        {
            const f32x4 w4 = *(const f32x4*)(sW + l0);
#pragma unroll
            for (int e = 0; e < 8; ++e) { u32x2 o; o.x = pk2(kk[0][e] * w4[0], kk[1][e] * w4[1]); o.y = pk2(kk[2][e] * w4[2], kk[3][e] * w4[3]); *(u32x2*)(KT + tsw(cgp * 8 + e, l0)) = o; }
        }
        __syncthreads();
        {
            bf16x8 av[2][2];
#pragma unroll
            for (int mi = 0; mi < 2; ++mi)
#pragma unroll
                for (int ks = 0; ks < 2; ++ks) av[mi][ks] = *(const bf16x8*)(VT + tsw(16 * (2 * hw + mi) + fr, ks * 32 + fq * 8));
#pragma unroll
            for (int nt = 0; nt < 8; ++nt) {
                bf16x8 bk[2];
#pragma unroll
                for (int ks = 0; ks < 2; ++ks) bk[ks] = *(const bf16x8*)(KT + tsw(16 * nt + fr, ks * 32 + fq * 8));
#pragma unroll
                for (int mi = 0; mi < 2; ++mi) {
                    f32x4 acc = (f32x4){0.f, 0.f, 0.f, 0.f};
#pragma unroll
                    for (int ks = 0; ks < 2; ++ks) acc = __builtin_amdgcn_mfma_f32_16x16x32_bf16(bk[ks], av[mi][ks], acc, 0, 0, 0);
                    u32x2 o; o.x = pk2(acc[0], acc[1]); o.y = pk2(acc[2], acc[3]);
                    { const int vd = 16 * (2 * hw + mi) + fr; *(u32x2*)(DCB + ((size_t)((h * 64 + (vd >> 1)) * NCH + c) << 8) + (vd & 1) * 128 + 16 * nt + fq * 4) = o; }
                }
            }
            if (htid < 128) { float s = 0.f;
#pragma unroll 8
                for (int l = 0; l < 64; ++l) s += bf2f(KT[htid * TP + l]);
                DN[(size_t)(h * NCH + c) * 128 + htid] = s; }
        }
        __syncthreads();
    }
    bf16* MIX = (bf16*)(ws + WS_MIX);
    for (int rb = blockIdx.x; rb < S / 64; rb += G) {
        const int cg8 = tid & 63, rg = tid >> 6, ch0 = cg8 * 8, gi = ch0 >> 7, win = 2 << gi, tq = rb * 64 + rg * 8;
        const bf16* up = PROJ + 2048 + ch0;
        u32x4 slot[23];
#pragma unroll
        for (int s = 0; s < 23; ++s) { const int row = tq - 15 + s; slot[s] = (s + win >= 16 && row >= 0) ? *(const u32x4*)(up + (size_t)row * NPROJ) : (u32x4){0u, 0u, 0u, 0u}; }
        float sum[8];
#pragma unroll
        for (int e = 0; e < 8; ++e) sum[e] = 0.f;
#pragma unroll
        for (int s = 0; s < 15; ++s) { float xv[8]; unpack8(slot[s], xv); const bool in = (s + win > 15);
#pragma unroll
            for (int e = 0; e < 8; ++e) sum[e] += in ? xv[e] : 0.f; }
#pragma unroll
        for (int i = 0; i < 8; ++i) {
            float ut[8]; unpack8(slot[15 + i], ut);
#pragma unroll
            for (int e = 0; e < 8; ++e) sum[e] += ut[e];
            const int t = tq + i; const float inv = 1.0f / (float)((t + 1) < win ? (t + 1) : win);
            float o[8];
#pragma unroll
            for (int e = 0; e < 8; ++e) o[e] = sum[e] * inv - ut[e];
            *(u32x4*)(MIX + (size_t)t * DM + 512 + ch0) = pack8(o);
            if (i < 7) {
                u32x4 d;
#pragma unroll
                for (int q = 0; q < 4; ++q) d[q] = gi == 0 ? slot[14 + i][q] : gi == 1 ? slot[12 + i][q] : gi == 2 ? slot[8 + i][q] : slot[i][q];
                float dv[8]; unpack8(d, dv);
#pragma unroll
                for (int e = 0; e < 8; ++e) sum[e] -= dv[e];
            }
        }
    }
}

__device__ __forceinline__ void m2_phase(const Params& p, unsigned char* ldsg, int G) {
    const int tid = threadIdx.x, lane = tid & 63, wave = __builtin_amdgcn_readfirstlane(tid >> 6);
    unsigned char* ws = p.ws;
    bf16* DCB = (bf16*)p.out; float* DN = (float*)(ws + WS_DN); const float* GARR = (const float*)(ws + WS_SC); const float* AMAXARR = GARR + 1024; float* MPREV = (float*)(ws + WS_SC) + 2048;
    float* sA = (float*)ldsg; float* sB = sA + 256; float* sAseg = sA + 512; float* sTot = sA + 1024;
    for (int it = blockIdx.x; it < 256; it += G) {
        const int h = it >> 6, slice = it & 63, c0 = 32 * wave;
        u32x2 x[32];
        char* ub = (char*)DCB + (((size_t)((h * 64 + slice) * NCH + c0) << 8) * 2);
        const unsigned loff = (unsigned)lane * 8u;
#pragma unroll
        for (int i = 0; i < 32; ++i) x[i] = *(const u32x2*)(ub + (size_t)i * 512 + loff);
        if (wave == 0) {
            const f32x4 g4 = *(const f32x4*)(GARR + h * NCH + 4 * lane), a4 = *(const f32x4*)(AMAXARR + h * NCH + 4 * lane);
            const float tot = (g4[0] + g4[1]) + (g4[2] + g4[3]);
            const float inc = wave_incl_sum(tot, lane); const float pbase = inc - tot;
            float P[5]; P[0] = pbase; P[1] = P[0] + g4[0]; P[2] = P[1] + g4[1]; P[3] = P[2] + g4[2]; P[4] = P[3] + g4[3];
            float z[4];
#pragma unroll
            for (int i = 0; i < 4; ++i) z[i] = a4[i] - P[i + 1];
            const float zl = fmaxf(fmaxf(z[0], z[1]), fmaxf(z[2], z[3]));
            const float zi = wave_incl_max(zl, lane); float zprev = __shfl_up(zi, 1); if (lane == 0) zprev = 0.f; zprev = fmaxf(zprev, 0.f);
            float Z = zprev;
#pragma unroll
            for (int i = 0; i < 4; ++i) {
                const float m = P[i] + Z; const float Zn = fmaxf(Z, z[i]); const float mn = P[i + 1] + Zn;
                sA[4 * lane + i] = expf(g4[i] + m - mn); sB[4 * lane + i] = expf(a4[i] - mn);
                if (slice == 0) MPREV[h * NCH + 4 * lane + i] = m;
                Z = Zn;
            }
        }
        __syncthreads();
        {
            float l0 = 0.f, l1 = 0.f, l2 = 0.f, l3 = 0.f, ap = 1.f;
#pragma unroll
            for (int i = 0; i < 32; ++i) { const float a = sA[c0 + i], b = sB[c0 + i];
                l0 = a * l0 + b * __uint_as_float(x[i].x << 16); l1 = a * l1 + b * __uint_as_float(x[i].x & 0xffff0000u);
                l2 = a * l2 + b * __uint_as_float(x[i].y << 16); l3 = a * l3 + b * __uint_as_float(x[i].y & 0xffff0000u); ap *= a; }
            *(f32x4*)(sTot + wave * 256 + lane * 4) = (f32x4){l0, l1, l2, l3};
            if (lane == 0) sAseg[wave] = ap;
        }
        __syncthreads();
        {
            float l0 = 0.f, l1 = 0.f, l2 = 0.f, l3 = 0.f;
            for (int j = 0; j < wave; ++j) { const float a = sAseg[j]; const f32x4 tv = *(const f32x4*)(sTot + j * 256 + lane * 4);
                l0 = a * l0 + tv[0]; l1 = a * l1 + tv[1]; l2 = a * l2 + tv[2]; l3 = a * l3 + tv[3]; }
#pragma unroll
            for (int i = 0; i < 32; ++i) { const float a = sA[c0 + i], b = sB[c0 + i];
                u32x2 o; o.x = pk2(l0, l1); o.y = pk2(l2, l3); *(u32x2*)(ub + (size_t)i * 512 + loff) = o;
                l0 = a * l0 + b * __uint_as_float(x[i].x << 16); l1 = a * l1 + b * __uint_as_float(x[i].x & 0xffff0000u);
                l2 = a * l2 + b * __uint_as_float(x[i].y << 16); l3 = a * l3 + b * __uint_as_float(x[i].y & 0xffff0000u); }
        }
        if (slice == 0) {
            __syncthreads();
            typedef float f32x2 __attribute__((ext_vector_type(2)));
            char* nb = (char*)DN + ((size_t)(h * NCH + c0) * 128) * 4;
            f32x2 y[32];
#pragma unroll
            for (int i = 0; i < 32; ++i) y[i] = *(const f32x2*)(nb + (size_t)i * 512 + loff);
            f32x2 l = (f32x2){0.f, 0.f};
#pragma unroll
            for (int i = 0; i < 32; ++i) l = l * sA[c0 + i] + y[i] * sB[c0 + i];
            *(f32x2*)(sTot + wave * 256 + lane * 2) = l;
            __syncthreads();
            l = (f32x2){0.f, 0.f};
            for (int j = 0; j < wave; ++j) l = l * sAseg[j] + *(const f32x2*)(sTot + j * 256 + lane * 2);
#pragma unroll
            for (int i = 0; i < 32; ++i) { *(f32x2*)(nb + (size_t)i * 512 + loff) = l; l = l * sA[c0 + i] + y[i] * sB[c0 + i]; }
        }
        __syncthreads();
    }
}

__device__ __forceinline__ void m3_phase(const Params& p, unsigned char* ldsg, int G) {
    const int tid = threadIdx.x, lane = tid & 63, wave = __builtin_amdgcn_readfirstlane(tid >> 6), fr = lane & 15, fq = lane >> 4;
    unsigned char* ws = p.ws;
    const bf16* PROJ = (const bf16*)(ws + WS_HB); const float* GATES = (const float*)(ws + WS_GATES); const bf16* QKC = (const bf16*)((const unsigned char*)p.out + 32 * MiB);
    const bf16* CPB = (const bf16*)p.out; const float* DN = (const float*)(ws + WS_DN); const float* MPREV = (const float*)(ws + WS_SC) + 2048;
    bf16* MIX = (bf16*)(ws + WS_MIX);
    bf16* Qs = (bf16*)(ldsg + L_QS); bf16* Ks = (bf16*)(ldsg + L_KS); bf16* VT = (bf16*)(ldsg + L_VT); bf16* CTs = (bf16*)(ldsg + L_CT); bf16* Ps = (bf16*)(ldsg + L_PS); bf16* Os = (bf16*)(ldsg + L_OS);
    float* sU = (float*)(ldsg + L_SM); float* sM = sU + 64; float* sIW = sU + 128; float* sEMT = sU + 192; float* sRS = sU + 256; float* sQN = sU + 320; float* sHS = sU + 384; float* sN = sU + 448;
    for (int u = blockIdx.x; u < NCH * NH; u += G) {
        const int c = u >> 2, h = u & 3, t0 = c * CL;
        {
            const int r = tid >> 4, cgp = tid & 15;
            u32x4 gq[2], gk[2], gv[2], go[2], gc[4];
#pragma unroll
            for (int pass = 0; pass < 2; ++pass) { const size_t t = t0 + r + 32 * pass;
                gq[pass] = *(const u32x4*)(QKC + t * DM + h * HD + cgp * 8); gk[pass] = *(const u32x4*)(QKC + t * DM + 512 + h * HD + cgp * 8);
                gv[pass] = *(const u32x4*)(PROJ + t * NPROJ + 1024 + h * HD + cgp * 8); go[pass] = *(const u32x4*)(PROJ + t * NPROJ + 1536 + h * HD + cgp * 8); }
#pragma unroll
            for (int i = 0; i < 4; ++i) { const int idx = tid + 512 * i; gc[i] = *(const u32x4*)(CPB + ((size_t)((h * 64 + (idx >> 5)) * NCH + c) << 8) + (idx & 31) * 8); }
            if (wave == 0) {
                const float ig = GATES[(size_t)(t0 + lane) * 8 + h], fp = GATES[(size_t)(t0 + lane) * 8 + 4 + h];
                const float b = wave_incl_sum(log_sigmoid_f(fp), lane);
                const float uu = ig - b;
                const float U = wave_incl_max(uu, lane);
                const float mp = MPREV[h * NCH + c];
                const float M = fmaxf(mp, U);
                sU[lane] = uu; sM[lane] = M; sIW[lane] = expf(mp - M); sEMT[lane] = expf(-(b + M)); sRS[lane] = 0.f; sHS[lane] = 0.f;
            } else if (wave == 1) {
                sN[lane] = DN[(size_t)(h * NCH + c) * 128 + lane]; sN[lane + 64] = DN[(size_t)(h * NCH + c) * 128 + 64 + lane];
            }
#pragma unroll
            for (int pass = 0; pass < 2; ++pass) { const int l = r + 32 * pass;
                *(u32x4*)(Qs + l * QP + cgp * 8) = gq[pass]; *(u32x4*)(Ks + l * QP + cgp * 8) = gk[pass]; *(u32x4*)(Os + l * QP + cgp * 8) = go[pass];
#pragma unroll
                for (int e = 0; e < 8; ++e) VT[tsw(cgp * 8 + e, l)] = (bf16)(gv[pass][e >> 1] >> ((e & 1) * 16)); }
#pragma unroll
            for (int i = 0; i < 4; ++i) { const int idx = tid + 512 * i, vd = idx >> 4, kc = (idx & 15) * 8; *(u32x4*)(CTs + vd * QP + kc) = gc[i]; }
        }
        __syncthreads();
        {
            const int l = tid >> 3, part = tid & 7; float s = 0.f;
#pragma unroll
            for (int e = 0; e < 16; ++e) s += bf2f(Qs[l * QP + part * 16 + e]) * sN[part * 16 + e];
            s += __shfl_xor(s, 1); s += __shfl_xor(s, 2); s += __shfl_xor(s, 4);
            if (part == 0) sQN[l] = s;
        }
        const int lt = wave >> 1;
        {
            bf16x8 aq[4];
#pragma unroll
            for (int ks = 0; ks < 4; ++ks) aq[ks] = *(const bf16x8*)(Qs + (16 * lt + fr) * QP + ks * 32 + fq * 8);
            float rs[4] = {0.f, 0.f, 0.f, 0.f};
#pragma unroll
            for (int si = 0; si < 2; ++si) {
                const int st = 2 * (wave & 1) + si;
                f32x4 acc = (f32x4){0.f, 0.f, 0.f, 0.f};
#pragma unroll
                for (int ks = 0; ks < 4; ++ks) { const bf16x8 b = *(const bf16x8*)(Ks + (16 * st + fr) * QP + ks * 32 + fq * 8); acc = __builtin_amdgcn_mfma_f32_16x16x32_bf16(aq[ks], b, acc, 0, 0, 0); }
                const int s = 16 * st + fr; const float us = sU[s];
#pragma unroll
                for (int j = 0; j < 4; ++j) { const int l = 16 * lt + fq * 4 + j; const float val = (s <= l) ? acc[j] * expf(us - sM[l]) : 0.f; Ps[l * TP + s] = (bf16)f2bf(val); rs[j] += val; }
            }
#pragma unroll
            for (int j = 0; j < 4; ++j) { float v = rs[j]; v += __shfl_xor(v, 1); v += __shfl_xor(v, 2); v += __shfl_xor(v, 4); v += __shfl_xor(v, 8); if (fr == 0) atomicAdd(&sRS[16 * lt + fq * 4 + j], v); }
        }
        __syncthreads();
        {
            f32x4 a1[4], a2[4];
#pragma unroll
            for (int n = 0; n < 4; ++n) { a1[n] = (f32x4){0.f, 0.f, 0.f, 0.f}; a2[n] = (f32x4){0.f, 0.f, 0.f, 0.f}; }
#pragma unroll
            for (int ks = 0; ks < 2; ++ks) { const bf16x8 a = *(const bf16x8*)(Ps + (16 * lt + fr) * TP + ks * 32 + fq * 8);
#pragma unroll
                for (int n = 0; n < 4; ++n) { const int nt = 4 * (wave & 1) + n; const bf16x8 b = *(const bf16x8*)(VT + tsw(16 * nt + fr, ks * 32 + fq * 8)); a1[n] = __builtin_amdgcn_mfma_f32_16x16x32_bf16(a, b, a1[n], 0, 0, 0); } }
#pragma unroll
            for (int ks = 0; ks < 4; ++ks) { const bf16x8 a = *(const bf16x8*)(Qs + (16 * lt + fr) * QP + ks * 32 + fq * 8);
#pragma unroll
                for (int n = 0; n < 4; ++n) { const int nt = 4 * (wave & 1) + n; const bf16x8 b = *(const bf16x8*)(CTs + (16 * nt + fr) * QP + ks * 32 + fq * 8); a2[n] = __builtin_amdgcn_mfma_f32_16x16x32_bf16(a, b, a2[n], 0, 0, 0); } }
#pragma unroll
            for (int j = 0; j < 4; ++j) {
                const int l = 16 * lt + fq * 4 + j; const float iw = sIW[l]; const float qn = sRS[l] + iw * sQN[l];
                const float den = fmaxf(fabsf(qn), sEMT[l]); const float inv = 1.0f / den; float hs = 0.f;
#pragma unroll
                for (int n = 0; n < 4; ++n) { const float v = (a1[n][j] + iw * a2[n][j]) * inv; hs += v * v; Ks[l * QP + 16 * (4 * (wave & 1) + n) + fr] = (bf16)f2bf(v); }
                hs += __shfl_xor(hs, 1); hs += __shfl_xor(hs, 2); hs += __shfl_xor(hs, 4); hs += __shfl_xor(hs, 8);
                if (fr == 0) atomicAdd(&sHS[l], hs);
            }
        }
        __syncthreads();
        {
            const int r = tid >> 4, cgp = tid & 15;
            const f32x4 n0 = *(const f32x4*)(p.mhn + h * HD + cgp * 8), n1 = *(const f32x4*)(p.mhn + h * HD + cgp * 8 + 4);
            const float nn[8] = {n0[0], n0[1], n0[2], n0[3], n1[0], n1[1], n1[2], n1[3]};
#pragma unroll
            for (int pass = 0; pass < 2; ++pass) { const int l = r + 32 * pass; const float rinv = 1.0f / sqrtf(sHS[l] * (1.0f / 128.0f) + EPS);
                float hv[8], ov[8], o[8]; unpack8(*(const u32x4*)(Ks + l * QP + cgp * 8), hv); unpack8(*(const u32x4*)(Os + l * QP + cgp * 8), ov);
#pragma unroll
                for (int e = 0; e < 8; ++e) o[e] = hv[e] * rinv * nn[e] * __builtin_amdgcn_rcpf(1.0f + __expf(-ov[e]));
                *(u32x4*)(MIX + (size_t)(t0 + l) * DM + h * HD + cgp * 8) = pack8(o); }
        }
        __syncthreads();
    }
}

#define XB_TMO      128
#define XB_XCNT(j)  (256  + 64 * (j))
#define XB_XSUB(j)  (1280 + 64 * (j))
#define XB_XGEN(j)  (2304 + 64 * (j))
#define XB_TOP      3328
#define XB_TOPGEN   3392
#define XCD_BAR_WORDS 3456
#define XB_SPIN_CAP (1u << 18)
__device__ __forceinline__ unsigned xb_ld(unsigned* p)              { return __hip_atomic_load(p, __ATOMIC_RELAXED, __HIP_MEMORY_SCOPE_AGENT); }
__device__ __forceinline__ unsigned xb_add(unsigned* p, unsigned v) { return __hip_atomic_fetch_add(p, v, __ATOMIC_RELAXED, __HIP_MEMORY_SCOPE_AGENT); }
__device__ __forceinline__ unsigned xb_xcc_id() { return (unsigned)__builtin_amdgcn_s_getreg((3 << 11) | 20) & 0xFu; }
#define XB_SPIN(cond, bar) do { unsigned _sp = 0; while (cond) { __builtin_amdgcn_s_sleep(1); \
    if ((++_sp & 255u) == 0u) { if (xb_ld(&(bar)[XB_TMO])) break; if (_sp > XB_SPIN_CAP) { atomicAdd(&(bar)[XB_TMO], 1u); break; } } } } while (0)
struct XcdBarrier { unsigned* bar; unsigned x; volatile LAS unsigned* st; };
__device__ __forceinline__ XcdBarrier xcd_barrier_post(unsigned* bar, volatile LAS unsigned* st) {
    XcdBarrier b; b.bar = bar; b.x = xb_xcc_id(); b.st = st;
    if (threadIdx.x == 0) (void)xb_add(&bar[XB_XCNT(b.x)], 1u);
    return b;
}
__device__ __forceinline__ void xcd_barrier_complete(unsigned* bar, unsigned x, unsigned& nloc, unsigned& nx) {
    const unsigned G = gridDim.x * gridDim.y * gridDim.z;
    unsigned sum, cnt, mine, sp = 0u;
    for (;;) {
        sum = 0u; cnt = 0u; mine = 0u;
#pragma unroll
        for (unsigned j = 0; j < 16; ++j) { const unsigned c = xb_ld(&bar[XB_XCNT(j)]); sum += c; cnt += (c > 0u) ? 1u : 0u; mine = (j == x) ? c : mine; }
        if (sum == G) break;
        __builtin_amdgcn_s_sleep(1);
        if ((++sp & 255u) == 0u) { if (xb_ld(&bar[XB_TMO])) break; if (sp > XB_SPIN_CAP) { atomicAdd(&bar[XB_TMO], 1u); break; } }
    }
    nloc = mine > 0u ? mine : 1u; nx = cnt > 0u ? cnt : 1u;
}
__device__ __forceinline__ void xcd_barrier(const XcdBarrier& b) {
    asm volatile("s_waitcnt vmcnt(0)" ::: "memory");
    __syncthreads();
    if (threadIdx.x == 0) {
        unsigned* bar = b.bar;
        __builtin_amdgcn_s_waitcnt(0);
        unsigned nloc = b.st[0], nx = b.st[1];
        if (nloc == 0u) { xcd_barrier_complete(bar, b.x, nloc, nx); b.st[0] = nloc; b.st[1] = nx; }
        const unsigned old = xb_add(&bar[XB_XSUB(b.x)], 1u);
        const unsigned gen = old / nloc;
        if (old + 1u == (gen + 1u) * nloc) {
            __builtin_amdgcn_fence(__ATOMIC_RELEASE, "agent");
            asm volatile("s_waitcnt vmcnt(0)" ::: "memory");
            const unsigned og = xb_add(&bar[XB_TOP], 1u);
            const unsigned tg = og / nx;
            if (og + 1u == (tg + 1u) * nx) xb_add(&bar[XB_TOPGEN], 1u);
            else XB_SPIN(xb_ld(&bar[XB_TOPGEN]) == tg, bar);
            __builtin_amdgcn_fence(__ATOMIC_ACQUIRE, "agent");
            xb_add(&bar[XB_XGEN(b.x)], 1u);
            asm volatile("s_waitcnt vmcnt(0)" ::: "memory");
        } else {
            XB_SPIN(xb_ld(&bar[XB_XGEN(b.x)]) == gen, bar);
            __builtin_amdgcn_fence(__ATOMIC_ACQUIRE, "agent");
            asm volatile("s_waitcnt vmcnt(0)" ::: "memory");
        }
    }
    __syncthreads();
}

__device__ __forceinline__ int fill_rtab(const pg8::StaticOrder& so, const float* ss, LAS float* rtab) {
    pg8::Unit u0; int pm0 = -1;
    if (so.next(0, u0)) { pm0 = u0.pm; if (threadIdx.x < 256) rtab[threadIdx.x] = pg8::row_rstd(ss, pm0 * 256 + (int)threadIdx.x); }
    __syncthreads();
    return pm0;
}
__global__ void __launch_bounds__(512, 2) fwd_megakernel(Params p) {
    extern __shared__ __attribute__((aligned(16))) unsigned char lds[];
    cg::grid_group grid = cg::this_grid();
    LAS unsigned char* ldsl = (LAS unsigned char*)lds;
    const int G = gridDim.x;
    unsigned char* ws = p.ws;
    bf16* XB = (bf16*)(ws + WS_XB); bf16* HB = (bf16*)(ws + WS_HB); bf16* MIX = (bf16*)(ws + WS_MIX);
    float* SS0 = (float*)(ws + WS_SS0); float* SS1 = (float*)(ws + WS_SS1); float* SS2 = (float*)(ws + WS_SS2); float* SS3 = (float*)(ws + WS_SS3);

    unsigned* barw = (unsigned*)(ws + WS_BAR);
    LAS float* rtab = (LAS float*)(ldsl + LDS_RTAB);
    volatile LAS unsigned* bst = (volatile LAS unsigned*)(ldsl + 131072);
    if (threadIdx.x < 2) bst[threadIdx.x] = 0u;
    if (p.ws == nullptr) grid.sync();
    {
        unsigned* flag = barw + 16384 - 64;
        constexpr unsigned MAGIC = 0x600DF1A6u;
        if (blockIdx.x == 0) {
            for (int i = threadIdx.x; i < 16384 - 64; i += 512) barw[i] = 0u;
            __threadfence(); __syncthreads();
            if (threadIdx.x == 0) { asm volatile("s_waitcnt vmcnt(0)" ::: "memory"); __hip_atomic_store(flag, MAGIC, __ATOMIC_RELEASE, __HIP_MEMORY_SCOPE_AGENT); }
        } else if (threadIdx.x == 0) {
            unsigned sp = 0; while (__hip_atomic_load(flag, __ATOMIC_RELAXED, __HIP_MEMORY_SCOPE_AGENT) != MAGIC) { __builtin_amdgcn_s_sleep(1); if (++sp > (1u << 22)) break; }
            __builtin_amdgcn_fence(__ATOMIC_ACQUIRE, "agent");
        }
        __syncthreads();
    }
    const XcdBarrier xb = xcd_barrier_post(barw, bst);
#define GSYNC() xcd_barrier(xb)
    p0_prologue(p, ldsl, G);
    GSYNC();
    if (blockIdx.x == 0 && threadIdx.x == 0) __hip_atomic_store(barw + 16384 - 64, 0u, __ATOMIC_RELAXED, __HIP_MEMORY_SCOPE_AGENT);
    { pg8::Gemm g{XB, (const bf16*)(ws + WS_WGU1), S, 2 * DFF, DM}; pg8::StaticOrder so; so.init(S, 2 * DFF, G, (int)blockIdx.x);
      const int pm0 = fill_rtab(so, SS0, rtab); pg8::EpiSwiGLU E{HB, DFF, SS0, rtab, pm0}; pg8::gemm_phase<pg8::EpiSwiGLU, pg8::StaticOrder, true, true>(ldsl, g, so, E); }
    { int sgw, sng; if (slack_rank((S / 256) * (2 * DFF / 256), G, sgw, sng)) { LAS float* scr = (LAS float*)(ldsl + (threadIdx.x >> 6) * 8448); const int lane = threadIdx.x & 63;
        slack1_items(p, scr, lane, sgw, sng); } }
    GSYNC();
    { pg8::Gemm g{HB, (const bf16*)(ws + WS_WD1), S, DM, DFF}; pg8::StaticOrder so; so.init(S, DM, G, (int)blockIdx.x);
      pg8::EpiResid<true> E{nullptr, XB, SS1, 0.5f}; pg8::gemm_phase<pg8::EpiResid<true>, pg8::StaticOrder, true, true>(ldsl, g, so, E); }
    GSYNC();
    { pg8::Gemm g{XB, (const bf16*)(ws + WS_WIN), S, NPROJ, DM}; pg8::StaticOrder so; so.init(S, NPROJ, G, (int)blockIdx.x);
      const int pm0 = fill_rtab(so, SS1, rtab); pg8::EpiProj E{HB, NPROJ, SS1, (float*)(ws + WS_GATES), p.bg, 10, rtab, pm0}; pg8::gemm_phase<pg8::EpiProj, pg8::StaticOrder, true, true>(ldsl, g, so, E); }
    { int sgw, sng; if (slack_rank((S / 256) * (NPROJ / 256), G, sgw, sng)) { LAS float* scr = (LAS float*)(ldsl + (threadIdx.x >> 6) * 8448); cvt_gu(p, 1, scr, threadIdx.x & 63, sgw, sng); } }
    GSYNC();
    m1_phase(p, lds, G);
    GSYNC();
    m2_phase(p, lds, G);
    GSYNC();
    m3_phase(p, lds, G);
    GSYNC();
    { pg8::Gemm g{MIX, (const bf16*)(ws + WS_WOUT), S, DM, DM}; pg8::StaticOrder so; so.init(S, DM, G, (int)blockIdx.x);
      pg8::EpiResid<true> E{nullptr, XB, SS2, 1.0f}; pg8::gemm_phase<pg8::EpiResid<true>, pg8::StaticOrder, true, true>(ldsl, g, so, E); }
    GSYNC();
    { pg8::Gemm g{XB, (const bf16*)(ws + WS_WGU2), S, 2 * DFF, DM}; pg8::StaticOrder so; so.init(S, 2 * DFF, G, (int)blockIdx.x);
      const int pm0 = fill_rtab(so, SS2, rtab); pg8::EpiSwiGLU E{HB, DFF, SS2, rtab, pm0}; pg8::gemm_phase<pg8::EpiSwiGLU, pg8::StaticOrder, true, true>(ldsl, g, so, E); }
    { int sgw, sng; if (slack_rank((S / 256) * (2 * DFF / 256), G, sgw, sng)) cvt_down(p, 1, (LAS float*)(ldsl + (threadIdx.x >> 6) * 8448), threadIdx.x & 63, sgw, sng); }
    GSYNC();
    { pg8::Gemm g{HB, (const bf16*)(ws + WS_WD2), S, DM, DFF}; pg8::StaticOrder so; so.init(S, DM, G, (int)blockIdx.x);
      pg8::EpiFinal E{XB, p.out, SS3, (unsigned*)(ws + WS_PCNT), p.nf, 0.5f}; pg8::gemm_phase<pg8::EpiFinal, pg8::StaticOrder, true, true>(ldsl, g, so, E); }
}

extern "C" void kernel_launch(void* const* d_in, const int* in_sizes, int n_in, void* d_out, int out_size, void* d_ws, size_t ws_size, hipStream_t stream) {
    static int grid_blocks = 0;
    if (grid_blocks == 0) {
        if (n_in != 19 || out_size != S * DM || ws_size < WS_END) { fprintf(stderr, "kernel_launch: unexpected problem (n_in %d, out %d, ws %zu)\n", n_in, out_size, ws_size); grid_blocks = -1; return; }
        int dev = 0, cus = 0, per_cu = 0;
        (void)hipGetDevice(&dev);
        (void)hipDeviceGetAttribute(&cus, hipDeviceAttributeMultiprocessorCount, dev);
        if (hipFuncSetAttribute((const void*)fwd_megakernel, hipFuncAttributeMaxDynamicSharedMemorySize, LDS_BYTES) != hipSuccess) { fprintf(stderr, "kernel_launch: hipFuncSetAttribute failed\n"); grid_blocks = -1; return; }
        if (hipOccupancyMaxActiveBlocksPerMultiprocessor(&per_cu, (const void*)fwd_megakernel, 512, LDS_BYTES) != hipSuccess || per_cu < 1) { fprintf(stderr, "kernel_launch: occupancy query gave %d\n", per_cu); per_cu = 1; }
        (void)hipGetLastError();
        grid_blocks = cus * 1;
        if (grid_blocks <= 0) grid_blocks = 256;
    }
    if (grid_blocks < 0) return;
    Params p{};
    p.x = (const float*)d_in[0]; p.n1 = (const float*)d_in[1]; p.wg1 = (const float*)d_in[2]; p.wu1 = (const float*)d_in[3]; p.wd1 = (const float*)d_in[4];
    p.nmix = (const float*)d_in[5]; p.win = (const float*)d_in[6]; p.bg = (const float*)d_in[7]; p.convw = (const float*)d_in[8]; p.convb = (const float*)d_in[9]; p.mhn = (const float*)d_in[10];
    p.poolw = (const float*)d_in[11]; p.pools = (const float*)d_in[12]; p.wout = (const float*)d_in[13]; p.n2 = (const float*)d_in[14]; p.wg2 = (const float*)d_in[15]; p.wu2 = (const float*)d_in[16]; p.wd2 = (const float*)d_in[17]; p.nf = (const float*)d_in[18];
    p.out = (float*)d_out; p.ws = (unsigned char*)d_ws;
    void* args[] = {&p};
    hipError_t e = hipLaunchCooperativeKernel((const void*)fwd_megakernel, dim3(grid_blocks), dim3(512), args, LDS_BYTES, stream);
    if (e != hipSuccess) fprintf(stderr, "cooperative launch failed: %s (grid %d)\n", hipGetErrorString(e), grid_blocks);
}
```

```cpp
#include <hip/hip_runtime.h>
#include <hip/hip_cooperative_groups.h>
#include <cstdio>
#include <cstdint>
namespace cg = cooperative_groups;

#define LAS __attribute__((address_space(3)))
typedef unsigned short bf16;
typedef short bf16x8 __attribute__((ext_vector_type(8)));
typedef float f32x4 __attribute__((ext_vector_type(4)));
typedef unsigned u32x4 __attribute__((ext_vector_type(4)));
typedef unsigned u32x2 __attribute__((ext_vector_type(2)));

constexpr int S = 16384, DM = 1024, DFF = 2816, NPROJ = 2816  , DINP = 2568;
constexpr int NCH = 256, CL = 64, NH = 4, HD = 128;
constexpr float EPS = 1e-6f;

constexpr size_t MiB = 1u << 20;
constexpr size_t WS_SS0 = 0 * MiB, WS_SS1 = 1 * MiB, WS_SS2 = 2 * MiB, WS_SS3 = 3 * MiB;
constexpr size_t WS_GATES = 4 * MiB;
constexpr size_t WS_DN = 4 * MiB + 512 * 1024;
constexpr size_t WS_BAR = 5 * MiB + 512 * 1024;
constexpr size_t WS_PCNT = WS_BAR + 16384;
constexpr size_t WS_SC = 5 * MiB;
constexpr size_t WS_WGU1 = 6 * MiB;
constexpr size_t WS_WD1 = 17 * MiB;
constexpr size_t WS_WGU2 = 23 * MiB;
constexpr size_t WS_WD2 = 34 * MiB;
constexpr size_t WS_WIN = 40 * MiB;
constexpr size_t WS_WOUT = 46 * MiB;
constexpr size_t WS_HB = 48 * MiB;
constexpr size_t WS_MIX = 136 * MiB;
constexpr size_t WS_XB = 168 * MiB;
constexpr size_t WS_END = 200 * MiB;

constexpr int LDS_RTAB = 131072 + 256;
constexpr int LDS_BYTES = 131072 + 256 + 1024;

namespace pg8 {
#define PG8_LAS __attribute__((address_space(3)))
typedef unsigned short bf16_t;
constexpr int BM = 256, BK = 64, HALF = 128, HTB = HALF * BK * 2, STAGE_BYTES = 8 * HTB, NXCD = 8, WGM = 8;

__host__ __device__ __forceinline__ int lds_byte(int r, int c) { const int st = (r >> 4) * 2 + (c >> 5), rr = r & 15, cc = c & 31, ob = rr * 64 + cc * 2; return st * 1024 + (ob ^ (((ob >> 9) & 1) << 5)); }
__host__ __device__ __forceinline__ void stage_rc(int b, int& R, int& C) { const int st = b / 1024, sb = b % 1024, swz = sb ^ (((sb >> 9) & 1) << 5); R = (st >> 1) * 16 + swz / 64; C = (st & 1) * 32 + (swz % 64) / 2; }
__host__ __device__ __forceinline__ int perm32(int rho) { const int n = rho >> 4, i = rho & 15; return 8 * (i >> 2) + 4 * n + (i & 3); }

struct Unit { int pm, pn; };
struct Gemm { const bf16_t* A; const bf16_t* Bt; int M, N, K; };

struct StaticOrder {
    int nM, nN, nwg, G, c;
    __host__ __device__ void init(int M, int N, int G_, int c_) { nM = M / BM; nN = N / BM; nwg = nM * nN; G = G_; c = c_; }
    __host__ __device__ bool next(int i, Unit& u) const {
        const long L = (long)i * G + c; if (L >= nwg) return false;
        int wgid = (int)L; { const int q = nwg / NXCD, r = nwg % NXCD, xcd = wgid % NXCD, off = wgid / NXCD; wgid = (xcd < r ? xcd * (q + 1) : r * (q + 1) + (xcd - r) * q) + off; }
        const int nig = WGM * nN, gid = wgid / nig, fm = gid * WGM, gsz = (nM - fm) < WGM ? (nM - fm) : WGM;
        u.pm = fm + ((wgid % nig) % gsz); u.pn = (wgid % nig) / gsz; return true;
    }
    __device__ __forceinline__ void a_ready(const Unit&) const {}
    __device__ __forceinline__ void done(const Unit&) const {}
};

__device__ __forceinline__ unsigned cvt_pk_bf16(float lo, float hi) { unsigned r; asm volatile("v_cvt_pk_bf16_f32 %0, %1, %2" : "=v"(r) : "v"(lo), "v"(hi)); return r; }

__device__ __forceinline__ float row_rstd(const float* ss, int row) {
    const f32x4* p = (const f32x4*)(ss + (size_t)row * 16);
    const f32x4 a = p[0], b = p[1], c = p[2], d = p[3];
    const float s = (((a[0] + a[1]) + (a[2] + a[3])) + ((b[0] + b[1]) + (b[2] + b[3]))) + (((c[0] + c[1]) + (c[2] + c[3])) + ((d[0] + d[1]) + (d[2] + d[3])));
    return 1.0f / sqrtf(s * (1.0f / 1024.0f) + 1e-6f);
}
__device__ __forceinline__ float silu_f(float g) { return g * __builtin_amdgcn_rcpf(1.0f + __expf(-g)); }
typedef float f32x2 __attribute__((ext_vector_type(2)));
__device__ __forceinline__ f32x2 swiglu_pk(f32x2 g, f32x2 u, float c, float r2) {
    const f32x2 t = g * c;
    f32x2 e; e.x = __builtin_amdgcn_exp2f(t.x); e.y = __builtin_amdgcn_exp2f(t.y);
    const f32x2 d = e + 1.0f;
    f32x2 s; s.x = __builtin_amdgcn_rcpf(d.x); s.y = __builtin_amdgcn_rcpf(d.y);
    return (g * u) * (s * r2);
}

struct EpiSwiGLU {
    static constexpr bool PERM = true, AFTER_DRAIN = false;
    bf16_t* H; int ldh; const float* ss; const PG8_LAS float* rtab; int rt_pm;
    __device__ __forceinline__ void operator()(const f32x4 (&acc)[2][2][4][2], const Unit& u, int wr, int wc, int fr, int fq) const {
        const int row0 = u.pm * BM + wr * 64 + fr, col0 = u.pn * HALF + wc * 32 + 8 * fq; const bool tab = (u.pm == rt_pm);
#pragma unroll
        for (int ai = 0; ai < 2; ++ai)
#pragma unroll
            for (int m = 0; m < 4; ++m) {
                const int row = row0 + ai * HALF + m * 16; const float r = tab ? rtab[row - u.pm * BM] : row_rstd(ss, row);
                const float c = r * -1.4426950408889634f, r2 = r * r;
                const f32x4 G0 = acc[ai][0][m][0], G1 = acc[ai][0][m][1], U0 = acc[ai][1][m][0], U1 = acc[ai][1][m][1];
                const f32x2 h0 = swiglu_pk((f32x2){G0[0], G0[1]}, (f32x2){U0[0], U0[1]}, c, r2), h1 = swiglu_pk((f32x2){G0[2], G0[3]}, (f32x2){U0[2], U0[3]}, c, r2);
                const f32x2 h2 = swiglu_pk((f32x2){G1[0], G1[1]}, (f32x2){U1[0], U1[1]}, c, r2), h3 = swiglu_pk((f32x2){G1[2], G1[3]}, (f32x2){U1[2], U1[3]}, c, r2);
                u32x4 w;
                w.x = cvt_pk_bf16(h0.x, h0.y); w.y = cvt_pk_bf16(h1.x, h1.y); w.z = cvt_pk_bf16(h2.x, h2.y); w.w = cvt_pk_bf16(h3.x, h3.y);
                *(u32x4*)(H + (size_t)row * ldh + col0) = w;
            }
    }
};
struct EpiProj {
    static constexpr bool PERM = true, AFTER_DRAIN = false;
    bf16_t* P; int ldp; const float* ss; float* gates; const float* bg; int gate_tile; const PG8_LAS float* rtab; int rt_pm;
    __device__ __forceinline__ void operator()(const f32x4 (&acc)[2][2][4][2], const Unit& u, int wr, int wc, int fr, int fq) const {
        const int row0 = u.pm * BM + wr * 64 + fr, col0 = u.pn * BM + wc * 32 + 8 * fq; const bool tab = (u.pm == rt_pm);
        if (u.pn < gate_tile) {
#pragma unroll
            for (int ai = 0; ai < 2; ++ai)
#pragma unroll
                for (int m = 0; m < 4; ++m) {
                    const int row = row0 + ai * HALF + m * 16; const float r = tab ? rtab[row - u.pm * BM] : row_rstd(ss, row);
#pragma unroll
                    for (int bj = 0; bj < 2; ++bj) {
                        const f32x4 v0 = acc[ai][bj][m][0] * r, v1 = acc[ai][bj][m][1] * r;
                        u32x4 w; w.x = cvt_pk_bf16(v0[0], v0[1]); w.y = cvt_pk_bf16(v0[2], v0[3]); w.z = cvt_pk_bf16(v1[0], v1[1]); w.w = cvt_pk_bf16(v1[2], v1[3]);
                        *(u32x4*)(P + (size_t)row * ldp + col0 + bj * HALF) = w;
                    }
                }
        } else if (wc == 0 && fq == 0) {
            const f32x4 b0 = *(const f32x4*)bg, b1 = *(const f32x4*)(bg + 4);
#pragma unroll
            for (int ai = 0; ai < 2; ++ai)
#pragma unroll
                for (int m = 0; m < 4; ++m) {
                    const int row = row0 + ai * HALF + m * 16; const float r = tab ? rtab[row - u.pm * BM] : row_rstd(ss, row);
                    *(f32x4*)(gates + (size_t)row * 8) = acc[ai][0][m][0] * r + b0;
                    *(f32x4*)(gates + (size_t)row * 8 + 4) = acc[ai][0][m][1] * r + b1;
                }
        }
    }
};
__device__ __forceinline__ void bf8_to_f32(const u32x4 v, f32x4& lo, f32x4& hi) {
    lo = (f32x4){__uint_as_float(v.x << 16), __uint_as_float(v.x & 0xffff0000u), __uint_as_float(v.y << 16), __uint_as_float(v.y & 0xffff0000u)};
    hi = (f32x4){__uint_as_float(v.z << 16), __uint_as_float(v.z & 0xffff0000u), __uint_as_float(v.w << 16), __uint_as_float(v.w & 0xffff0000u)};
}
template <bool XI_BF16> struct EpiResid {
    static constexpr bool PERM = true, AFTER_DRAIN = false;
    const float* xi; bf16_t* xb; float* ssout; float scale;
    __device__ __forceinline__ void operator()(const f32x4 (&acc)[2][2][4][2], const Unit& u, int wr, int wc, int fr, int fq) const {
        const int row0 = u.pm * BM + wr * 64 + fr, col0 = u.pn * BM + wc * 32 + 8 * fq;
#pragma unroll
        for (int ai = 0; ai < 2; ++ai) {
        u32x4 xin[1][4][2];
        if (XI_BF16) {
#pragma unroll
                for (int m = 0; m < 4; ++m)
#pragma unroll
                    for (int bj = 0; bj < 2; ++bj) xin[0][m][bj] = *(const u32x4*)(xb + (size_t)(row0 + ai * HALF + m * 16) * DM + col0 + bj * HALF);
        }
#pragma unroll
            for (int m = 0; m < 4; ++m) {
                const int row = row0 + ai * HALF + m * 16; const size_t off = (size_t)row * DM + col0; float q = 0.f;
#pragma unroll
                for (int bj = 0; bj < 2; ++bj) {
                    const size_t o2 = off + bj * HALF; f32x4 b0, b1;
                    if (XI_BF16) bf8_to_f32(xin[0][m][bj], b0, b1); else { b0 = *(const f32x4*)(xi + o2); b1 = *(const f32x4*)(xi + o2 + 4); }
                    const f32x4 o0 = b0 + acc[ai][bj][m][0] * scale, o1 = b1 + acc[ai][bj][m][1] * scale;
                    u32x4 w; w.x = cvt_pk_bf16(o0[0], o0[1]); w.y = cvt_pk_bf16(o0[2], o0[3]); w.z = cvt_pk_bf16(o1[0], o1[1]); w.w = cvt_pk_bf16(o1[2], o1[3]);
                    *(u32x4*)(xb + o2) = w;
                    q += ((o0[0] * o0[0] + o0[1] * o0[1]) + (o0[2] * o0[2] + o0[3] * o0[3])) + ((o1[0] * o1[0] + o1[1] * o1[1]) + (o1[2] * o1[2] + o1[3] * o1[3]));
                }
                q += __shfl_xor(q, 16); q += __shfl_xor(q, 32);
                if (fq == 0) ssout[(size_t)row * 16 + u.pn * 4 + wc] = q;
                if (!XI_BF16) asm volatile("" ::: "memory");
            }
            asm volatile("" ::: "memory");
        }
    }
};
struct EpiFinal {
    static constexpr bool PERM = true, AFTER_DRAIN = false;
    const bf16_t* xb; float* out; float* ss; unsigned* cnt; const float* gf; float scale;
    __device__ __forceinline__ void operator()(f32x4 (&acc)[2][2][4][2], const Unit& u, int wr, int wc, int fr, int fq) const {
        const int row0 = u.pm * BM + wr * 64 + fr, col0 = u.pn * BM + wc * 32 + 8 * fq;
#pragma unroll
        for (int ai = 0; ai < 2; ++ai) {
        u32x4 xin[4][2];
#pragma unroll
            for (int m = 0; m < 4; ++m)
#pragma unroll
                for (int bj = 0; bj < 2; ++bj) xin[m][bj] = *(const u32x4*)(xb + (size_t)(row0 + ai * HALF + m * 16) * DM + col0 + bj * HALF);
#pragma unroll
            for (int m = 0; m < 4; ++m) {
                const int row = row0 + ai * HALF + m * 16; float q = 0.f;
#pragma unroll
                for (int bj = 0; bj < 2; ++bj) {
                    f32x4 b0, b1; bf8_to_f32(xin[m][bj], b0, b1);
                    const f32x4 o0 = b0 + acc[ai][bj][m][0] * scale, o1 = b1 + acc[ai][bj][m][1] * scale;
                    acc[ai][bj][m][0] = o0; acc[ai][bj][m][1] = o1;
                    q += ((o0[0] * o0[0] + o0[1] * o0[1]) + (o0[2] * o0[2] + o0[3] * o0[3])) + ((o1[0] * o1[0] + o1[1] * o1[1]) + (o1[2] * o1[2] + o1[3] * o1[3]));
                }
                q += __shfl_xor(q, 16); q += __shfl_xor(q, 32);
                if (fq == 0) __hip_atomic_store((unsigned*)(ss + (size_t)row * 16 + u.pn * 4 + wc), __float_as_uint(q), __ATOMIC_RELAXED, __HIP_MEMORY_SCOPE_AGENT);
            }
            asm volatile("" ::: "memory");
        }
        asm volatile("s_waitcnt vmcnt(0)" ::: "memory");
        unsigned* pc = cnt + 64 * u.pm;
        if ((threadIdx.x & 63) == 0) __hip_atomic_fetch_add(pc, 1u, __ATOMIC_RELAXED, __HIP_MEMORY_SCOPE_AGENT);
        { unsigned sp = 0; while ((unsigned)__builtin_amdgcn_readfirstlane(__hip_atomic_load(pc, __ATOMIC_RELAXED, __HIP_MEMORY_SCOPE_AGENT)) < 32u) { __builtin_amdgcn_s_sleep(2); if (++sp > (1u << 20)) break; } }
        __builtin_amdgcn_fence(__ATOMIC_ACQUIRE, "agent");
        f32x4 gv[2][2];
#pragma unroll
        for (int bj = 0; bj < 2; ++bj) { gv[bj][0] = *(const f32x4*)(gf + col0 + bj * HALF); gv[bj][1] = *(const f32x4*)(gf + col0 + bj * HALF + 4); }
        f32x4 ptv[2][4];
#pragma unroll
        for (int ai = 0; ai < 2; ++ai)
#pragma unroll
            for (int m = 0; m < 4; ++m) ptv[ai][m] = *(const f32x4*)(ss + (size_t)(row0 + ai * HALF + m * 16) * 16 + fq * 4);
#pragma unroll
        for (int ai = 0; ai < 2; ++ai)
#pragma unroll
            for (int m = 0; m < 4; ++m) {
                const int row = row0 + ai * HALF + m * 16; const size_t off = (size_t)row * DM + col0;
                const f32x4 pt = ptv[ai][m];
                float s = (pt[0] + pt[1]) + (pt[2] + pt[3]); s += __shfl_xor(s, 16); s += __shfl_xor(s, 32);
                const float r = 1.0f / sqrtf(s * (1.0f / 1024.0f) + 1e-6f);
#pragma unroll
                for (int bj = 0; bj < 2; ++bj) { *(f32x4*)(out + off + bj * HALF) = acc[ai][bj][m][0] * r * gv[bj][0]; *(f32x4*)(out + off + bj * HALF + 4) = acc[ai][bj][m][1] * r * gv[bj][1]; }
            }
    }
};

template <class Epi, class Sched, bool ALIGN_EPI = false, bool SP2 = false>
__device__ __forceinline__ void gemm_phase(PG8_LAS unsigned char* lds, const Gemm g, const Sched& S, const Epi& E) {
    const int tid = threadIdx.x, wid = __builtin_amdgcn_readfirstlane(tid >> 6), lane = tid & 63, wr = wid >> 2, wc = wid & 3, fr = lane & 15, fq = lane >> 4;
    const int K = g.K, nt = K / BK;
    unsigned voffA[2], voffB[2];
#pragma unroll
    for (int i = 0; i < 2; ++i) { int R, C; stage_rc(tid * 16 + i * 8192, R, C); const int Rb = Epi::PERM ? ((R & ~31) + perm32(R & 31)) : R;
        voffA[i] = (unsigned)(R * K + C) * 2u; voffB[i] = (unsigned)(Rb * K + C) * 2u; }
    const size_t kstep = (size_t)(BK * 2);
    const size_t hstep = (size_t)HALF * K * 2;
    const size_t tstep = 2 * hstep;
    const unsigned ldsw = (unsigned)wid * 1024u;
    const int aoff = lds_byte(wr * 64 + fr, fq * 8), boff = lds_byte(wc * 32 + fr, fq * 8);
#define PG8_SA(b, h) (((b) * 2 + (h)) * HTB)
#define PG8_SB(b, h) ((4 + (b) * 2 + (h)) * HTB)
#define PG8_STAGE(bufoff, gbase, voff) do { _Pragma("unroll") for (int _i = 0; _i < 2; ++_i) \
        __builtin_amdgcn_global_load_lds((const unsigned*)((const char*)(gbase) + (voff)[_i]), (PG8_LAS unsigned*)(lds + (bufoff) + ldsw + _i * 8192), 16, 0, 0); } while (0)
#define PG8_LDA(dst, b, h) do { _Pragma("unroll") for (int m = 0; m < 4; ++m) _Pragma("unroll") for (int k = 0; k < 2; ++k) dst[m][k] = *(const PG8_LAS bf16x8*)(lds + PG8_SA(b, h) + aoff + m * 2048 + k * 1024); } while (0)
#define PG8_LDB(dst, b, h) do { _Pragma("unroll") for (int n = 0; n < 2; ++n) _Pragma("unroll") for (int k = 0; k < 2; ++k) dst[n][k] = *(const PG8_LAS bf16x8*)(lds + PG8_SB(b, h) + boff + n * 2048 + k * 1024); } while (0)
#define PG8_MMA(ai, bj, At, Bt) do { __builtin_amdgcn_s_setprio(1); _Pragma("unroll") for (int m = 0; m < 4; ++m) _Pragma("unroll") for (int n = 0; n < 2; ++n) _Pragma("unroll") for (int k = 0; k < 2; ++k) \
        acc[ai][bj][m][n] = __builtin_amdgcn_mfma_f32_16x16x32_bf16(Bt[n][k], At[m][k], acc[ai][bj][m][n], 0, 0, 0); __builtin_amdgcn_s_setprio(0); } while (0)
#define PG8_WAIT_V(n) asm volatile("s_waitcnt vmcnt(" #n ")" ::: "memory")
#define PG8_WAIT_L(n) asm volatile("s_waitcnt lgkmcnt(" #n ")" ::: "memory")
#define PG8_BAR __builtin_amdgcn_s_barrier()
#define PG8_SCHED __builtin_amdgcn_sched_barrier(0)
    Unit cur, nxt; int ui = 0;
    if (!S.next(0, cur)) return;
    f32x4 acc[2][2][4][2];
#pragma unroll
    for (int a = 0; a < 2; ++a)
#pragma unroll
        for (int b = 0; b < 2; ++b)
#pragma unroll
            for (int m = 0; m < 4; ++m)
#pragma unroll
                for (int n = 0; n < 2; ++n) acc[a][b][m][n] = (f32x4){0.f, 0.f, 0.f, 0.f};
    bf16x8 At[4][2], B0[2][2], B1[2][2];
    const char* cA = (const char*)g.A + (size_t)cur.pm * tstep; const char* cB = (const char*)g.Bt + (size_t)cur.pn * tstep;
    S.a_ready(cur);
    if constexpr (SP2) {
        PG8_STAGE(PG8_SB(0, 0), cB, voffB); PG8_STAGE(PG8_SB(0, 1), cB + hstep, voffB); PG8_STAGE(PG8_SA(0, 0), cA, voffA); PG8_STAGE(PG8_SA(0, 1), cA + hstep, voffA);
        if (wr == 1) PG8_BAR;
        PG8_WAIT_V(2); PG8_BAR;
        PG8_STAGE(PG8_SB(1, 0), cB + kstep, voffB); PG8_STAGE(PG8_SA(1, 0), cA + kstep, voffA); PG8_STAGE(PG8_SB(1, 1), cB + hstep + kstep, voffB);
        PG8_WAIT_V(6); PG8_BAR;
    } else {
        PG8_STAGE(PG8_SB(0, 0), cB, voffB); PG8_STAGE(PG8_SA(0, 0), cA, voffA); PG8_STAGE(PG8_SB(0, 1), cB + hstep, voffB); PG8_STAGE(PG8_SA(0, 1), cA + hstep, voffA);
        if (wr == 1) PG8_BAR;
        PG8_WAIT_V(4); PG8_BAR;
        PG8_STAGE(PG8_SB(1, 0), cB + kstep, voffB); PG8_STAGE(PG8_SA(1, 0), cA + kstep, voffA); PG8_STAGE(PG8_SB(1, 1), cB + hstep + kstep, voffB);
        PG8_WAIT_V(6); PG8_BAR;
    }
    for (;;) {
        const bool has_next = S.next(ui + 1, nxt);
        const char* nA = has_next ? (const char*)g.A + (size_t)nxt.pm * tstep : cA; const char* nB = has_next ? (const char*)g.Bt + (size_t)nxt.pn * tstep : cB;
        for (int t = 0; t < nt; t += 2) {
            const bool last = (t == nt - 2);
            const char* a1 = cA + (size_t)(t + 1) * kstep;
            const char* a2 = last ? nA : cA + (size_t)(t + 2) * kstep; const char* b2 = last ? nB : cB + (size_t)(t + 2) * kstep;
            const char* a3 = a2 + kstep; const char* b3 = b2 + kstep;
            if (last && has_next) S.a_ready(nxt);
            if constexpr (SP2) {
            PG8_LDB(B0, 0, 0); PG8_LDB(B1, 0, 1); PG8_SCHED; PG8_LDA(At, 0, 0); PG8_STAGE(PG8_SA(1, 1), a1 + hstep, voffA);
            PG8_WAIT_V(8); PG8_WAIT_L(0); PG8_BAR; PG8_MMA(0, 0, At, B0); PG8_MMA(0, 1, At, B1); PG8_BAR; PG8_SCHED;
            PG8_LDA(At, 0, 1); PG8_STAGE(PG8_SB(0, 0), b2, voffB); PG8_STAGE(PG8_SB(0, 1), b2 + hstep, voffB); PG8_STAGE(PG8_SA(0, 0), a2, voffA);
            PG8_WAIT_V(8); PG8_WAIT_L(0); PG8_BAR; PG8_MMA(1, 0, At, B0); PG8_MMA(1, 1, At, B1); PG8_BAR; PG8_SCHED;
            PG8_LDB(B0, 1, 0); PG8_LDB(B1, 1, 1); PG8_SCHED; PG8_LDA(At, 1, 0); PG8_STAGE(PG8_SA(0, 1), a2 + hstep, voffA);
            PG8_WAIT_V(8); PG8_WAIT_L(0); PG8_BAR; PG8_MMA(0, 0, At, B0); PG8_MMA(0, 1, At, B1); PG8_BAR; PG8_SCHED;
            PG8_LDA(At, 1, 1); PG8_STAGE(PG8_SB(1, 0), b3, voffB); PG8_STAGE(PG8_SB(1, 1), b3 + hstep, voffB); PG8_STAGE(PG8_SA(1, 0), a3, voffA);
            PG8_WAIT_V(8); PG8_WAIT_L(0); PG8_BAR; PG8_MMA(1, 0, At, B0); PG8_MMA(1, 1, At, B1); PG8_BAR; PG8_SCHED;
            } else {
            PG8_LDB(B0, 0, 0); PG8_SCHED; PG8_LDA(At, 0, 0); PG8_STAGE(PG8_SA(1, 1), a1 + hstep, voffA);
            PG8_WAIT_L(8); PG8_BAR; PG8_WAIT_L(0); PG8_MMA(0, 0, At, B0); PG8_BAR; PG8_SCHED;
            PG8_LDB(B1, 0, 1); PG8_STAGE(PG8_SB(0, 0), b2, voffB);
            PG8_BAR; PG8_WAIT_L(0); PG8_MMA(0, 1, At, B1); PG8_BAR;
            PG8_LDA(At, 0, 1); PG8_STAGE(PG8_SA(0, 0), a2, voffA);
            PG8_BAR; PG8_WAIT_L(0); PG8_MMA(1, 0, At, B0); PG8_BAR; PG8_SCHED;
            PG8_STAGE(PG8_SB(0, 1), b2 + hstep, voffB);
            PG8_WAIT_V(6); PG8_BAR; PG8_MMA(1, 1, At, B1); PG8_BAR;
            PG8_LDB(B0, 1, 0); PG8_SCHED; PG8_LDA(At, 1, 0); PG8_STAGE(PG8_SA(0, 1), a2 + hstep, voffA);
            PG8_WAIT_L(8); PG8_BAR; PG8_WAIT_L(0); PG8_MMA(0, 0, At, B0); PG8_BAR; PG8_SCHED;
            PG8_LDB(B1, 1, 1); PG8_STAGE(PG8_SB(1, 0), b3, voffB);
            PG8_BAR; PG8_WAIT_L(0); PG8_MMA(0, 1, At, B1); PG8_BAR;
            PG8_LDA(At, 1, 1); PG8_STAGE(PG8_SA(1, 0), a3, voffA);
            PG8_BAR; PG8_WAIT_L(0); PG8_MMA(1, 0, At, B0); PG8_BAR; PG8_SCHED;
            PG8_STAGE(PG8_SB(1, 1), b3 + hstep, voffB);
            PG8_WAIT_V(6); PG8_BAR; PG8_MMA(1, 1, At, B1); PG8_BAR;
            }
        }
        if constexpr (ALIGN_EPI) { if (wr == 0) PG8_BAR; }
        if constexpr (!Epi::AFTER_DRAIN) { E(acc, cur, wr, wc, fr, fq); S.done(cur); }
        if (!has_next) break;
#pragma unroll
        for (int a = 0; a < 2; ++a)
#pragma unroll
            for (int b = 0; b < 2; ++b)
#pragma unroll
                for (int m = 0; m < 4; ++m)
#pragma unroll
                    for (int n = 0; n < 2; ++n) acc[a][b][m][n] = (f32x4){0.f, 0.f, 0.f, 0.f};
        cur = nxt; cA = nA; cB = nB; ++ui;
        if constexpr (ALIGN_EPI) { if (wr == 1) PG8_BAR; }
    }
    PG8_WAIT_V(0);
    if constexpr (!ALIGN_EPI) { if (wr == 0) PG8_BAR; }
    PG8_BAR;
#undef PG8_SA
#undef PG8_SB
#undef PG8_STAGE
#undef PG8_LDA
#undef PG8_LDB
#undef PG8_MMA
#undef PG8_WAIT_V
#undef PG8_WAIT_L
#undef PG8_BAR
#undef PG8_SCHED
}
}

#define LDS_WAIT() asm volatile("s_waitcnt lgkmcnt(0)" ::: "memory")
__device__ __forceinline__ unsigned f2bf(float f) { unsigned u = __builtin_bit_cast(unsigned, f); return (u + 0x7fffu + ((u >> 16) & 1u)) >> 16; }
__device__ __forceinline__ unsigned pk2(float lo, float hi) { return f2bf(lo) | (f2bf(hi) << 16); }
__device__ __forceinline__ float bf2f(unsigned b) { return __uint_as_float(b << 16); }
__device__ __forceinline__ float wave_sum(float v) {
#pragma unroll
    for (int o = 1; o < 64; o <<= 1) v += __shfl_xor(v, o);
    return v;
}
__device__ __forceinline__ float wave_max(float v) {
#pragma unroll
    for (int o = 1; o < 64; o <<= 1) v = fmaxf(v, __shfl_xor(v, o));
    return v;
}
__device__ __forceinline__ float wave_incl_sum(float v, int lane) {
#pragma unroll
    for (int o = 1; o < 64; o <<= 1) { const float t = __shfl_up(v, o); if (lane >= o) v += t; }
    return v;
}
__device__ __forceinline__ float wave_incl_max(float v, int lane) {
#pragma unroll
    for (int o = 1; o < 64; o <<= 1) { const float t = __shfl_up(v, o); if (lane >= o) v = fmaxf(v, t); }
    return v;
}
__device__ __forceinline__ float log_sigmoid_f(float x) { return fminf(x, 0.f) - log1pf(expf(-fabsf(x))); }

struct TItem { const float* W; int ldw, src_col0; bf16* WT; int K, dst_row0, k0; const float* gk; };
__device__ __forceinline__ void titem_load(const TItem& t, float (&wv)[32], f32x4 (&gv)[2], int lane) {
    const float* wp = t.W + (size_t)(t.k0 + (lane >> 5)) * t.ldw + t.src_col0 + (lane & 31);
#pragma unroll
    for (int i = 0; i < 32; ++i) wv[i] = __builtin_nontemporal_load(wp + (size_t)(2 * i) * t.ldw);
    if (t.gk) { gv[0] = *(const f32x4*)(t.gk + t.k0 + 8 * (lane & 7)); gv[1] = *(const f32x4*)(t.gk + t.k0 + 8 * (lane & 7) + 4); }
    else { gv[0] = (f32x4){1.f, 1.f, 1.f, 1.f}; gv[1] = gv[0]; }
}
__device__ __forceinline__ void titem_finish(const TItem& t, const float (&wv)[32], const f32x4 (&gv)[2], LAS float* scr, int lane) {
#pragma unroll
    for (int i = 0; i < 32; ++i) scr[(2 * i + (lane >> 5)) * 33 + (lane & 31)] = wv[i];
    LDS_WAIT(); asm volatile("" ::: "memory");
    const int c = lane & 7;
#pragma unroll
    for (int j = 0; j < 4; ++j) { const int n = (lane >> 3) + 8 * j; const LAS float* s = scr + (8 * c) * 33 + n;
        u32x4 o; o.x = pk2(s[0 * 33] * gv[0][0], s[1 * 33] * gv[0][1]); o.y = pk2(s[2 * 33] * gv[0][2], s[3 * 33] * gv[0][3]);
        o.z = pk2(s[4 * 33] * gv[1][0], s[5 * 33] * gv[1][1]); o.w = pk2(s[6 * 33] * gv[1][2], s[7 * 33] * gv[1][3]);
        *(u32x4*)(t.WT + (size_t)(t.dst_row0 + n) * t.K + t.k0 + 8 * c) = o; }
    LDS_WAIT(); asm volatile("" ::: "memory");
}
__device__ __forceinline__ void p0_item(const float* W, int ldw, int src_col0, bf16* WT, int K, int dst_row0, int k0, const float* gk, LAS float* scr, int lane) {
    const TItem t{W, ldw, src_col0, WT, K, dst_row0, k0, gk}; float wv[32]; f32x4 gv[2];
    titem_load(t, wv, gv, lane); titem_finish(t, wv, gv, scr, lane);
}
__device__ __forceinline__ void titem_pair(const TItem& a, const TItem& b, LAS float* scr, int lane) {
    float wa[32], wb[32]; f32x4 ga[2], gb[2];
    titem_load(a, wa, ga, lane); titem_load(b, wb, gb, lane);
    titem_finish(a, wa, ga, scr, lane); titem_finish(b, wb, gb, scr, lane);
}

struct Params {
    const float* x; const float* n1; const float* wg1; const float* wu1; const float* wd1;
    const float* nmix; const float* win; const float* bg; const float* convw; const float* convb; const float* mhn;
    const float* poolw; const float* pools; const float* wout; const float* n2; const float* wg2; const float* wu2; const float* wd2; const float* nf;
    float* out; unsigned char* ws;
};

__device__ __forceinline__ void cvt_gu(const Params& p, int set, LAS float* scr, int lane, int gw, int NGW) {
    constexpr int I_GU = 16 * 88;
    bf16* WT = (bf16*)(p.ws + (set ? WS_WGU2 : WS_WGU1)); const float* gk = set ? p.n2 : p.n1;
    auto mk = [&](int it) { const int up = it / I_GU, r = it - up * I_GU, kb = r / 88, nb = r % 88, n0 = 32 * nb;
        const float* W = set ? (up ? p.wu2 : p.wg2) : (up ? p.wu1 : p.wg1);
        return TItem{W, DFF, n0, WT, DM, (n0 >> 7) * 256 + (n0 & 127) + up * 128, 64 * kb, gk}; };
    int it = gw;
    for (; it + NGW < 2 * I_GU; it += 2 * NGW) titem_pair(mk(it), mk(it + NGW), scr, lane);
    if (it < 2 * I_GU) { const TItem t = mk(it); p0_item(t.W, t.ldw, t.src_col0, t.WT, t.K, t.dst_row0, t.k0, t.gk, scr, lane); }
}
__device__ __forceinline__ void cvt_down(const Params& p, int set, LAS float* scr, int lane, int gw, int NGW) {
    auto mk = [&](int it) { const int kb = it / 32, nb = it % 32; return TItem{set ? p.wd2 : p.wd1, DM, 32 * nb, (bf16*)(p.ws + (set ? WS_WD2 : WS_WD1)), DFF, 32 * nb, 64 * kb, nullptr}; };
    int it = gw;
    for (; it + NGW < 44 * 32; it += 2 * NGW) titem_pair(mk(it), mk(it + NGW), scr, lane);
    if (it < 44 * 32) { const TItem t = mk(it); p0_item(t.W, t.ldw, t.src_col0, t.WT, t.K, t.dst_row0, t.k0, t.gk, scr, lane); }
}
__device__ __forceinline__ void cvt_in(const Params& p, LAS float* scr, int lane, int gw, int NGW) {
    bf16* WIN = (bf16*)(p.ws + WS_WIN);
    for (int it = gw; it < 16 * 64 + 16 * 16; it += NGW) {
        if (it < 16 * 64) { const int kb = it / 64, nb = it % 64; p0_item(p.win, DINP, 32 * nb, WIN, DM, 32 * nb, 64 * kb, p.nmix, scr, lane); }
        else { const int r = it - 16 * 64, kb = r / 16, nb = r % 16; p0_item(p.win, DINP, 2056 + 32 * nb, WIN, DM, 2048 + 32 * nb, 64 * kb, p.nmix, scr, lane); }
    }
    for (int wi = gw; wi < 512; wi += NGW) {
        const int idx = wi * 64 + lane, rr = idx >> 7, kc = (idx & 127) * 8;
        u32x4 o = (u32x4){0u, 0u, 0u, 0u};
        if (rr < 8) {
            float v[8];
#pragma unroll
            for (int e = 0; e < 8; ++e) v[e] = p.win[(size_t)(kc + e) * DINP + 2048 + rr] * p.nmix[kc + e];
            o.x = pk2(v[0], v[1]); o.y = pk2(v[2], v[3]); o.z = pk2(v[4], v[5]); o.w = pk2(v[6], v[7]);
        }
        *(u32x4*)(WIN + (size_t)(2560 + rr) * DM + kc) = o;
    }
}
__device__ __forceinline__ void cvt_out(const Params& p, LAS float* scr, int lane, int gw, int NGW) {
    bf16* WOUT = (bf16*)(p.ws + WS_WOUT);
    for (int it = gw; it < 8 * 32; it += NGW) { const int kb = it / 32, nb = it % 32; p0_item(p.wout, DM, 32 * nb, WOUT, DM, 32 * nb, 64 * kb, nullptr, scr, lane); }
    for (int wi = gw; wi < 1024; wi += NGW) {
        const int nblk = wi & 15, cgp = (wi >> 4) & 15, g = wi >> 8, n = nblk * 64 + lane, c0 = cgp * 8;
        float a[8];
#pragma unroll
        for (int e = 0; e < 8; ++e) a[e] = 0.f;
        const float* pw = p.poolw + (size_t)(g * 128 + c0) * 128; const float* ps = p.pools + g * 128; const float* wo = p.wout + (size_t)(512 + g * 128) * DM + n;
        for (int d0 = 0; d0 < 128; d0 += 32) {
            float wv[32];
#pragma unroll
            for (int dd = 0; dd < 32; ++dd) wv[dd] = wo[(size_t)(d0 + dd) * DM];
#pragma unroll
            for (int dd = 0; dd < 32; ++dd) { const float w = wv[dd] * ps[d0 + dd];
#pragma unroll
                for (int e = 0; e < 8; ++e) a[e] += pw[e * 128 + d0 + dd] * w; }
        }
        u32x4 o; o.x = pk2(a[0], a[1]); o.y = pk2(a[2], a[3]); o.z = pk2(a[4], a[5]); o.w = pk2(a[6], a[7]);
        *(u32x4*)(WOUT + (size_t)n * DM + 512 + g * 128 + c0) = o;
    }
}
__device__ __forceinline__ void slack1_items(const Params& p, LAS float* scr, int lane, int gw, int NGW) {
    constexpr int N_D = 44 * 32, N_IN = 16 * 64 + 16 * 16, N_G = 512, N_O = 8 * 32, N_F = 1024;
    bf16* WIN = (bf16*)(p.ws + WS_WIN); bf16* WOUT = (bf16*)(p.ws + WS_WOUT);
    auto mkt = [&](int it) {
        if (it < N_D) { const int kb = it / 32, nb = it % 32; return TItem{p.wd1, DM, 32 * nb, (bf16*)(p.ws + WS_WD1), DFF, 32 * nb, 64 * kb, nullptr}; }
        it -= N_D;
        if (it < 16 * 64) { const int kb = it / 64, nb = it % 64; return TItem{p.win, DINP, 32 * nb, WIN, DM, 32 * nb, 64 * kb, p.nmix}; }
        const int r = it - 16 * 64, kb = r / 16, nb = r % 16; return TItem{p.win, DINP, 2056 + 32 * nb, WIN, DM, 2048 + 32 * nb, 64 * kb, p.nmix}; };
    int first = gw;
    if (gw + NGW < N_D + N_IN) { titem_pair(mkt(gw), mkt(gw + NGW), scr, lane); first = gw + 2 * NGW; }
    for (int it0 = first; it0 < N_D + N_IN + N_G + N_O + N_F; it0 += NGW) {
        int it = it0;
        if (it < N_D) { const int kb = it / 32, nb = it % 32; p0_item(p.wd1, DM, 32 * nb, (bf16*)(p.ws + WS_WD1), DFF, 32 * nb, 64 * kb, nullptr, scr, lane); continue; }
        it -= N_D;
        if (it < N_IN) {
            if (it < 16 * 64) { const int kb = it / 64, nb = it % 64; p0_item(p.win, DINP, 32 * nb, WIN, DM, 32 * nb, 64 * kb, p.nmix, scr, lane); }
            else { const int r = it - 16 * 64, kb = r / 16, nb = r % 16; p0_item(p.win, DINP, 2056 + 32 * nb, WIN, DM, 2048 + 32 * nb, 64 * kb, p.nmix, scr, lane); }
            continue;
        }
        it -= N_IN;
        if (it < N_G) {
            const int idx = it * 64 + lane, rr = idx >> 7, kc = (idx & 127) * 8;
            u32x4 o = (u32x4){0u, 0u, 0u, 0u};
            if (rr < 8) {
                float v[8];
#pragma unroll
                for (int e = 0; e < 8; ++e) v[e] = p.win[(size_t)(kc + e) * DINP + 2048 + rr] * p.nmix[kc + e];
                o.x = pk2(v[0], v[1]); o.y = pk2(v[2], v[3]); o.z = pk2(v[4], v[5]); o.w = pk2(v[6], v[7]);
            }
            *(u32x4*)(WIN + (size_t)(2560 + rr) * DM + kc) = o;
            continue;
        }
        it -= N_G;
        if (it < N_O) { const int kb = it / 32, nb = it % 32; p0_item(p.wout, DM, 32 * nb, WOUT, DM, 32 * nb, 64 * kb, nullptr, scr, lane); continue; }
        it -= N_O;
        {
            const int wi = it, nblk = wi & 15, cgp = (wi >> 4) & 15, g = wi >> 8, n = nblk * 64 + lane, c0 = cgp * 8;
            float a[8];
#pragma unroll
            for (int e = 0; e < 8; ++e) a[e] = 0.f;
            const float* pw = p.poolw + (size_t)(g * 128 + c0) * 128; const float* ps = p.pools + g * 128; const float* wo = p.wout + (size_t)(512 + g * 128) * DM + n;
            for (int d0 = 0; d0 < 128; d0 += 32) {
                float wv[32];
#pragma unroll
                for (int dd = 0; dd < 32; ++dd) wv[dd] = wo[(size_t)(d0 + dd) * DM];
#pragma unroll
                for (int dd = 0; dd < 32; ++dd) { const float w = wv[dd] * ps[d0 + dd];
#pragma unroll
                    for (int e = 0; e < 8; ++e) a[e] += pw[e * 128 + d0 + dd] * w; }
            }
            u32x4 o; o.x = pk2(a[0], a[1]); o.y = pk2(a[2], a[3]); o.z = pk2(a[4], a[5]); o.w = pk2(a[6], a[7]);
            *(u32x4*)(WOUT + (size_t)n * DM + 512 + g * 128 + c0) = o;
        }
    }
}
__device__ __forceinline__ void p0_prologue(const Params& p, LAS unsigned char* lds, int G) {
    const int tid = threadIdx.x, lane = tid & 63, wave = __builtin_amdgcn_readfirstlane(tid >> 6);
    LAS float* scr = (LAS float*)(lds + wave * 8448);
    const int gw = blockIdx.x * 8 + wave, NGW = G * 8;
    cvt_gu(p, 0, scr, lane, gw, NGW);
    bf16* XB = (bf16*)(p.ws + WS_XB); float* SS0 = (float*)(p.ws + WS_SS0);
    for (int m0 = gw * 4; m0 < S; m0 += NGW * 4) {
        f32x4 v[4][4];
#pragma unroll
        for (int rr = 0; rr < 4; ++rr) { const f32x4* xr = (const f32x4*)(p.x + (size_t)(m0 + rr) * DM) + lane;
#pragma unroll
            for (int j = 0; j < 4; ++j) v[rr][j] = __builtin_nontemporal_load(xr + 64 * j); }
#pragma unroll
        for (int rr = 0; rr < 4; ++rr) {
            float s = 0.f;
#pragma unroll
            for (int j = 0; j < 4; ++j) s += (v[rr][j][0] * v[rr][j][0] + v[rr][j][1] * v[rr][j][1]) + (v[rr][j][2] * v[rr][j][2] + v[rr][j][3] * v[rr][j][3]);
            s = wave_sum(s);
            u32x2* o8 = (u32x2*)(XB + (size_t)(m0 + rr) * DM) + lane;
#pragma unroll
            for (int j = 0; j < 4; ++j) { u32x2 w; w.x = pk2(v[rr][j][0], v[rr][j][1]); w.y = pk2(v[rr][j][2], v[rr][j][3]); o8[64 * j] = w; }
            if (lane < 16) SS0[(size_t)(m0 + rr) * 16 + lane] = lane == 0 ? s : 0.f;
        }
    }
}
__device__ __forceinline__ bool slack_rank(int nwg, int G, int& gw, int& NGW) {
    const int imax = (nwg - 1) / G, cb = nwg - imax * G;
    if ((int)blockIdx.x < cb || cb >= G) return false;
    gw = ((int)blockIdx.x - cb) * 8 + (int)__builtin_amdgcn_readfirstlane(threadIdx.x >> 6); NGW = (G - cb) * 8; return true;
}

constexpr int L_QS = 0, L_KS = 17408, L_VT = 34816, L_CT = 53248, L_PS = 88064, L_OS = 97280, L_SM = 114688;
constexpr int QP = 136, TP = 72;

__device__ __forceinline__ int tsw(int row, int col) { return row * TP + (col ^ (((row >> 3) & 7) << 3)); }
__device__ __forceinline__ void unpack8(const u32x4 v, float (&f)[8]) {
    f[0] = __uint_as_float(v.x << 16); f[1] = __uint_as_float(v.x & 0xffff0000u); f[2] = __uint_as_float(v.y << 16); f[3] = __uint_as_float(v.y & 0xffff0000u);
    f[4] = __uint_as_float(v.z << 16); f[5] = __uint_as_float(v.z & 0xffff0000u); f[6] = __uint_as_float(v.w << 16); f[7] = __uint_as_float(v.w & 0xffff0000u);
}
__device__ __forceinline__ void conv8(const bf16* proj, int t, int ch, const float* cw, const float* cb, float sc, float (&o)[8]) {
    { const f32x4 b0 = *(const f32x4*)(cb + ch), b1 = *(const f32x4*)(cb + ch + 4);
      o[0] = b0[0]; o[1] = b0[1]; o[2] = b0[2]; o[3] = b0[3]; o[4] = b1[0]; o[5] = b1[1]; o[6] = b1[2]; o[7] = b1[3]; }
#pragma unroll
    for (int w = 0; w < 4; ++w) {
        const int tr = t - 3 + w;
        if (tr >= 0) {
            const u32x4 raw = *(const u32x4*)(proj + (size_t)tr * NPROJ + ch); float xv[8]; unpack8(raw, xv);
            const f32x4 w0 = *(const f32x4*)(cw + w * 1024 + ch), w1 = *(const f32x4*)(cw + w * 1024 + ch + 4);
            o[0] += w0[0] * xv[0]; o[1] += w0[1] * xv[1]; o[2] += w0[2] * xv[2]; o[3] += w0[3] * xv[3];
            o[4] += w1[0] * xv[4]; o[5] += w1[1] * xv[5]; o[6] += w1[2] * xv[6]; o[7] += w1[3] * xv[7];
        }
    }
#pragma unroll
    for (int e = 0; e < 8; ++e) o[e] = o[e] * sc * __builtin_amdgcn_rcpf(1.0f + __expf(-o[e]));
}
__device__ __forceinline__ void conv4x8(const bf16* proj, int t, int ch, const float* cw, const float* cb, float sc, float (&o)[4][8]) {
    u32x4 raw[7];
#pragma unroll
    for (int i = 0; i < 7; ++i) { const int tr = t - 3 + i; raw[i] = tr >= 0 ? *(const u32x4*)(proj + (size_t)tr * NPROJ + ch) : (u32x4){0u, 0u, 0u, 0u}; }
    { const f32x4 b0 = *(const f32x4*)(cb + ch), b1 = *(const f32x4*)(cb + ch + 4);
#pragma unroll
      for (int j = 0; j < 4; ++j) { o[j][0] = b0[0]; o[j][1] = b0[1]; o[j][2] = b0[2]; o[j][3] = b0[3]; o[j][4] = b1[0]; o[j][5] = b1[1]; o[j][6] = b1[2]; o[j][7] = b1[3]; } }
#pragma unroll
    for (int w = 0; w < 4; ++w) {
        const f32x4 w0 = *(const f32x4*)(cw + w * 1024 + ch), w1 = *(const f32x4*)(cw + w * 1024 + ch + 4);
        const float wv[8] = {w0[0], w0[1], w0[2], w0[3], w1[0], w1[1], w1[2], w1[3]};
#pragma unroll
        for (int j = 0; j < 4; ++j) { float xv[8]; unpack8(raw[j + w], xv);
#pragma unroll
            for (int e = 0; e < 8; ++e) o[j][e] += wv[e] * xv[e]; }
    }
#pragma unroll
    for (int j = 0; j < 4; ++j)
#pragma unroll
        for (int e = 0; e < 8; ++e) o[j][e] = o[j][e] * sc * __builtin_amdgcn_rcpf(1.0f + __expf(-o[j][e]));
}
__device__ __forceinline__ u32x4 pack8(const float (&v)[8]) { u32x4 o; o.x = pk2(v[0], v[1]); o.y = pk2(v[2], v[3]); o.z = pk2(v[4], v[5]); o.w = pk2(v[6], v[7]); return o; }

__device__ __forceinline__ void m1_phase(const Params& p, unsigned char* ldsg, int G) {
    const int tid = threadIdx.x, lane = tid & 63, wave = __builtin_amdgcn_readfirstlane(tid >> 6), fr = lane & 15, fq = lane >> 4;
    const int half = wave >> 2, hw = wave & 3, htid = tid & 255;
    unsigned char* ws = p.ws;
    const bf16* PROJ = (const bf16*)(ws + WS_HB); const float* GATES = (const float*)(ws + WS_GATES);
    bf16* DCB = (bf16*)p.out; bf16* QKC = (bf16*)((unsigned char*)p.out + 32 * MiB); float* DN = (float*)(ws + WS_DN); float* GARR = (float*)(ws + WS_SC); float* AMAXARR = GARR + 1024;
    bf16* KT = (bf16*)(ldsg + half * 40960); bf16* VT = KT + 128 * TP; float* sW = (float*)(ldsg + half * 40960 + 36864);
    for (int r = blockIdx.x; r < NCH * NH / 2; r += G) {
        const int c = r >> 1, h = 2 * (r & 1) + half, u = c * 4 + h, t0 = c * CL;
        if (hw == 0) {
            const float ig = GATES[(size_t)(t0 + lane) * 8 + h], fp = GATES[(size_t)(t0 + lane) * 8 + 4 + h];
            const float b = wave_incl_sum(log_sigmoid_f(fp), lane);
            const float g = __shfl(b, 63);
            const float a = g - b + ig;
            const float amax = wave_max(a);
            sW[lane] = expf(a - amax);
            if (lane == 0) { GARR[h * NCH + c] = g; AMAXARR[h * NCH + c] = amax; }
        }
        const int rg = htid >> 4, cgp = htid & 15, l0 = 4 * rg;
        float kk[4][8];
        {
            float qv[4][8];
            conv4x8(PROJ, t0 + l0, h * HD + cgp * 8, p.convw, p.convb, 1.0f, qv);
#pragma unroll
            for (int j = 0; j < 4; ++j) *(u32x4*)(QKC + (size_t)(t0 + l0 + j) * DM + h * HD + cgp * 8) = pack8(qv[j]);
        }
        asm volatile("" ::: "memory");
        conv4x8(PROJ, t0 + l0, 512 + h * HD + cgp * 8, p.convw, p.convb, 0.08838834764831845f, kk);
#pragma unroll
        for (int j = 0; j < 4; ++j) *(u32x4*)(QKC + (size_t)(t0 + l0 + j) * DM + 512 + h * HD + cgp * 8) = pack8(kk[j]);
        {
            u32x4 rv[4];
#pragma unroll
            for (int j = 0; j < 4; ++j) rv[j] = *(const u32x4*)(PROJ + (size_t)(t0 + l0 + j) * NPROJ + 1024 + h * HD + cgp * 8);
#pragma unroll
            for (int e = 0; e < 8; ++e) {
                const unsigned sh = (e & 1) * 16;
                u32x2 o; o.x = ((rv[0][e >> 1] >> sh) & 0xffffu) | (((rv[1][e >> 1] >> sh) & 0xffffu) << 16); o.y = ((rv[2][e >> 1] >> sh) & 0xffffu) | (((rv[3][e >> 1] >> sh) & 0xffffu) << 16);
                *(u32x2*)(VT + tsw(cgp * 8 + e, l0)) = o;
            }
        }
        __syncthreads();
        {
            const f32x4 w4 = *(const f32x4*)(sW + l0);
#pragma unroll
            for (int e = 0; e < 8; ++e) { u32x2 o; o.x = pk2(kk[0][e] * w4[0], kk[1][e] * w4[1]); o.y = pk2(kk[2][e] * w4[2], kk[3][e] * w4[3]); *(u32x2*)(KT + tsw(cgp * 8 + e, l0)) = o; }
        }
        __syncthreads();
        {
            bf16x8 av[2][2];
#pragma unroll
            for (int mi = 0; mi < 2; ++mi)
#pragma unroll
                for (int ks = 0; ks < 2; ++ks) av[mi][ks] = *(const bf16x8*)(VT + tsw(16 * (2 * hw + mi) + fr, ks * 32 + fq * 8));
#pragma unroll
            for (int nt = 0; nt < 8; ++nt) {
                bf16x8 bk[2];
#pragma unroll
                for (int ks = 0; ks < 2; ++ks) bk[ks] = *(const bf16x8*)(KT + tsw(16 * nt + fr, ks * 32 + fq * 8));
#pragma unroll
                for (int mi = 0; mi < 2; ++mi) {
                    f32x4 acc = (f32x4){0.f, 0.f, 0.f, 0.f};
#pragma unroll
                    for (int ks = 0; ks < 2; ++ks) acc = __builtin_amdgcn_mfma_f32_16x16x32_bf16(bk[ks], av[mi][ks], acc, 0, 0, 0);
                    u32x2 o; o.x = pk2(acc[0], acc[1]); o.y = pk2(acc[2], acc[3]);
                    { const int vd = 16 * (2 * hw + mi) + fr; *(u32x2*)(DCB + ((size_t)((h * 64 + (vd >> 1)) * NCH + c) << 8) + (vd & 1) * 128 + 16 * nt + fq * 4) = o; }
                }
            }
            if (htid < 128) { float s = 0.f;
#pragma unroll 8
                for (int l = 0; l < 64; ++l) s += bf2f(KT[htid * TP + l]);
                DN[(size_t)(h * NCH + c) * 128 + htid] = s; }
        }
        __syncthreads();
    }
    bf16* MIX = (bf16*)(ws + WS_MIX);
    for (int rb = blockIdx.x; rb < S / 64; rb += G) {
        const int cg8 = tid & 63, rg = tid >> 6, ch0 = cg8 * 8, gi = ch0 >> 7, win = 2 << gi, tq = rb * 64 + rg * 8;
        const bf16* up = PROJ + 2048 + ch0;
        u32x4 slot[23];
#pragma unroll
        for (int s = 0; s < 23; ++s) { const int row = tq - 15 + s; slot[s] = (s + win >= 16 && row >= 0) ? *(const u32x4*)(up + (size_t)row * NPROJ) : (u32x4){0u, 0u, 0u, 0u}; }
        float sum[8];
#pragma unroll
        for (int e = 0; e < 8; ++e) sum[e] = 0.f;
#pragma unroll
        for (int s = 0; s < 15; ++s) { float xv[8]; unpack8(slot[s], xv); const bool in = (s + win > 15);
#pragma unroll
            for (int e = 0; e < 8; ++e) sum[e] += in ? xv[e] : 0.f; }
#pragma unroll
        for (int i = 0; i < 8; ++i) {
            float ut[8]; unpack8(slot[15 + i], ut);
#pragma unroll
            for (int e = 0; e < 8; ++e) sum[e] += ut[e];
            const int t = tq + i; const float inv = 1.0f / (float)((t + 1) < win ? (t + 1) : win);
            float o[8];
#pragma unroll
            for (int e = 0; e < 8; ++e) o[e] = sum[e] * inv - ut[e];
            *(u32x4*)(MIX + (size_t)t * DM + 512 + ch0) = pack8(o);
            if (i < 7) {
                u32x4 d;
#pragma unroll
                for (int q = 0; q < 4; ++q) d[q] = gi == 0 ? slot[14 + i][q] : gi == 1 ? slot[12 + i][q] : gi == 2 ? slot[8 + i][q] : slot[i][q];
                float dv[8]; unpack8(d, dv);
#pragma unroll
                for (int e = 0; e < 8; ++e) sum[e] -= dv[e];
            }
        }
    }
}

__device__ __forceinline__ void m2_phase(const Params& p, unsigned char* ldsg, int G) {
    const int tid = threadIdx.x, lane = tid & 63, wave = __builtin_amdgcn_readfirstlane(tid >> 6);
    unsigned char* ws = p.ws;
    bf16* DCB = (bf16*)p.out; float* DN = (float*)(ws + WS_DN); const float* GARR = (const float*)(ws + WS_SC); const float* AMAXARR = GARR + 1024; float* MPREV = (float*)(ws + WS_SC) + 2048;
    float* sA = (float*)ldsg; float* sB = sA + 256; float* sAseg = sA + 512; float* sTot = sA + 1024;
    for (int it = blockIdx.x; it < 256; it += G) {
        const int h = it >> 6, slice = it & 63, c0 = 32 * wave;
        u32x2 x[32];
        char* ub = (char*)DCB + (((size_t)((h * 64 + slice) * NCH + c0) << 8) * 2);
        const unsigned loff = (unsigned)lane * 8u;
#pragma unroll
        for (int i = 0; i < 32; ++i) x[i] = *(const u32x2*)(ub + (size_t)i * 512 + loff);
        if (wave == 0) {
            const f32x4 g4 = *(const f32x4*)(GARR + h * NCH + 4 * lane), a4 = *(const f32x4*)(AMAXARR + h * NCH + 4 * lane);
            const float tot = (g4[0] + g4[1]) + (g4[2] + g4[3]);
            const float inc = wave_incl_sum(tot, lane); const float pbase = inc - tot;
            float P[5]; P[0] = pbase; P[1] = P[0] + g4[0]; P[2] = P[1] + g4[1]; P[3] = P[2] + g4[2]; P[4] = P[3] + g4[3];
            float z[4];
#pragma unroll
            for (int i = 0; i < 4; ++i) z[i] = a4[i] - P[i + 1];
            const float zl = fmaxf(fmaxf(z[0], z[1]), fmaxf(z[2], z[3]));
            const float zi = wave_incl_max(zl, lane); float zprev = __shfl_up(zi, 1); if (lane == 0) zprev = 0.f; zprev = fmaxf(zprev, 0.f);
            float Z = zprev;
#pragma unroll
            for (int i = 0; i < 4; ++i) {
                const float m = P[i] + Z; const float Zn = fmaxf(Z, z[i]); const float mn = P[i + 1] + Zn;
                sA[4 * lane + i] = expf(g4[i] + m - mn); sB[4 * lane + i] = expf(a4[i] - mn);
                if (slice == 0) MPREV[h * NCH + 4 * lane + i] = m;
                Z = Zn;
            }
        }
        __syncthreads();
        {
            float l0 = 0.f, l1 = 0.f, l2 = 0.f, l3 = 0.f, ap = 1.f;
#pragma unroll
            for (int i = 0; i < 32; ++i) { const float a = sA[c0 + i], b = sB[c0 + i];
                l0 = a * l0 + b * __uint_as_float(x[i].x << 16); l1 = a * l1 + b * __uint_as_float(x[i].x & 0xffff0000u);
                l2 = a * l2 + b * __uint_as_float(x[i].y << 16); l3 = a * l3 + b * __uint_as_float(x[i].y & 0xffff0000u); ap *= a; }
            *(f32x4*)(sTot + wave * 256 + lane * 4) = (f32x4){l0, l1, l2, l3};
            if (lane == 0) sAseg[wave] = ap;
        }
        __syncthreads();
        {
            float l0 = 0.f, l1 = 0.f, l2 = 0.f, l3 = 0.f;
            for (int j = 0; j < wave; ++j) { const float a = sAseg[j]; const f32x4 tv = *(const f32x4*)(sTot + j * 256 + lane * 4);
                l0 = a * l0 + tv[0]; l1 = a * l1 + tv[1]; l2 = a * l2 + tv[2]; l3 = a * l3 + tv[3]; }
#pragma unroll
            for (int i = 0; i < 32; ++i) { const float a = sA[c0 + i], b = sB[c0 + i];
                u32x2 o; o.x = pk2(l0, l1); o.y = pk2(l2, l3); *(u32x2*)(ub + (size_t)i * 512 + loff) = o;
                l0 = a * l0 + b * __uint_as_float(x[i].x << 16); l1 = a * l1 + b * __uint_as_float(x[i].x & 0xffff0000u);
                l2 = a * l2 + b * __uint_as_float(x[i].y << 16); l3 = a * l3 + b * __uint_as_float(x[i].y & 0xffff0000u); }
        }
        if (slice == 0) {
            __syncthreads();
            typedef float f32x2 __attribute__((ext_vector_type(2)));
            char* nb = (char*)DN + ((size_t)(h * NCH + c0) * 128) * 4;
            f32x2 y[32];
#pragma unroll
            for (int i = 0; i < 32; ++i) y[i] = *(const f32x2*)(nb + (size_t)i * 512 + loff);
            f32x2 l = (f32x2){0.f, 0.f};
#pragma unroll
            for (int i = 0; i < 32; ++i) l = l * sA[c0 + i] + y[i] * sB[c0 + i];
            *(f32x2*)(sTot + wave * 256 + lane * 2) = l;
            __syncthreads();
            l = (f32x2){0.f, 0.f};
            for (int j = 0; j < wave; ++j) l = l * sAseg[j] + *(const f32x2*)(sTot + j * 256 + lane * 2);
#pragma unroll
            for (int i = 0; i < 32; ++i) { *(f32x2*)(nb + (size_t)i * 512 + loff) = l; l = l * sA[c0 + i] + y[i] * sB[c0 + i]; }
        }
        __syncthreads();
    }
}

__device__ __forceinline__ void m3_phase(const Params& p, unsigned char* ldsg, int G) {
    const int tid = threadIdx.x, lane = tid & 63, wave = __builtin_amdgcn_readfirstlane(tid >> 6), fr = lane & 15, fq = lane >> 4;
    unsigned char* ws = p.ws;
    const bf16* PROJ = (const bf16*)(ws + WS_HB); const float* GATES = (const float*)(ws + WS_GATES); const bf16* QKC = (const bf16*)((const unsigned char*)p.out + 32 * MiB);
    const bf16* CPB = (const bf16*)p.out; const float* DN = (const float*)(ws + WS_DN); const float* MPREV = (const float*)(ws + WS_SC) + 2048;
    bf16* MIX = (bf16*)(ws + WS_MIX);
    bf16* Qs = (bf16*)(ldsg + L_QS); bf16* Ks = (bf16*)(ldsg + L_KS); bf16* VT = (bf16*)(ldsg + L_VT); bf16* CTs = (bf16*)(ldsg + L_CT); bf16* Ps = (bf16*)(ldsg + L_PS); bf16* Os = (bf16*)(ldsg + L_OS);
    float* sU = (float*)(ldsg + L_SM); float* sM = sU + 64; float* sIW = sU + 128; float* sEMT = sU + 192; float* sRS = sU + 256; float* sQN = sU + 320; float* sHS = sU + 384; float* sN = sU + 448;
    for (int u = blockIdx.x; u < NCH * NH; u += G) {
        const int c = u >> 2, h = u & 3, t0 = c * CL;
        {
            const int r = tid >> 4, cgp = tid & 15;
            u32x4 gq[2], gk[2], gv[2], go[2], gc[4];
#pragma unroll
            for (int pass = 0; pass < 2; ++pass) { const size_t t = t0 + r + 32 * pass;
                gq[pass] = *(const u32x4*)(QKC + t * DM + h * HD + cgp * 8); gk[pass] = *(const u32x4*)(QKC + t * DM + 512 + h * HD + cgp * 8);
                gv[pass] = *(const u32x4*)(PROJ + t * NPROJ + 1024 + h * HD + cgp * 8); go[pass] = *(const u32x4*)(PROJ + t * NPROJ + 1536 + h * HD + cgp * 8); }
#pragma unroll
            for (int i = 0; i < 4; ++i) { const int idx = tid + 512 * i; gc[i] = *(const u32x4*)(CPB + ((size_t)((h * 64 + (idx >> 5)) * NCH + c) << 8) + (idx & 31) * 8); }
            if (wave == 0) {
                const float ig = GATES[(size_t)(t0 + lane) * 8 + h], fp = GATES[(size_t)(t0 + lane) * 8 + 4 + h];
                const float b = wave_incl_sum(log_sigmoid_f(fp), lane);
                const float uu = ig - b;
                const float U = wave_incl_max(uu, lane);
                const float mp = MPREV[h * NCH + c];
                const float M = fmaxf(mp, U);
                sU[lane] = uu; sM[lane] = M; sIW[lane] = expf(mp - M); sEMT[lane] = expf(-(b + M)); sRS[lane] = 0.f; sHS[lane] = 0.f;
            } else if (wave == 1) {
                sN[lane] = DN[(size_t)(h * NCH + c) * 128 + lane]; sN[lane + 64] = DN[(size_t)(h * NCH + c) * 128 + 64 + lane];
            }
#pragma unroll
            for (int pass = 0; pass < 2; ++pass) { const int l = r + 32 * pass;
                *(u32x4*)(Qs + l * QP + cgp * 8) = gq[pass]; *(u32x4*)(Ks + l * QP + cgp * 8) = gk[pass]; *(u32x4*)(Os + l * QP + cgp * 8) = go[pass];
#pragma unroll
                for (int e = 0; e < 8; ++e) VT[tsw(cgp * 8 + e, l)] = (bf16)(gv[pass][e >> 1] >> ((e & 1) * 16)); }
#pragma unroll
            for (int i = 0; i < 4; ++i) { const int idx = tid + 512 * i, vd = idx >> 4, kc = (idx & 15) * 8; *(u32x4*)(CTs + vd * QP + kc) = gc[i]; }
        }
        __syncthreads();
        {
            const int l = tid >> 3, part = tid & 7; float s = 0.f;
#pragma unroll
            for (int e = 0; e < 16; ++e) s += bf2f(Qs[l * QP + part * 16 + e]) * sN[part * 16 + e];
            s += __shfl_xor(s, 1); s += __shfl_xor(s, 2); s += __shfl_xor(s, 4);
            if (part == 0) sQN[l] = s;
        }
        const int lt = wave >> 1;
        {
            bf16x8 aq[4];
#pragma unroll
            for (int ks = 0; ks < 4; ++ks) aq[ks] = *(const bf16x8*)(Qs + (16 * lt + fr) * QP + ks * 32 + fq * 8);
            float rs[4] = {0.f, 0.f, 0.f, 0.f};
#pragma unroll
            for (int si = 0; si < 2; ++si) {
                const int st = 2 * (wave & 1) + si;
                f32x4 acc = (f32x4){0.f, 0.f, 0.f, 0.f};
#pragma unroll
                for (int ks = 0; ks < 4; ++ks) { const bf16x8 b = *(const bf16x8*)(Ks + (16 * st + fr) * QP + ks * 32 + fq * 8); acc = __builtin_amdgcn_mfma_f32_16x16x32_bf16(aq[ks], b, acc, 0, 0, 0); }
                const int s = 16 * st + fr; const float us = sU[s];
#pragma unroll
                for (int j = 0; j < 4; ++j) { const int l = 16 * lt + fq * 4 + j; const float val = (s <= l) ? acc[j] * expf(us - sM[l]) : 0.f; Ps[l * TP + s] = (bf16)f2bf(val); rs[j] += val; }
            }
#pragma unroll
            for (int j = 0; j < 4; ++j) { float v = rs[j]; v += __shfl_xor(v, 1); v += __shfl_xor(v, 2); v += __shfl_xor(v, 4); v += __shfl_xor(v, 8); if (fr == 0) atomicAdd(&sRS[16 * lt + fq * 4 + j], v); }
        }
        __syncthreads();
        {
            f32x4 a1[4], a2[4];
#pragma unroll
            for (int n = 0; n < 4; ++n) { a1[n] = (f32x4){0.f, 0.f, 0.f, 0.f}; a2[n] = (f32x4){0.f, 0.f, 0.f, 0.f}; }
#pragma unroll
            for (int ks = 0; ks < 2; ++ks) { const bf16x8 a = *(const bf16x8*)(Ps + (16 * lt + fr) * TP + ks * 32 + fq * 8);
#pragma unroll
                for (int n = 0; n < 4; ++n) { const int nt = 4 * (wave & 1) + n; const bf16x8 b = *(const bf16x8*)(VT + tsw(16 * nt + fr, ks * 32 + fq * 8)); a1[n] = __builtin_amdgcn_mfma_f32_16x16x32_bf16(a, b, a1[n], 0, 0, 0); } }
#pragma unroll
            for (int ks = 0; ks < 4; ++ks) { const bf16x8 a = *(const bf16x8*)(Qs + (16 * lt + fr) * QP + ks * 32 + fq * 8);
#pragma unroll
                for (int n = 0; n < 4; ++n) { const int nt = 4 * (wave & 1) + n; const bf16x8 b = *(const bf16x8*)(CTs + (16 * nt + fr) * QP + ks * 32 + fq * 8); a2[n] = __builtin_amdgcn_mfma_f32_16x16x32_bf16(a, b, a2[n], 0, 0, 0); } }
#pragma unroll
            for (int j = 0; j < 4; ++j) {
                const int l = 16 * lt + fq * 4 + j; const float iw = sIW[l]; const float qn = sRS[l] + iw * sQN[l];
                const float den = fmaxf(fabsf(qn), sEMT[l]); const float inv = 1.0f / den; float hs = 0.f;
#pragma unroll
                for (int n = 0; n < 4; ++n) { const float v = (a1[n][j] + iw * a2[n][j]) * inv; hs += v * v; Ks[l * QP + 16 * (4 * (wave & 1) + n) + fr] = (bf16)f2bf(v); }
                hs += __shfl_xor(hs, 1); hs += __shfl_xor(hs, 2); hs += __shfl_xor(hs, 4); hs += __shfl_xor(hs, 8);
                if (fr == 0) atomicAdd(&sHS[l], hs);
            }
        }
        __syncthreads();
        {
            const int r = tid >> 4, cgp = tid & 15;
            const f32x4 n0 = *(const f32x4*)(p.mhn + h * HD + cgp * 8), n1 = *(const f32x4*)(p.mhn + h * HD + cgp * 8 + 4);
            const float nn[8] = {n0[0], n0[1], n0[2], n0[3], n1[0], n1[1], n1[2], n1[3]};
#pragma unroll
            for (int pass = 0; pass < 2; ++pass) { const int l = r + 32 * pass; const float rinv = 1.0f / sqrtf(sHS[l] * (1.0f / 128.0f) + EPS);
                float hv[8], ov[8], o[8]; unpack8(*(const u32x4*)(Ks + l * QP + cgp * 8), hv); unpack8(*(const u32x4*)(Os + l * QP + cgp * 8), ov);
#pragma unroll
                for (int e = 0; e < 8; ++e) o[e] = hv[e] * rinv * nn[e] * __builtin_amdgcn_rcpf(1.0f + __expf(-ov[e]));
                *(u32x4*)(MIX + (size_t)(t0 + l) * DM + h * HD + cgp * 8) = pack8(o); }
        }
        __syncthreads();
    }
}

#define XB_TMO      128
#define XB_XCNT(j)  (256  + 64 * (j))
#define XB_XSUB(j)  (1280 + 64 * (j))
#define XB_XGEN(j)  (2304 + 64 * (j))
#define XB_TOP      3328
#define XB_TOPGEN   3392
#define XCD_BAR_WORDS 3456
#define XB_SPIN_CAP (1u << 18)
__device__ __forceinline__ unsigned xb_ld(unsigned* p)              { return __hip_atomic_load(p, __ATOMIC_RELAXED, __HIP_MEMORY_SCOPE_AGENT); }
__device__ __forceinline__ unsigned xb_add(unsigned* p, unsigned v) { return __hip_atomic_fetch_add(p, v, __ATOMIC_RELAXED, __HIP_MEMORY_SCOPE_AGENT); }
__device__ __forceinline__ unsigned xb_xcc_id() { return (unsigned)__builtin_amdgcn_s_getreg((3 << 11) | 20) & 0xFu; }
#define XB_SPIN(cond, bar) do { unsigned _sp = 0; while (cond) { __builtin_amdgcn_s_sleep(1); \
    if ((++_sp & 255u) == 0u) { if (xb_ld(&(bar)[XB_TMO])) break; if (_sp > XB_SPIN_CAP) { atomicAdd(&(bar)[XB_TMO], 1u); break; } } } } while (0)
struct XcdBarrier { unsigned* bar; unsigned x; volatile LAS unsigned* st; };
__device__ __forceinline__ XcdBarrier xcd_barrier_post(unsigned* bar, volatile LAS unsigned* st) {
    XcdBarrier b; b.bar = bar; b.x = xb_xcc_id(); b.st = st;
    if (threadIdx.x == 0) (void)xb_add(&bar[XB_XCNT(b.x)], 1u);
    return b;
}
__device__ __forceinline__ void xcd_barrier_complete(unsigned* bar, unsigned x, unsigned& nloc, unsigned& nx) {
    const unsigned G = gridDim.x * gridDim.y * gridDim.z;
    unsigned sum, cnt, mine, sp = 0u;
    for (;;) {
        sum = 0u; cnt = 0u; mine = 0u;
#pragma unroll
        for (unsigned j = 0; j < 16; ++j) { const unsigned c = xb_ld(&bar[XB_XCNT(j)]); sum += c; cnt += (c > 0u) ? 1u : 0u; mine = (j == x) ? c : mine; }
        if (sum == G) break;
        __builtin_amdgcn_s_sleep(1);
        if ((++sp & 255u) == 0u) { if (xb_ld(&bar[XB_TMO])) break; if (sp > XB_SPIN_CAP) { atomicAdd(&bar[XB_TMO], 1u); break; } }
    }
    nloc = mine > 0u ? mine : 1u; nx = cnt > 0u ? cnt : 1u;
}
__device__ __forceinline__ void xcd_barrier(const XcdBarrier& b) {
    asm volatile("s_waitcnt vmcnt(0)" ::: "memory");
    __syncthreads();
    if (threadIdx.x == 0) {
        unsigned* bar = b.bar;
        __builtin_amdgcn_s_waitcnt(0);
        unsigned nloc = b.st[0], nx = b.st[1];
        if (nloc == 0u) { xcd_barrier_complete(bar, b.x, nloc, nx); b.st[0] = nloc; b.st[1] = nx; }
        const unsigned old = xb_add(&bar[XB_XSUB(b.x)], 1u);
        const unsigned gen = old / nloc;
        if (old + 1u == (gen + 1u) * nloc) {
            __builtin_amdgcn_fence(__ATOMIC_RELEASE, "agent");
            asm volatile("s_waitcnt vmcnt(0)" ::: "memory");
            const unsigned og = xb_add(&bar[XB_TOP], 1u);
            const unsigned tg = og / nx;
            if (og + 1u == (tg + 1u) * nx) xb_add(&bar[XB_TOPGEN], 1u);
            else XB_SPIN(xb_ld(&bar[XB_TOPGEN]) == tg, bar);
            __builtin_amdgcn_fence(__ATOMIC_ACQUIRE, "agent");
            xb_add(&bar[XB_XGEN(b.x)], 1u);
            asm volatile("s_waitcnt vmcnt(0)" ::: "memory");
        } else {
            XB_SPIN(xb_ld(&bar[XB_XGEN(b.x)]) == gen, bar);
            __builtin_amdgcn_fence(__ATOMIC_ACQUIRE, "agent");
            asm volatile("s_waitcnt vmcnt(0)" ::: "memory");
        }
    }
    __syncthreads();
}

__device__ __forceinline__ int fill_rtab(const pg8::StaticOrder& so, const float* ss, LAS float* rtab) {
    pg8::Unit u0; int pm0 = -1;
    if (so.next(0, u0)) { pm0 = u0.pm; if (threadIdx.x < 256) rtab[threadIdx.x] = pg8::row_rstd(ss, pm0 * 256 + (int)threadIdx.x); }
    __syncthreads();
    return pm0;
}
__global__ void __launch_bounds__(512, 2) fwd_megakernel(Params p) {
    extern __shared__ __attribute__((aligned(16))) unsigned char lds[];
    cg::grid_group grid = cg::this_grid();
    LAS unsigned char* ldsl = (LAS unsigned char*)lds;
    const int G = gridDim.x;
    unsigned char* ws = p.ws;
    bf16* XB = (bf16*)(ws + WS_XB); bf16* HB = (bf16*)(ws + WS_HB); bf16* MIX = (bf16*)(ws + WS_MIX);
    float* SS0 = (float*)(ws + WS_SS0); float* SS1 = (float*)(ws + WS_SS1); float* SS2 = (float*)(ws + WS_SS2); float* SS3 = (float*)(ws + WS_SS3);

    unsigned* barw = (unsigned*)(ws + WS_BAR);
    LAS float* rtab = (LAS float*)(ldsl + LDS_RTAB);
    volatile LAS unsigned* bst = (volatile LAS unsigned*)(ldsl + 131072);
    if (threadIdx.x < 2) bst[threadIdx.x] = 0u;
    if (p.ws == nullptr) grid.sync();
    {
        unsigned* flag = barw + 16384 - 64;
        constexpr unsigned MAGIC = 0x600DF1A6u;
        if (blockIdx.x == 0) {
            for (int i = threadIdx.x; i < 16384 - 64; i += 512) barw[i] = 0u;
            __threadfence(); __syncthreads();
            if (threadIdx.x == 0) { asm volatile("s_waitcnt vmcnt(0)" ::: "memory"); __hip_atomic_store(flag, MAGIC, __ATOMIC_RELEASE, __HIP_MEMORY_SCOPE_AGENT); }
        } else if (threadIdx.x == 0) {
            unsigned sp = 0; while (__hip_atomic_load(flag, __ATOMIC_RELAXED, __HIP_MEMORY_SCOPE_AGENT) != MAGIC) { __builtin_amdgcn_s_sleep(1); if (++sp > (1u << 22)) break; }
            __builtin_amdgcn_fence(__ATOMIC_ACQUIRE, "agent");
        }
        __syncthreads();
    }
    const XcdBarrier xb = xcd_barrier_post(barw, bst);
#define GSYNC() xcd_barrier(xb)
    p0_prologue(p, ldsl, G);
    GSYNC();
    if (blockIdx.x == 0 && threadIdx.x == 0) __hip_atomic_store(barw + 16384 - 64, 0u, __ATOMIC_RELAXED, __HIP_MEMORY_SCOPE_AGENT);
    { pg8::Gemm g{XB, (const bf16*)(ws + WS_WGU1), S, 2 * DFF, DM}; pg8::StaticOrder so; so.init(S, 2 * DFF, G, (int)blockIdx.x);
      const int pm0 = fill_rtab(so, SS0, rtab); pg8::EpiSwiGLU E{HB, DFF, SS0, rtab, pm0}; pg8::gemm_phase<pg8::EpiSwiGLU, pg8::StaticOrder, true, true>(ldsl, g, so, E); }
    { int sgw, sng; if (slack_rank((S / 256) * (2 * DFF / 256), G, sgw, sng)) { LAS float* scr = (LAS float*)(ldsl + (threadIdx.x >> 6) * 8448); const int lane = threadIdx.x & 63;
        slack1_items(p, scr, lane, sgw, sng); } }
    GSYNC();
    { pg8::Gemm g{HB, (const bf16*)(ws + WS_WD1), S, DM, DFF}; pg8::StaticOrder so; so.init(S, DM, G, (int)blockIdx.x);
      pg8::EpiResid<true> E{nullptr, XB, SS1, 0.5f}; pg8::gemm_phase<pg8::EpiResid<true>, pg8::StaticOrder, true, true>(ldsl, g, so, E); }
    GSYNC();
    { pg8::Gemm g{XB, (const bf16*)(ws + WS_WIN), S, NPROJ, DM}; pg8::StaticOrder so; so.init(S, NPROJ, G, (int)blockIdx.x);
      const int pm0 = fill_rtab(so, SS1, rtab); pg8::EpiProj E{HB, NPROJ, SS1, (float*)(ws + WS_GATES), p.bg, 10, rtab, pm0}; pg8::gemm_phase<pg8::EpiProj, pg8::StaticOrder, true, true>(ldsl, g, so, E); }
    { int sgw, sng; if (slack_rank((S / 256) * (NPROJ / 256), G, sgw, sng)) { LAS float* scr = (LAS float*)(ldsl + (threadIdx.x >> 6) * 8448); cvt_gu(p, 1, scr, threadIdx.x & 63, sgw, sng); } }
    GSYNC();
    m1_phase(p, lds, G);
    GSYNC();
    m2_phase(p, lds, G);
    GSYNC();
    m3_phase(p, lds, G);
    GSYNC();
    { pg8::Gemm g{MIX, (const bf16*)(ws + WS_WOUT), S, DM, DM}; pg8::StaticOrder so; so.init(S, DM, G, (int)blockIdx.x);
      pg8::EpiResid<true> E{nullptr, XB, SS2, 1.0f}; pg8::gemm_phase<pg8::EpiResid<true>, pg8::StaticOrder, true, true>(ldsl, g, so, E); }
    GSYNC();
    { pg8::Gemm g{XB, (const bf16*)(ws + WS_WGU2), S, 2 * DFF, DM}; pg8::StaticOrder so; so.init(S, 2 * DFF, G, (int)blockIdx.x);
      const int pm0 = fill_rtab(so, SS2, rtab); pg8::EpiSwiGLU E{HB, DFF, SS2, rtab, pm0}; pg8::gemm_phase<pg8::EpiSwiGLU, pg8::StaticOrder, true, true>(ldsl, g, so, E); }
    { int sgw, sng; if (slack_rank((S / 256) * (2 * DFF / 256), G, sgw, sng)) cvt_down(p, 1, (LAS float*)(ldsl + (threadIdx.x >> 6) * 8448), threadIdx.x & 63, sgw, sng); }
    GSYNC();
    { pg8::Gemm g{HB, (const bf16*)(ws + WS_WD2), S, DM, DFF}; pg8::StaticOrder so; so.init(S, DM, G, (int)blockIdx.x);
      pg8::EpiFinal E{XB, p.out, SS3, (unsigned*)(ws + WS_PCNT), p.nf, 0.5f}; pg8::gemm_phase<pg8::EpiFinal, pg8::StaticOrder, true, true>(ldsl, g, so, E); }
}

extern "C" void kernel_launch(void* const* d_in, const int* in_sizes, int n_in, void* d_out, int out_size, void* d_ws, size_t ws_size, hipStream_t stream) {
    static int grid_blocks = 0;
    if (grid_blocks == 0) {
        if (n_in != 19 || out_size != S * DM || ws_size < WS_END) { fprintf(stderr, "kernel_launch: unexpected problem (n_in %d, out %d, ws %zu)\n", n_in, out_size, ws_size); grid_blocks = -1; return; }
        int dev = 0, cus = 0, per_cu = 0;
        (void)hipGetDevice(&dev);
        (void)hipDeviceGetAttribute(&cus, hipDeviceAttributeMultiprocessorCount, dev);
        if (hipFuncSetAttribute((const void*)fwd_megakernel, hipFuncAttributeMaxDynamicSharedMemorySize, LDS_BYTES) != hipSuccess) { fprintf(stderr, "kernel_launch: hipFuncSetAttribute failed\n"); grid_blocks = -1; return; }
        if (hipOccupancyMaxActiveBlocksPerMultiprocessor(&per_cu, (const void*)fwd_megakernel, 512, LDS_BYTES) != hipSuccess || per_cu < 1) { fprintf(stderr, "kernel_launch: occupancy query gave %d\n", per_cu); per_cu = 1; }
        (void)hipGetLastError();
        grid_blocks = cus * 1;
        if (grid_blocks <= 0) grid_blocks = 256;
    }
    if (grid_blocks < 0) return;
    Params p{};
    p.x = (const float*)d_in[0]; p.n1 = (const float*)d_in[1]; p.wg1 = (const float*)d_in[2]; p.wu1 = (const float*)d_in[3]; p.wd1 = (const float*)d_in[4];
    p.nmix = (const float*)d_in[5]; p.win = (const float*)d_in[6]; p.bg = (const float*)d_in[7]; p.convw = (const float*)d_in[8]; p.convb = (const float*)d_in[9]; p.mhn = (const float*)d_in[10];
    p.poolw = (const float*)d_in[11]; p.pools = (const float*)d_in[12]; p.wout = (const float*)d_in[13]; p.n2 = (const float*)d_in[14]; p.wg2 = (const float*)d_in[15]; p.wu2 = (const float*)d_in[16]; p.wd2 = (const float*)d_in[17]; p.nf = (const float*)d_in[18];
    p.out = (float*)d_out; p.ws = (unsigned char*)d_ws;
    void* args[] = {&p};
    hipError_t e = hipLaunchCooperativeKernel((const void*)fwd_megakernel, dim3(grid_blocks), dim3(512), args, LDS_BYTES, stream);
    if (e != hipSuccess) fprintf(stderr, "cooperative launch failed: %s (grid %d)\n", hipGetErrorString(e), grid_blocks);
}
```

```cpp
#include <hip/hip_runtime.h>
#include <hip/hip_cooperative_groups.h>
#include <cstdio>
#include <cstdint>
namespace cg = cooperative_groups;

#define LAS __attribute__((address_space(3)))
typedef unsigned short bf16;
typedef short bf16x8 __attribute__((ext_vector_type(8)));
typedef float f32x4 __attribute__((ext_vector_type(4)));
typedef unsigned u32x4 __attribute__((ext_vector_type(4)));
typedef unsigned u32x2 __attribute__((ext_vector_type(2)));

constexpr int S = 16384, DM = 1024, DFF = 2816, NPROJ = 2816  , DINP = 2568;
constexpr int NCH = 256, CL = 64, NH = 4, HD = 128;
constexpr float EPS = 1e-6f;

constexpr size_t MiB = 1u << 20;
constexpr size_t WS_SS0 = 0 * MiB, WS_SS1 = 1 * MiB, WS_SS2 = 2 * MiB, WS_SS3 = 3 * MiB;
constexpr size_t WS_GATES = 4 * MiB;
constexpr size_t WS_DN = 4 * MiB + 512 * 1024;
constexpr size_t WS_BAR = 5 * MiB + 512 * 1024;
constexpr size_t WS_PCNT = WS_BAR + 16384;
constexpr size_t WS_SC = 5 * MiB;
constexpr size_t WS_WGU1 = 6 * MiB;
constexpr size_t WS_WD1 = 17 * MiB;
constexpr size_t WS_WGU2 = 23 * MiB;
constexpr size_t WS_WD2 = 34 * MiB;
constexpr size_t WS_WIN = 40 * MiB;
constexpr size_t WS_WOUT = 46 * MiB;
constexpr size_t WS_HB = 48 * MiB;
constexpr size_t WS_MIX = 136 * MiB;
constexpr size_t WS_XB = 168 * MiB;
constexpr size_t WS_END = 200 * MiB;

constexpr int LDS_RTAB = 131072 + 256;
constexpr int LDS_BYTES = 131072 + 256 + 1024;

namespace pg8 {
#define PG8_LAS __attribute__((address_space(3)))
typedef unsigned short bf16_t;
constexpr int BM = 256, BK = 64, HALF = 128, HTB = HALF * BK * 2, STAGE_BYTES = 8 * HTB, NXCD = 8, WGM = 8;

__host__ __device__ __forceinline__ int lds_byte(int r, int c) { const int st = (r >> 4) * 2 + (c >> 5), rr = r & 15, cc = c & 31, ob = rr * 64 + cc * 2; return st * 1024 + (ob ^ (((ob >> 9) & 1) << 5)); }
__host__ __device__ __forceinline__ void stage_rc(int b, int& R, int& C) { const int st = b / 1024, sb = b % 1024, swz = sb ^ (((sb >> 9) & 1) << 5); R = (st >> 1) * 16 + swz / 64; C = (st & 1) * 32 + (swz % 64) / 2; }
__host__ __device__ __forceinline__ int perm32(int rho) { const int n = rho >> 4, i = rho & 15; return 8 * (i >> 2) + 4 * n + (i & 3); }

struct Unit { int pm, pn; };
struct Gemm { const bf16_t* A; const bf16_t* Bt; int M, N, K; };

struct StaticOrder {
    int nM, nN, nwg, G, c;
    __host__ __device__ void init(int M, int N, int G_, int c_) { nM = M / BM; nN = N / BM; nwg = nM * nN; G = G_; c = c_; }
    __host__ __device__ bool next(int i, Unit& u) const {
        const long L = (long)i * G + c; if (L >= nwg) return false;
        int wgid = (int)L; { const int q = nwg / NXCD, r = nwg % NXCD, xcd = wgid % NXCD, off = wgid / NXCD; wgid = (xcd < r ? xcd * (q + 1) : r * (q + 1) + (xcd - r) * q) + off; }
        const int nig = WGM * nN, gid = wgid / nig, fm = gid * WGM, gsz = (nM - fm) < WGM ? (nM - fm) : WGM;
        u.pm = fm + ((wgid % nig) % gsz); u.pn = (wgid % nig) / gsz; return true;
    }
    __device__ __forceinline__ void a_ready(const Unit&) const {}
    __device__ __forceinline__ void done(const Unit&) const {}
};

__device__ __forceinline__ unsigned cvt_pk_bf16(float lo, float hi) { unsigned r; asm volatile("v_cvt_pk_bf16_f32 %0, %1, %2" : "=v"(r) : "v"(lo), "v"(hi)); return r; }

__device__ __forceinline__ float row_rstd(const float* ss, int row) {
    const f32x4* p = (const f32x4*)(ss + (size_t)row * 16);
    const f32x4 a = p[0], b = p[1], c = p[2], d = p[3];
    const float s = (((a[0] + a[1]) + (a[2] + a[3])) + ((b[0] + b[1]) + (b[2] + b[3]))) + (((c[0] + c[1]) + (c[2] + c[3])) + ((d[0] + d[1]) + (d[2] + d[3])));
    return 1.0f / sqrtf(s * (1.0f / 1024.0f) + 1e-6f);
}
__device__ __forceinline__ float silu_f(float g) { return g * __builtin_amdgcn_rcpf(1.0f + __expf(-g)); }
typedef float f32x2 __attribute__((ext_vector_type(2)));
__device__ __forceinline__ f32x2 swiglu_pk(f32x2 g, f32x2 u, float c, float r2) {
    const f32x2 t = g * c;
    f32x2 e; e.x = __builtin_amdgcn_exp2f(t.x); e.y = __builtin_amdgcn_exp2f(t.y);
    const f32x2 d = e + 1.0f;
    f32x2 s; s.x = __builtin_amdgcn_rcpf(d.x); s.y = __builtin_amdgcn_rcpf(d.y);
    return (g * u) * (s * r2);
}

struct EpiSwiGLU {
    static constexpr bool PERM = true, AFTER_DRAIN = false;
    bf16_t* H; int ldh; const float* ss; const PG8_LAS float* rtab; int rt_pm;
    __device__ __forceinline__ void operator()(const f32x4 (&acc)[2][2][4][2], const Unit& u, int wr, int wc, int fr, int fq) const {
        const int row0 = u.pm * BM + wr * 64 + fr, col0 = u.pn * HALF + wc * 32 + 8 * fq; const bool tab = (u.pm == rt_pm);
#pragma unroll
        for (int ai = 0; ai < 2; ++ai)
#pragma unroll
            for (int m = 0; m < 4; ++m) {
                const int row = row0 + ai * HALF + m * 16; const float r = tab ? rtab[row - u.pm * BM] : row_rstd(ss, row);
                const float c = r * -1.4426950408889634f, r2 = r * r;
                const f32x4 G0 = acc[ai][0][m][0], G1 = acc[ai][0][m][1], U0 = acc[ai][1][m][0], U1 = acc[ai][1][m][1];
                const f32x2 h0 = swiglu_pk((f32x2){G0[0], G0[1]}, (f32x2){U0[0], U0[1]}, c, r2), h1 = swiglu_pk((f32x2){G0[2], G0[3]}, (f32x2){U0[2], U0[3]}, c, r2);
                const f32x2 h2 = swiglu_pk((f32x2){G1[0], G1[1]}, (f32x2){U1[0], U1[1]}, c, r2), h3 = swiglu_pk((f32x2){G1[2], G1[3]}, (f32x2){U1[2], U1[3]}, c, r2);
                u32x4 w;
                w.x = cvt_pk_bf16(h0.x, h0.y); w.y = cvt_pk_bf16(h1.x, h1.y); w.z = cvt_pk_bf16(h2.x, h2.y); w.w = cvt_pk_bf16(h3.x, h3.y);
                *(u32x4*)(H + (size_t)row * ldh + col0) = w;
            }
    }
};
struct EpiProj {
    static constexpr bool PERM = true, AFTER_DRAIN = false;
    bf16_t* P; int ldp; const float* ss; float* gates; const float* bg; int gate_tile; const PG8_LAS float* rtab; int rt_pm;
    __device__ __forceinline__ void operator()(const f32x4 (&acc)[2][2][4][2], const Unit& u, int wr, int wc, int fr, int fq) const {
        const int row0 = u.pm * BM + wr * 64 + fr, col0 = u.pn * BM + wc * 32 + 8 * fq; const bool tab = (u.pm == rt_pm);
        if (u.pn < gate_tile) {
#pragma unroll
            for (int ai = 0; ai < 2; ++ai)
#pragma unroll
                for (int m = 0; m < 4; ++m) {
                    const int row = row0 + ai * HALF + m * 16; const float r = tab ? rtab[row - u.pm * BM] : row_rstd(ss, row);
#pragma unroll
                    for (int bj = 0; bj < 2; ++bj) {
                        const f32x4 v0 = acc[ai][bj][m][0] * r, v1 = acc[ai][bj][m][1] * r;
                        u32x4 w; w.x = cvt_pk_bf16(v0[0], v0[1]); w.y = cvt_pk_bf16(v0[2], v0[3]); w.z = cvt_pk_bf16(v1[0], v1[1]); w.w = cvt_pk_bf16(v1[2], v1[3]);
                        *(u32x4*)(P + (size_t)row * ldp + col0 + bj * HALF) = w;
                    }
                }
        } else if (wc == 0 && fq == 0) {
            const f32x4 b0 = *(const f32x4*)bg, b1 = *(const f32x4*)(bg + 4);
#pragma unroll
            for (int ai = 0; ai < 2; ++ai)
#pragma unroll
                for (int m = 0; m < 4; ++m) {
                    const int row = row0 + ai * HALF + m * 16; const float r = tab ? rtab[row - u.pm * BM] : row_rstd(ss, row);
                    *(f32x4*)(gates + (size_t)row * 8) = acc[ai][0][m][0] * r + b0;
                    *(f32x4*)(gates + (size_t)row * 8 + 4) = acc[ai][0][m][1] * r + b1;
                }
        }
    }
};
__device__ __forceinline__ void bf8_to_f32(const u32x4 v, f32x4& lo, f32x4& hi) {
    lo = (f32x4){__uint_as_float(v.x << 16), __uint_as_float(v.x & 0xffff0000u), __uint_as_float(v.y << 16), __uint_as_float(v.y & 0xffff0000u)};
    hi = (f32x4){__uint_as_float(v.z << 16), __uint_as_float(v.z & 0xffff0000u), __uint_as_float(v.w << 16), __uint_as_float(v.w & 0xffff0000u)};
}
template <bool XI_BF16> struct EpiResid {
    static constexpr bool PERM = true, AFTER_DRAIN = false;
    const float* xi; bf16_t* xb; float* ssout; float scale;
    __device__ __forceinline__ void operator()(const f32x4 (&acc)[2][2][4][2], const Unit& u, int wr, int wc, int fr, int fq) const {
        const int row0 = u.pm * BM + wr * 64 + fr, col0 = u.pn * BM + wc * 32 + 8 * fq;
#pragma unroll
        for (int ai = 0; ai < 2; ++ai) {
        u32x4 xin[1][4][2];
        if (XI_BF16) {
#pragma unroll
                for (int m = 0; m < 4; ++m)
#pragma unroll
                    for (int bj = 0; bj < 2; ++bj) xin[0][m][bj] = *(const u32x4*)(xb + (size_t)(row0 + ai * HALF + m * 16) * DM + col0 + bj * HALF);
        }
#pragma unroll
            for (int m = 0; m < 4; ++m) {
                const int row = row0 + ai * HALF + m * 16; const size_t off = (size_t)row * DM + col0; float q = 0.f;
#pragma unroll
                for (int bj = 0; bj < 2; ++bj) {
                    const size_t o2 = off + bj * HALF; f32x4 b0, b1;
                    if (XI_BF16) bf8_to_f32(xin[0][m][bj], b0, b1); else { b0 = *(const f32x4*)(xi + o2); b1 = *(const f32x4*)(xi + o2 + 4); }
                    const f32x4 o0 = b0 + acc[ai][bj][m][0] * scale, o1 = b1 + acc[ai][bj][m][1] * scale;
                    u32x4 w; w.x = cvt_pk_bf16(o0[0], o0[1]); w.y = cvt_pk_bf16(o0[2], o0[3]); w.z = cvt_pk_bf16(o1[0], o1[1]); w.w = cvt_pk_bf16(o1[2], o1[3]);
                    *(u32x4*)(xb + o2) = w;
                    q += ((o0[0] * o0[0] + o0[1] * o0[1]) + (o0[2] * o0[2] + o0[3] * o0[3])) + ((o1[0] * o1[0] + o1[1] * o1[1]) + (o1[2] * o1[2] + o1[3] * o1[3]));
                }
                q += __shfl_xor(q, 16); q += __shfl_xor(q, 32);
                if (fq == 0) ssout[(size_t)row * 16 + u.pn * 4 + wc] = q;
                if (!XI_BF16) asm volatile("" ::: "memory");
            }
            asm volatile("" ::: "memory");
        }
    }
};
struct EpiFinal {
    static constexpr bool PERM = true, AFTER_DRAIN = false;
    const bf16_t* xb; float* out; float* ss; unsigned* cnt; const float* gf; float scale;
    __device__ __forceinline__ void operator()(f32x4 (&acc)[2][2][4][2], const Unit& u, int wr, int wc, int fr, int fq) const {
        const int row0 = u.pm * BM + wr * 64 + fr, col0 = u.pn * BM + wc * 32 + 8 * fq;
#pragma unroll
        for (int ai = 0; ai < 2; ++ai) {
        u32x4 xin[4][2];
#pragma unroll
            for (int m = 0; m < 4; ++m)
#pragma unroll
                for (int bj = 0; bj < 2; ++bj) xin[m][bj] = *(const u32x4*)(xb + (size_t)(row0 + ai * HALF + m * 16) * DM + col0 + bj * HALF);
#pragma unroll
            for (int m = 0; m < 4; ++m) {
                const int row = row0 + ai * HALF + m * 16; float q = 0.f;
#pragma unroll
                for (int bj = 0; bj < 2; ++bj) {
                    f32x4 b0, b1; bf8_to_f32(xin[m][bj], b0, b1);
                    const f32x4 o0 = b0 + acc[ai][bj][m][0] * scale, o1 = b1 + acc[ai][bj][m][1] * scale;
                    acc[ai][bj][m][0] = o0; acc[ai][bj][m][1] = o1;
                    q += ((o0[0] * o0[0] + o0[1] * o0[1]) + (o0[2] * o0[2] + o0[3] * o0[3])) + ((o1[0] * o1[0] + o1[1] * o1[1]) + (o1[2] * o1[2] + o1[3] * o1[3]));
                }
                q += __shfl_xor(q, 16); q += __shfl_xor(q, 32);
                if (fq == 0) __hip_atomic_store((unsigned*)(ss + (size_t)row * 16 + u.pn * 4 + wc), __float_as_uint(q), __ATOMIC_RELAXED, __HIP_MEMORY_SCOPE_AGENT);
            }
            asm volatile("" ::: "memory");
        }
        asm volatile("s_waitcnt vmcnt(0)" ::: "memory");
        unsigned* pc = cnt + 64 * u.pm;
        if ((threadIdx.x & 63) == 0) __hip_atomic_fetch_add(pc, 1u, __ATOMIC_RELAXED, __HIP_MEMORY_SCOPE_AGENT);
        { unsigned sp = 0; while ((unsigned)__builtin_amdgcn_readfirstlane(__hip_atomic_load(pc, __ATOMIC_RELAXED, __HIP_MEMORY_SCOPE_AGENT)) < 32u) { __builtin_amdgcn_s_sleep(2); if (++sp > (1u << 20)) break; } }
        __builtin_amdgcn_fence(__ATOMIC_ACQUIRE, "agent");
        f32x4 gv[2][2];
#pragma unroll
        for (int bj = 0; bj < 2; ++bj) { gv[bj][0] = *(const f32x4*)(gf + col0 + bj * HALF); gv[bj][1] = *(const f32x4*)(gf + col0 + bj * HALF + 4); }
        f32x4 ptv[2][4];
#pragma unroll
        for (int ai = 0; ai < 2; ++ai)
#pragma unroll
            for (int m = 0; m < 4; ++m) ptv[ai][m] = *(const f32x4*)(ss + (size_t)(row0 + ai * HALF + m * 16) * 16 + fq * 4);
#pragma unroll
        for (int ai = 0; ai < 2; ++ai)
#pragma unroll
            for (int m = 0; m < 4; ++m) {
                const int row = row0 + ai * HALF + m * 16; const size_t off = (size_t)row * DM + col0;
                const f32x4 pt = ptv[ai][m];
                float s = (pt[0] + pt[1]) + (pt[2] + pt[3]); s += __shfl_xor(s, 16); s += __shfl_xor(s, 32);
                const float r = 1.0f / sqrtf(s * (1.0f / 1024.0f) + 1e-6f);
#pragma unroll
                for (int bj = 0; bj < 2; ++bj) { *(f32x4*)(out + off + bj * HALF) = acc[ai][bj][m][0] * r * gv[bj][0]; *(f32x4*)(out + off + bj * HALF + 4) = acc[ai][bj][m][1] * r * gv[bj][1]; }
            }
    }
};

template <class Epi, class Sched, bool ALIGN_EPI = false, bool SP2 = false>
__device__ __forceinline__ void gemm_phase(PG8_LAS unsigned char* lds, const Gemm g, const Sched& S, const Epi& E) {
    const int tid = threadIdx.x, wid = __builtin_amdgcn_readfirstlane(tid >> 6), lane = tid & 63, wr = wid >> 2, wc = wid & 3, fr = lane & 15, fq = lane >> 4;
    const int K = g.K, nt = K / BK;
    unsigned voffA[2], voffB[2];
#pragma unroll
    for (int i = 0; i < 2; ++i) { int R, C; stage_rc(tid * 16 + i * 8192, R, C); const int Rb = Epi::PERM ? ((R & ~31) + perm32(R & 31)) : R;
        voffA[i] = (unsigned)(R * K + C) * 2u; voffB[i] = (unsigned)(Rb * K + C) * 2u; }
    const size_t kstep = (size_t)(BK * 2);
    const size_t hstep = (size_t)HALF * K * 2;
    const size_t tstep = 2 * hstep;
    const unsigned ldsw = (unsigned)wid * 1024u;
    const int aoff = lds_byte(wr * 64 + fr, fq * 8), boff = lds_byte(wc * 32 + fr, fq * 8);
#define PG8_SA(b, h) (((b) * 2 + (h)) * HTB)
#define PG8_SB(b, h) ((4 + (b) * 2 + (h)) * HTB)
#define PG8_STAGE(bufoff, gbase, voff) do { _Pragma("unroll") for (int _i = 0; _i < 2; ++_i) \
        __builtin_amdgcn_global_load_lds((const unsigned*)((const char*)(gbase) + (voff)[_i]), (PG8_LAS unsigned*)(lds + (bufoff) + ldsw + _i * 8192), 16, 0, 0); } while (0)
#define PG8_LDA(dst, b, h) do { _Pragma("unroll") for (int m = 0; m < 4; ++m) _Pragma("unroll") for (int k = 0; k < 2; ++k) dst[m][k] = *(const PG8_LAS bf16x8*)(lds + PG8_SA(b, h) + aoff + m * 2048 + k * 1024); } while (0)
#define PG8_LDB(dst, b, h) do { _Pragma("unroll") for (int n = 0; n < 2; ++n) _Pragma("unroll") for (int k = 0; k < 2; ++k) dst[n][k] = *(const PG8_LAS bf16x8*)(lds + PG8_SB(b, h) + boff + n * 2048 + k * 1024); } while (0)
#define PG8_MMA(ai, bj, At, Bt) do { __builtin_amdgcn_s_setprio(1); _Pragma("unroll") for (int m = 0; m < 4; ++m) _Pragma("unroll") for (int n = 0; n < 2; ++n) _Pragma("unroll") for (int k = 0; k < 2; ++k) \
        acc[ai][bj][m][n] = __builtin_amdgcn_mfma_f32_16x16x32_bf16(Bt[n][k], At[m][k], acc[ai][bj][m][n], 0, 0, 0); __builtin_amdgcn_s_setprio(0); } while (0)
#define PG8_WAIT_V(n) asm volatile("s_waitcnt vmcnt(" #n ")" ::: "memory")
#define PG8_WAIT_L(n) asm volatile("s_waitcnt lgkmcnt(" #n ")" ::: "memory")
#define PG8_BAR __builtin_amdgcn_s_barrier()
#define PG8_SCHED __builtin_amdgcn_sched_barrier(0)
    Unit cur, nxt; int ui = 0;
    if (!S.next(0, cur)) return;
    f32x4 acc[2][2][4][2];
#pragma unroll
    for (int a = 0; a < 2; ++a)
#pragma unroll
        for (int b = 0; b < 2; ++b)
#pragma unroll
            for (int m = 0; m < 4; ++m)
#pragma unroll
                for (int n = 0; n < 2; ++n) acc[a][b][m][n] = (f32x4){0.f, 0.f, 0.f, 0.f};
    bf16x8 At[4][2], B0[2][2], B1[2][2];
    const char* cA = (const char*)g.A + (size_t)cur.pm * tstep; const char* cB = (const char*)g.Bt + (size_t)cur.pn * tstep;
    S.a_ready(cur);
    if constexpr (SP2) {
        PG8_STAGE(PG8_SB(0, 0), cB, voffB); PG8_STAGE(PG8_SB(0, 1), cB + hstep, voffB); PG8_STAGE(PG8_SA(0, 0), cA, voffA); PG8_STAGE(PG8_SA(0, 1), cA + hstep, voffA);
        if (wr == 1) PG8_BAR;
        PG8_WAIT_V(2); PG8_BAR;
        PG8_STAGE(PG8_SB(1, 0), cB + kstep, voffB); PG8_STAGE(PG8_SA(1, 0), cA + kstep, voffA); PG8_STAGE(PG8_SB(1, 1), cB + hstep + kstep, voffB);
        PG8_WAIT_V(6); PG8_BAR;
    } else {
        PG8_STAGE(PG8_SB(0, 0), cB, voffB); PG8_STAGE(PG8_SA(0, 0), cA, voffA); PG8_STAGE(PG8_SB(0, 1), cB + hstep, voffB); PG8_STAGE(PG8_SA(0, 1), cA + hstep, voffA);
        if (wr == 1) PG8_BAR;
        PG8_WAIT_V(4); PG8_BAR;
        PG8_STAGE(PG8_SB(1, 0), cB + kstep, voffB); PG8_STAGE(PG8_SA(1, 0), cA + kstep, voffA); PG8_STAGE(PG8_SB(1, 1), cB + hstep + kstep, voffB);
        PG8_WAIT_V(6); PG8_BAR;
    }
    for (;;) {
        const bool has_next = S.next(ui + 1, nxt);
        const char* nA = has_next ? (const char*)g.A + (size_t)nxt.pm * tstep : cA; const char* nB = has_next ? (const char*)g.Bt + (size_t)nxt.pn * tstep : cB;
        for (int t = 0; t < nt; t += 2) {
            const bool last = (t == nt - 2);
            const char* a1 = cA + (size_t)(t + 1) * kstep;
            const char* a2 = last ? nA : cA + (size_t)(t + 2) * kstep; const char* b2 = last ? nB : cB + (size_t)(t + 2) * kstep;
            const char* a3 = a2 + kstep; const char* b3 = b2 + kstep;
            if (last && has_next) S.a_ready(nxt);
            if constexpr (SP2) {
            PG8_LDB(B0, 0, 0); PG8_LDB(B1, 0, 1); PG8_SCHED; PG8_LDA(At, 0, 0); PG8_STAGE(PG8_SA(1, 1), a1 + hstep, voffA);
            PG8_WAIT_V(8); PG8_WAIT_L(0); PG8_BAR; PG8_MMA(0, 0, At, B0); PG8_MMA(0, 1, At, B1); PG8_BAR; PG8_SCHED;
            PG8_LDA(At, 0, 1); PG8_STAGE(PG8_SB(0, 0), b2, voffB); PG8_STAGE(PG8_SB(0, 1), b2 + hstep, voffB); PG8_STAGE(PG8_SA(0, 0), a2, voffA);
            PG8_WAIT_V(8); PG8_WAIT_L(0); PG8_BAR; PG8_MMA(1, 0, At, B0); PG8_MMA(1, 1, At, B1); PG8_BAR; PG8_SCHED;
            PG8_LDB(B0, 1, 0); PG8_LDB(B1, 1, 1); PG8_SCHED; PG8_LDA(At, 1, 0); PG8_STAGE(PG8_SA(0, 1), a2 + hstep, voffA);
            PG8_WAIT_V(8); PG8_WAIT_L(0); PG8_BAR; PG8_MMA(0, 0, At, B0); PG8_MMA(0, 1, At, B1); PG8_BAR; PG8_SCHED;
            PG8_LDA(At, 1, 1); PG8_STAGE(PG8_SB(1, 0), b3, voffB); PG8_STAGE(PG8_SB(1, 1), b3 + hstep, voffB); PG8_STAGE(PG8_SA(1, 0), a3, voffA);
            PG8_WAIT_V(8); PG8_WAIT_L(0); PG8_BAR; PG8_MMA(1, 0, At, B0); PG8_MMA(1, 1, At, B1); PG8_BAR; PG8_SCHED;
            } else {
            PG8_LDB(B0, 0, 0); PG8_SCHED; PG8_LDA(At, 0, 0); PG8_STAGE(PG8_SA(1, 1), a1 + hstep, voffA);
            PG8_WAIT_L(8); PG8_BAR; PG8_WAIT_L(0); PG8_MMA(0, 0, At, B0); PG8_BAR; PG8_SCHED;
            PG8_LDB(B1, 0, 1); PG8_STAGE(PG8_SB(0, 0), b2, voffB);
            PG8_BAR; PG8_WAIT_L(0); PG8_MMA(0, 1, At, B1); PG8_BAR;
            PG8_LDA(At, 0, 1); PG8_STAGE(PG8_SA(0, 0), a2, voffA);
            PG8_BAR; PG8_WAIT_L(0); PG8_MMA(1, 0, At, B0); PG8_BAR; PG8_SCHED;
            PG8_STAGE(PG8_SB(0, 1), b2 + hstep, voffB);
            PG8_WAIT_V(6); PG8_BAR; PG8_MMA(1, 1, At, B1); PG8_BAR;
            PG8_LDB(B0, 1, 0); PG8_SCHED; PG8_LDA(At, 1, 0); PG8_STAGE(PG8_SA(0, 1), a2 + hstep, voffA);
            PG8_WAIT_L(8); PG8_BAR; PG8_WAIT_L(0); PG8_MMA(0, 0, At, B0); PG8_BAR; PG8_SCHED;
            PG8_LDB(B1, 1, 1); PG8_STAGE(PG8_SB(1, 0), b3, voffB);
            PG8_BAR; PG8_WAIT_L(0); PG8_MMA(0, 1, At, B1); PG8_BAR;
            PG8_LDA(At, 1, 1); PG8_STAGE(PG8_SA(1, 0), a3, voffA);
            PG8_BAR; PG8_WAIT_L(0); PG8_MMA(1, 0, At, B0); PG8_BAR; PG8_SCHED;
            PG8_STAGE(PG8_SB(1, 1), b3 + hstep, voffB);
            PG8_WAIT_V(6); PG8_BAR; PG8_MMA(1, 1, At, B1); PG8_BAR;
            }
        }
        if constexpr (ALIGN_EPI) { if (wr == 0) PG8_BAR; }
        if constexpr (!Epi::AFTER_DRAIN) { E(acc, cur, wr, wc, fr, fq); S.done(cur); }
        if (!has_next) break;
#pragma unroll
        for (int a = 0; a < 2; ++a)
#pragma unroll
            for (int b = 0; b < 2; ++b)
#pragma unroll
                for (int m = 0; m < 4; ++m)
#pragma unroll
                    for (int n = 0; n < 2; ++n) acc[a][b][m][n] = (f32x4){0.f, 0.f, 0.f, 0.f};
        cur = nxt; cA = nA; cB = nB; ++ui;
        if constexpr (ALIGN_EPI) { if (wr == 1) PG8_BAR; }
    }
    PG8_WAIT_V(0);
    if constexpr (!ALIGN_EPI) { if (wr == 0) PG8_BAR; }
    PG8_BAR;
#undef PG8_SA
#undef PG8_SB
#undef PG8_STAGE
#undef PG8_LDA
#undef PG8_LDB
#undef PG8_MMA
#undef PG8_WAIT_V
#undef PG8_WAIT_L
#undef PG8_BAR
#undef PG8_SCHED
}
}

#define LDS_WAIT() asm volatile("s_waitcnt lgkmcnt(0)" ::: "memory")
__device__ __forceinline__ unsigned f2bf(float f) { unsigned u = __builtin_bit_cast(unsigned, f); return (u + 0x7fffu + ((u >> 16) & 1u)) >> 16; }
__device__ __forceinline__ unsigned pk2(float lo, float hi) { return f2bf(lo) | (f2bf(hi) << 16); }
__device__ __forceinline__ float bf2f(unsigned b) { return __uint_as_float(b << 16); }
__device__ __forceinline__ float wave_sum(float v) {
#pragma unroll
    for (int o = 1; o < 64; o <<= 1) v += __shfl_xor(v, o);
    return v;
}
__device__ __forceinline__ float wave_max(float v) {
#pragma unroll
    for (int o = 1; o < 64; o <<= 1) v = fmaxf(v, __shfl_xor(v, o));
    return v;
}
__device__ __forceinline__ float wave_incl_sum(float v, int lane) {
#pragma unroll
    for (int o = 1; o < 64; o <<= 1) { const float t = __shfl_up(v, o); if (lane >= o) v += t; }
    return v;
}
__device__ __forceinline__ float wave_incl_max(float v, int lane) {
#pragma unroll
    for (int o = 1; o < 64; o <<= 1) { const float t = __shfl_up(v, o); if (lane >= o) v = fmaxf(v, t); }
    return v;
}
__device__ __forceinline__ float log_sigmoid_f(float x) { return fminf(x, 0.f) - log1pf(expf(-fabsf(x))); }

struct TItem { const float* W; int ldw, src_col0; bf16* WT; int K, dst_row0, k0; const float* gk; };
__device__ __forceinline__ void titem_load(const TItem& t, float (&wv)[32], f32x4 (&gv)[2], int lane) {
    const float* wp = t.W + (size_t)(t.k0 + (lane >> 5)) * t.ldw + t.src_col0 + (lane & 31);
#pragma unroll
    for (int i = 0; i < 32; ++i) wv[i] = __builtin_nontemporal_load(wp + (size_t)(2 * i) * t.ldw);
    if (t.gk) { gv[0] = *(const f32x4*)(t.gk + t.k0 + 8 * (lane & 7)); gv[1] = *(const f32x4*)(t.gk + t.k0 + 8 * (lane & 7) + 4); }
    else { gv[0] = (f32x4){1.f, 1.f, 1.f, 1.f}; gv[1] = gv[0]; }
}
__device__ __forceinline__ void titem_finish(const TItem& t, const float (&wv)[32], const f32x4 (&gv)[2], LAS float* scr, int lane) {
#pragma unroll
    for (int i = 0; i < 32; ++i) scr[(2 * i + (lane >> 5)) * 33 + (lane & 31)] = wv[i];
    LDS_WAIT(); asm volatile("" ::: "memory");
    const int c = lane & 7;
#pragma unroll
    for (int j = 0; j < 4; ++j) { const int n = (lane >> 3) + 8 * j; const LAS float* s = scr + (8 * c) * 33 + n;
        u32x4 o; o.x = pk2(s[0 * 33] * gv[0][0], s[1 * 33] * gv[0][1]); o.y = pk2(s[2 * 33] * gv[0][2], s[3 * 33] * gv[0][3]);
        o.z = pk2(s[4 * 33] * gv[1][0], s[5 * 33] * gv[1][1]); o.w = pk2(s[6 * 33] * gv[1][2], s[7 * 33] * gv[1][3]);
        *(u32x4*)(t.WT + (size_t)(t.dst_row0 + n) * t.K + t.k0 + 8 * c) = o; }
    LDS_WAIT(); asm volatile("" ::: "memory");
}
__device__ __forceinline__ void p0_item(const float* W, int ldw, int src_col0, bf16* WT, int K, int dst_row0, int k0, const float* gk, LAS float* scr, int lane) {
    const TItem t{W, ldw, src_col0, WT, K, dst_row0, k0, gk}; float wv[32]; f32x4 gv[2];
    titem_load(t, wv, gv, lane); titem_finish(t, wv, gv, scr, lane);
}
__device__ __forceinline__ void titem_triple(const TItem& a, const TItem& b, const TItem& c, LAS float* scr, int lane) {
    float wa[32], wb[32], wc[32]; f32x4 ga[2], gb[2], gc[2];
    titem_load(a, wa, ga, lane); titem_load(b, wb, gb, lane); titem_load(c, wc, gc, lane);
    titem_finish(a, wa, ga, scr, lane); titem_finish(b, wb, gb, scr, lane); titem_finish(c, wc, gc, scr, lane);
}
__device__ __forceinline__ void titem_pair(const TItem& a, const TItem& b, LAS float* scr, int lane) {
    float wa[32], wb[32]; f32x4 ga[2], gb[2];
    titem_load(a, wa, ga, lane); titem_load(b, wb, gb, lane);
    titem_finish(a, wa, ga, scr, lane); titem_finish(b, wb, gb, scr, lane);
}

struct Params {
    const float* x; const float* n1; const float* wg1; const float* wu1; const float* wd1;
    const float* nmix; const float* win; const float* bg; const float* convw; const float* convb; const float* mhn;
    const float* poolw; const float* pools; const float* wout; const float* n2; const float* wg2; const float* wu2; const float* wd2; const float* nf;
    float* out; unsigned char* ws;
};

__device__ __forceinline__ void cvt_gu(const Params& p, int set, LAS float* scr, int lane, int gw, int NGW) {
    constexpr int I_GU = 16 * 88;
    bf16* WT = (bf16*)(p.ws + (set ? WS_WGU2 : WS_WGU1)); const float* gk = set ? p.n2 : p.n1;
    auto mk = [&](int it) { const int up = it / I_GU, r = it - up * I_GU, kb = r / 88, nb = r % 88, n0 = 32 * nb;
        const float* W = set ? (up ? p.wu2 : p.wg2) : (up ? p.wu1 : p.wg1);
        return TItem{W, DFF, n0, WT, DM, (n0 >> 7) * 256 + (n0 & 127) + up * 128, 64 * kb, gk}; };
    int it = gw;
    for (; it + NGW < 2 * I_GU; it += 2 * NGW) titem_pair(mk(it), mk(it + NGW), scr, lane);
    if (it < 2 * I_GU) { const TItem t = mk(it); p0_item(t.W, t.ldw, t.src_col0, t.WT, t.K, t.dst_row0, t.k0, t.gk, scr, lane); }
}
__device__ __forceinline__ void cvt_down(const Params& p, int set, LAS float* scr, int lane, int gw, int NGW) {
    auto mk = [&](int it) { const int kb = it / 32, nb = it % 32; return TItem{set ? p.wd2 : p.wd1, DM, 32 * nb, (bf16*)(p.ws + (set ? WS_WD2 : WS_WD1)), DFF, 32 * nb, 64 * kb, nullptr}; };
    int it = gw;
    for (; it + NGW < 44 * 32; it += 2 * NGW) titem_pair(mk(it), mk(it + NGW), scr, lane);
    if (it < 44 * 32) { const TItem t = mk(it); p0_item(t.W, t.ldw, t.src_col0, t.WT, t.K, t.dst_row0, t.k0, t.gk, scr, lane); }
}
__device__ __forceinline__ void cvt_in(const Params& p, LAS float* scr, int lane, int gw, int NGW) {
    bf16* WIN = (bf16*)(p.ws + WS_WIN);
    for (int it = gw; it < 16 * 64 + 16 * 16; it += NGW) {
        if (it < 16 * 64) { const int kb = it / 64, nb = it % 64; p0_item(p.win, DINP, 32 * nb, WIN, DM, 32 * nb, 64 * kb, p.nmix, scr, lane); }
        else { const int r = it - 16 * 64, kb = r / 16, nb = r % 16; p0_item(p.win, DINP, 2056 + 32 * nb, WIN, DM, 2048 + 32 * nb, 64 * kb, p.nmix, scr, lane); }
    }
    for (int wi = gw; wi < 512; wi += NGW) {
        const int idx = wi * 64 + lane, rr = idx >> 7, kc = (idx & 127) * 8;
        u32x4 o = (u32x4){0u, 0u, 0u, 0u};
        if (rr < 8) {
            float v[8];
#pragma unroll
            for (int e = 0; e < 8; ++e) v[e] = p.win[(size_t)(kc + e) * DINP + 2048 + rr] * p.nmix[kc + e];
            o.x = pk2(v[0], v[1]); o.y = pk2(v[2], v[3]); o.z = pk2(v[4], v[5]); o.w = pk2(v[6], v[7]);
        }
        *(u32x4*)(WIN + (size_t)(2560 + rr) * DM + kc) = o;
    }
}
__device__ __forceinline__ void cvt_out(const Params& p, LAS float* scr, int lane, int gw, int NGW) {
    bf16* WOUT = (bf16*)(p.ws + WS_WOUT);
    for (int it = gw; it < 8 * 32; it += NGW) { const int kb = it / 32, nb = it % 32; p0_item(p.wout, DM, 32 * nb, WOUT, DM, 32 * nb, 64 * kb, nullptr, scr, lane); }
    for (int wi = gw; wi < 1024; wi += NGW) {
        const int nblk = wi & 15, cgp = (wi >> 4) & 15, g = wi >> 8, n = nblk * 64 + lane, c0 = cgp * 8;
        float a[8];
#pragma unroll
        for (int e = 0; e < 8; ++e) a[e] = 0.f;
        const float* pw = p.poolw + (size_t)(g * 128 + c0) * 128; const float* ps = p.pools + g * 128; const float* wo = p.wout + (size_t)(512 + g * 128) * DM + n;
        for (int d0 = 0; d0 < 128; d0 += 32) {
            float wv[32];
#pragma unroll
            for (int dd = 0; dd < 32; ++dd) wv[dd] = wo[(size_t)(d0 + dd) * DM];
#pragma unroll
            for (int dd = 0; dd < 32; ++dd) { const float w = wv[dd] * ps[d0 + dd];
#pragma unroll
                for (int e = 0; e < 8; ++e) a[e] += pw[e * 128 + d0 + dd] * w; }
        }
        u32x4 o; o.x = pk2(a[0], a[1]); o.y = pk2(a[2], a[3]); o.z = pk2(a[4], a[5]); o.w = pk2(a[6], a[7]);
        *(u32x4*)(WOUT + (size_t)n * DM + 512 + g * 128 + c0) = o;
    }
}
__device__ __forceinline__ void slack1_items(const Params& p, LAS float* scr, int lane, int gw, int NGW) {
    constexpr int N_D = 44 * 32, N_IN = 16 * 64 + 16 * 16, N_O = 8 * 32, N_T = N_D + N_IN + N_O, N_F = 1024, N_G = 512;
    bf16* WIN = (bf16*)(p.ws + WS_WIN); bf16* WOUT = (bf16*)(p.ws + WS_WOUT);
    auto mkt = [&](int it) {
        if (it < N_D) { const int kb = it / 32, nb = it % 32; return TItem{p.wd1, DM, 32 * nb, (bf16*)(p.ws + WS_WD1), DFF, 32 * nb, 64 * kb, nullptr}; }
        it -= N_D;
        if (it < 16 * 64) { const int kb = it / 64, nb = it % 64; return TItem{p.win, DINP, 32 * nb, WIN, DM, 32 * nb, 64 * kb, p.nmix}; }
        if (it < N_IN) { const int r = it - 16 * 64, kb = r / 16, nb = r % 16; return TItem{p.win, DINP, 2056 + 32 * nb, WIN, DM, 2048 + 32 * nb, 64 * kb, p.nmix}; }
        it -= N_IN;
        { const int kb = it / 32, nb = it % 32; return TItem{p.wout, DM, 32 * nb, WOUT, DM, 32 * nb, 64 * kb, nullptr}; } };
    int it0 = gw;
    if (it0 + 2 * NGW < N_T) { titem_triple(mkt(it0), mkt(it0 + NGW), mkt(it0 + 2 * NGW), scr, lane); it0 += 3 * NGW; }
    else if (it0 + NGW < N_T) { titem_pair(mkt(it0), mkt(it0 + NGW), scr, lane); it0 += 2 * NGW; }
    for (; it0 < N_T + N_F + N_G; it0 += NGW) {
        int it = it0;
        if (it < N_T) { const TItem t = mkt(it); p0_item(t.W, t.ldw, t.src_col0, t.WT, t.K, t.dst_row0, t.k0, t.gk, scr, lane); continue; }
        it -= N_T;
        if (it < N_F) {
            const int wi = it, nblk = wi & 15, cgp = (wi >> 4) & 15, g = wi >> 8, n = nblk * 64 + lane, c0 = cgp * 8;
            float a[8];
#pragma unroll
            for (int e = 0; e < 8; ++e) a[e] = 0.f;
            const float* pw = p.poolw + (size_t)(g * 128 + c0) * 128; const float* ps = p.pools + g * 128; const float* wo = p.wout + (size_t)(512 + g * 128) * DM + n;
            for (int d0 = 0; d0 < 128; d0 += 32) {
                float wv[32];
#pragma unroll
                for (int dd = 0; dd < 32; ++dd) wv[dd] = wo[(size_t)(d0 + dd) * DM];
#pragma unroll
                for (int dd = 0; dd < 32; ++dd) { const float w = wv[dd] * ps[d0 + dd];
#pragma unroll
                    for (int e = 0; e < 8; ++e) a[e] += pw[e * 128 + d0 + dd] * w; }
            }
            u32x4 o; o.x = pk2(a[0], a[1]); o.y = pk2(a[2], a[3]); o.z = pk2(a[4], a[5]); o.w = pk2(a[6], a[7]);
            *(u32x4*)(WOUT + (size_t)n * DM + 512 + g * 128 + c0) = o;
            continue;
        }
        it -= N_F;
        {
            const int idx = it * 64 + lane, rr = idx >> 7, kc = (idx & 127) * 8;
            u32x4 o = (u32x4){0u, 0u, 0u, 0u};
            if (rr < 8) {
                float v[8];
#pragma unroll
                for (int e = 0; e < 8; ++e) v[e] = p.win[(size_t)(kc + e) * DINP + 2048 + rr] * p.nmix[kc + e];
                o.x = pk2(v[0], v[1]); o.y = pk2(v[2], v[3]); o.z = pk2(v[4], v[5]); o.w = pk2(v[6], v[7]);
            }
            *(u32x4*)(WIN + (size_t)(2560 + rr) * DM + kc) = o;
        }
    }
}
__device__ __forceinline__ void p0_prologue(const Params& p, LAS unsigned char* lds, int G) {
    const int tid = threadIdx.x, lane = tid & 63, wave = __builtin_amdgcn_readfirstlane(tid >> 6);
    LAS float* scr = (LAS float*)(lds + wave * 8448);
    const int gw = blockIdx.x * 8 + wave, NGW = G * 8;
    cvt_gu(p, 0, scr, lane, gw, NGW);
    bf16* XB = (bf16*)(p.ws + WS_XB); float* SS0 = (float*)(p.ws + WS_SS0);
    for (int m0 = gw * 4; m0 < S; m0 += NGW * 4) {
        f32x4 v[4][4];
#pragma unroll
        for (int rr = 0; rr < 4; ++rr) { const f32x4* xr = (const f32x4*)(p.x + (size_t)(m0 + rr) * DM) + lane;
#pragma unroll
            for (int j = 0; j < 4; ++j) v[rr][j] = __builtin_nontemporal_load(xr + 64 * j); }
#pragma unroll
        for (int rr = 0; rr < 4; ++rr) {
            float s = 0.f;
#pragma unroll
            for (int j = 0; j < 4; ++j) s += (v[rr][j][0] * v[rr][j][0] + v[rr][j][1] * v[rr][j][1]) + (v[rr][j][2] * v[rr][j][2] + v[rr][j][3] * v[rr][j][3]);
            s = wave_sum(s);
            u32x2* o8 = (u32x2*)(XB + (size_t)(m0 + rr) * DM) + lane;
#pragma unroll
            for (int j = 0; j < 4; ++j) { u32x2 w; w.x = pk2(v[rr][j][0], v[rr][j][1]); w.y = pk2(v[rr][j][2], v[rr][j][3]); o8[64 * j] = w; }
            if (lane < 16) SS0[(size_t)(m0 + rr) * 16 + lane] = lane == 0 ? s : 0.f;
        }
    }
}
__device__ __forceinline__ bool slack_rank(int nwg, int G, int& gw, int& NGW) {
    const int imax = (nwg - 1) / G, cb = nwg - imax * G;
    if ((int)blockIdx.x < cb || cb >= G) return false;
    gw = ((int)blockIdx.x - cb) * 8 + (int)__builtin_amdgcn_readfirstlane(threadIdx.x >> 6); NGW = (G - cb) * 8; return true;
}

constexpr int L_QS = 0, L_KS = 17408, L_VT = 34816, L_CT = 53248, L_PS = 88064, L_OS = 97280, L_SM = 114688;
constexpr int QP = 136, TP = 72;

__device__ __forceinline__ int tsw(int row, int col) { return row * TP + (col ^ (((row >> 3) & 7) << 3)); }
__device__ __forceinline__ void unpack8(const u32x4 v, float (&f)[8]) {
    f[0] = __uint_as_float(v.x << 16); f[1] = __uint_as_float(v.x & 0xffff0000u); f[2] = __uint_as_float(v.y << 16); f[3] = __uint_as_float(v.y & 0xffff0000u);
    f[4] = __uint_as_float(v.z << 16); f[5] = __uint_as_float(v.z & 0xffff0000u); f[6] = __uint_as_float(v.w << 16); f[7] = __uint_as_float(v.w & 0xffff0000u);
}
__device__ __forceinline__ void conv8(const bf16* proj, int t, int ch, const float* cw, const float* cb, float sc, float (&o)[8]) {
    { const f32x4 b0 = *(const f32x4*)(cb + ch), b1 = *(const f32x4*)(cb + ch + 4);
      o[0] = b0[0]; o[1] = b0[1]; o[2] = b0[2]; o[3] = b0[3]; o[4] = b1[0]; o[5] = b1[1]; o[6] = b1[2]; o[7] = b1[3]; }
#pragma unroll
    for (int w = 0; w < 4; ++w) {
        const int tr = t - 3 + w;
        if (tr >= 0) {
            const u32x4 raw = *(const u32x4*)(proj + (size_t)tr * NPROJ + ch); float xv[8]; unpack8(raw, xv);
            const f32x4 w0 = *(const f32x4*)(cw + w * 1024 + ch), w1 = *(const f32x4*)(cw + w * 1024 + ch + 4);
            o[0] += w0[0] * xv[0]; o[1] += w0[1] * xv[1]; o[2] += w0[2] * xv[2]; o[3] += w0[3] * xv[3];
            o[4] += w1[0] * xv[4]; o[5] += w1[1] * xv[5]; o[6] += w1[2] * xv[6]; o[7] += w1[3] * xv[7];
        }
    }
#pragma unroll
    for (int e = 0; e < 8; ++e) o[e] = o[e] * sc * __builtin_amdgcn_rcpf(1.0f + __expf(-o[e]));
}
__device__ __forceinline__ void conv4x8(const bf16* proj, int t, int ch, const float* cw, const float* cb, float sc, float (&o)[4][8]) {
    u32x4 raw[7];
#pragma unroll
    for (int i = 0; i < 7; ++i) { const int tr = t - 3 + i; raw[i] = tr >= 0 ? *(const u32x4*)(proj + (size_t)tr * NPROJ + ch) : (u32x4){0u, 0u, 0u, 0u}; }
    { const f32x4 b0 = *(const f32x4*)(cb + ch), b1 = *(const f32x4*)(cb + ch + 4);
#pragma unroll
      for (int j = 0; j < 4; ++j) { o[j][0] = b0[0]; o[j][1] = b0[1]; o[j][2] = b0[2]; o[j][3] = b0[3]; o[j][4] = b1[0]; o[j][5] = b1[1]; o[j][6] = b1[2]; o[j][7] = b1[3]; } }
#pragma unroll
    for (int w = 0; w < 4; ++w) {
        const f32x4 w0 = *(const f32x4*)(cw + w * 1024 + ch), w1 = *(const f32x4*)(cw + w * 1024 + ch + 4);
        const float wv[8] = {w0[0], w0[1], w0[2], w0[3], w1[0], w1[1], w1[2], w1[3]};
#pragma unroll
        for (int j = 0; j < 4; ++j) { float xv[8]; unpack8(raw[j + w], xv);
#pragma unroll
            for (int e = 0; e < 8; ++e) o[j][e] += wv[e] * xv[e]; }
    }
#pragma unroll
    for (int j = 0; j < 4; ++j)
#pragma unroll
        for (int e = 0; e < 8; ++e) o[j][e] = o[j][e] * sc * __builtin_amdgcn_rcpf(1.0f + __expf(-o[j][e]));
}
__device__ __forceinline__ u32x4 pack8(const float (&v)[8]) { u32x4 o; o.x = pk2(v[0], v[1]); o.y = pk2(v[2], v[3]); o.z = pk2(v[4], v[5]); o.w = pk2(v[6], v[7]); return o; }

__device__ __forceinline__ void m1_phase(const Params& p, unsigned char* ldsg, int G) {
    const int tid = threadIdx.x, lane = tid & 63, wave = __builtin_amdgcn_readfirstlane(tid >> 6), fr = lane & 15, fq = lane >> 4;
    const int half = wave >> 2, hw = wave & 3, htid = tid & 255;
    unsigned char* ws = p.ws;
    const bf16* PROJ = (const bf16*)(ws + WS_HB); const float* GATES = (const float*)(ws + WS_GATES);
    bf16* DCB = (bf16*)p.out; bf16* QKC = (bf16*)((unsigned char*)p.out + 32 * MiB); float* DN = (float*)(ws + WS_DN); float* GARR = (float*)(ws + WS_SC); float* AMAXARR = GARR + 1024;
    bf16* KT = (bf16*)(ldsg + half * 40960); bf16* VT = KT + 128 * TP; float* sW = (float*)(ldsg + half * 40960 + 36864);
    for (int r = blockIdx.x; r < NCH * NH / 2; r += G) {
        const int c = r >> 1, h = 2 * (r & 1) + half, u = c * 4 + h, t0 = c * CL;
        if (hw == 0) {
            const float ig = GATES[(size_t)(t0 + lane) * 8 + h], fp = GATES[(size_t)(t0 + lane) * 8 + 4 + h];
            const float b = wave_incl_sum(log_sigmoid_f(fp), lane);
            const float g = __shfl(b, 63);
            const float a = g - b + ig;
            const float amax = wave_max(a);
            sW[lane] = expf(a - amax);
            if (lane == 0) { GARR[h * NCH + c] = g; AMAXARR[h * NCH + c] = amax; }
        }
        const int rg = htid >> 4, cgp = htid & 15, l0 = 4 * rg;
        float kk[4][8];
        {
            float qv[4][8];
            conv4x8(PROJ, t0 + l0, h * HD + cgp * 8, p.convw, p.convb, 1.0f, qv);
#pragma unroll
            for (int j = 0; j < 4; ++j) *(u32x4*)(QKC + (size_t)(t0 + l0 + j) * DM + h * HD + cgp * 8) = pack8(qv[j]);
        }
        asm volatile("" ::: "memory");
        conv4x8(PROJ, t0 + l0, 512 + h * HD + cgp * 8, p.convw, p.convb, 0.08838834764831845f, kk);
#pragma unroll
        for (int j = 0; j < 4; ++j) *(u32x4*)(QKC + (size_t)(t0 + l0 + j) * DM + 512 + h * HD + cgp * 8) = pack8(kk[j]);
        {
            u32x4 rv[4];
#pragma unroll
            for (int j = 0; j < 4; ++j) rv[j] = *(const u32x4*)(PROJ + (size_t)(t0 + l0 + j) * NPROJ + 1024 + h * HD + cgp * 8);
#pragma unroll
            for (int e = 0; e < 8; ++e) {
                const unsigned sh = (e & 1) * 16;
                u32x2 o; o.x = ((rv[0][e >> 1] >> sh) & 0xffffu) | (((rv[1][e >> 1] >> sh) & 0xffffu) << 16); o.y = ((rv[2][e >> 1] >> sh) & 0xffffu) | (((rv[3][e >> 1] >> sh) & 0xffffu) << 16);
                *(u32x2*)(VT + tsw(cgp * 8 + e, l0)) = o;
            }
        }
        __syncthreads();
        {
            const f32x4 w4 = *(const f32x4*)(sW + l0);
#pragma unroll
            for (int e = 0; e < 8; ++e) { u32x2 o; o.x = pk2(kk[0][e] * w4[0], kk[1][e] * w4[1]); o.y = pk2(kk[2][e] * w4[2], kk[3][e] * w4[3]); *(u32x2*)(KT + tsw(cgp * 8 + e, l0)) = o; }
        }
        __syncthreads();
        {
            bf16x8 av[2][2];
#pragma unroll
            for (int mi = 0; mi < 2; ++mi)
#pragma unroll
                for (int ks = 0; ks < 2; ++ks) av[mi][ks] = *(const bf16x8*)(VT + tsw(16 * (2 * hw + mi) + fr, ks * 32 + fq * 8));
#pragma unroll
            for (int nt = 0; nt < 8; ++nt) {
                bf16x8 bk[2];
#pragma unroll
                for (int ks = 0; ks < 2; ++ks) bk[ks] = *(const bf16x8*)(KT + tsw(16 * nt + fr, ks * 32 + fq * 8));
#pragma unroll
                for (int mi = 0; mi < 2; ++mi) {
                    f32x4 acc = (f32x4){0.f, 0.f, 0.f, 0.f};
#pragma unroll
                    for (int ks = 0; ks < 2; ++ks) acc = __builtin_amdgcn_mfma_f32_16x16x32_bf16(bk[ks], av[mi][ks], acc, 0, 0, 0);
                    u32x2 o; o.x = pk2(acc[0], acc[1]); o.y = pk2(acc[2], acc[3]);
                    { const int vd = 16 * (2 * hw + mi) + fr; *(u32x2*)(DCB + ((size_t)((h * 64 + (vd >> 1)) * NCH + c) << 8) + (vd & 1) * 128 + 16 * nt + fq * 4) = o; }
                }
            }
            if (htid < 128) { float s = 0.f;
#pragma unroll 8
                for (int l = 0; l < 64; ++l) s += bf2f(KT[htid * TP + l]);
                DN[(size_t)(h * NCH + c) * 128 + htid] = s; }
        }
        __syncthreads();
    }
    bf16* MIX = (bf16*)(ws + WS_MIX);
    for (int rb = blockIdx.x; rb < S / 64; rb += G) {
        const int cg8 = tid & 63, rg = tid >> 6, ch0 = cg8 * 8, gi = ch0 >> 7, win = 2 << gi, tq = rb * 64 + rg * 8;
        const bf16* up = PROJ + 2048 + ch0;
        u32x4 slot[23];
#pragma unroll
        for (int s = 0; s < 23; ++s) { const int row = tq - 15 + s; slot[s] = (s + win >= 16 && row >= 0) ? *(const u32x4*)(up + (size_t)row * NPROJ) : (u32x4){0u, 0u, 0u, 0u}; }
        float sum[8];
#pragma unroll
        for (int e = 0; e < 8; ++e) sum[e] = 0.f;
#pragma unroll
        for (int s = 0; s < 15; ++s) { float xv[8]; unpack8(slot[s], xv); const bool in = (s + win > 15);
#pragma unroll
            for (int e = 0; e < 8; ++e) sum[e] += in ? xv[e] : 0.f; }
#pragma unroll
        for (int i = 0; i < 8; ++i) {
            float ut[8]; unpack8(slot[15 + i], ut);
#pragma unroll
            for (int e = 0; e < 8; ++e) sum[e] += ut[e];
            const int t = tq + i; const float inv = 1.0f / (float)((t + 1) < win ? (t + 1) : win);
            float o[8];
#pragma unroll
            for (int e = 0; e < 8; ++e) o[e] = sum[e] * inv - ut[e];
            *(u32x4*)(MIX + (size_t)t * DM + 512 + ch0) = pack8(o);
            if (i < 7) {
                u32x4 d;
#pragma unroll
                for (int q = 0; q < 4; ++q) d[q] = gi == 0 ? slot[14 + i][q] : gi == 1 ? slot[12 + i][q] : gi == 2 ? slot[8 + i][q] : slot[i][q];
                float dv[8]; unpack8(d, dv);
#pragma unroll
                for (int e = 0; e < 8; ++e) sum[e] -= dv[e];
            }
        }
    }
}

__device__ __forceinline__ void m2_phase(const Params& p, unsigned char* ldsg, int G) {
    const int tid = threadIdx.x, lane = tid & 63, wave = __builtin_amdgcn_readfirstlane(tid >> 6);
    unsigned char* ws = p.ws;
    bf16* DCB = (bf16*)p.out; float* DN = (float*)(ws + WS_DN); const float* GARR = (const float*)(ws + WS_SC); const float* AMAXARR = GARR + 1024; float* MPREV = (float*)(ws + WS_SC) + 2048;
    float* sA = (float*)ldsg; float* sB = sA + 256; float* sAseg = sA + 512; float* sTot = sA + 1024;
    for (int it = blockIdx.x; it < 256; it += G) {
        const int h = it >> 6, slice = it & 63, c0 = 32 * wave;
        u32x2 x[32];
        char* ub = (char*)DCB + (((size_t)((h * 64 + slice) * NCH + c0) << 8) * 2);
        const unsigned loff = (unsigned)lane * 8u;
#pragma unroll
        for (int i = 0; i < 32; ++i) x[i] = *(const u32x2*)(ub + (size_t)i * 512 + loff);
        if (wave == 0) {
            const f32x4 g4 = *(const f32x4*)(GARR + h * NCH + 4 * lane), a4 = *(const f32x4*)(AMAXARR + h * NCH + 4 * lane);
            const float tot = (g4[0] + g4[1]) + (g4[2] + g4[3]);
            const float inc = wave_incl_sum(tot, lane); const float pbase = inc - tot;
            float P[5]; P[0] = pbase; P[1] = P[0] + g4[0]; P[2] = P[1] + g4[1]; P[3] = P[2] + g4[2]; P[4] = P[3] + g4[3];
            float z[4];
#pragma unroll
            for (int i = 0; i < 4; ++i) z[i] = a4[i] - P[i + 1];
            const float zl = fmaxf(fmaxf(z[0], z[1]), fmaxf(z[2], z[3]));
            const float zi = wave_incl_max(zl, lane); float zprev = __shfl_up(zi, 1); if (lane == 0) zprev = 0.f; zprev = fmaxf(zprev, 0.f);
            float Z = zprev;
#pragma unroll
            for (int i = 0; i < 4; ++i) {
                const float m = P[i] + Z; const float Zn = fmaxf(Z, z[i]); const float mn = P[i + 1] + Zn;
                sA[4 * lane + i] = expf(g4[i] + m - mn); sB[4 * lane + i] = expf(a4[i] - mn);
                if (slice == 0) MPREV[h * NCH + 4 * lane + i] = m;
                Z = Zn;
            }
        }
        __syncthreads();
        {
            float l0 = 0.f, l1 = 0.f, l2 = 0.f, l3 = 0.f, ap = 1.f;
#pragma unroll
            for (int i = 0; i < 32; ++i) { const float a = sA[c0 + i], b = sB[c0 + i];
                l0 = a * l0 + b * __uint_as_float(x[i].x << 16); l1 = a * l1 + b * __uint_as_float(x[i].x & 0xffff0000u);
                l2 = a * l2 + b * __uint_as_float(x[i].y << 16); l3 = a * l3 + b * __uint_as_float(x[i].y & 0xffff0000u); ap *= a; }
            *(f32x4*)(sTot + wave * 256 + lane * 4) = (f32x4){l0, l1, l2, l3};
            if (lane == 0) sAseg[wave] = ap;
        }
        __syncthreads();
        {
            float l0 = 0.f, l1 = 0.f, l2 = 0.f, l3 = 0.f;
            for (int j = 0; j < wave; ++j) { const float a = sAseg[j]; const f32x4 tv = *(const f32x4*)(sTot + j * 256 + lane * 4);
                l0 = a * l0 + tv[0]; l1 = a * l1 + tv[1]; l2 = a * l2 + tv[2]; l3 = a * l3 + tv[3]; }
#pragma unroll
            for (int i = 0; i < 32; ++i) { const float a = sA[c0 + i], b = sB[c0 + i];
                u32x2 o; o.x = pk2(l0, l1); o.y = pk2(l2, l3); *(u32x2*)(ub + (size_t)i * 512 + loff) = o;
                l0 = a * l0 + b * __uint_as_float(x[i].x << 16); l1 = a * l1 + b * __uint_as_float(x[i].x & 0xffff0000u);
                l2 = a * l2 + b * __uint_as_float(x[i].y << 16); l3 = a * l3 + b * __uint_as_float(x[i].y & 0xffff0000u); }
        }
        if (slice == 0) {
            __syncthreads();
            typedef float f32x2 __attribute__((ext_vector_type(2)));
            char* nb = (char*)DN + ((size_t)(h * NCH + c0) * 128) * 4;
            f32x2 y[32];
#pragma unroll
            for (int i = 0; i < 32; ++i) y[i] = *(const f32x2*)(nb + (size_t)i * 512 + loff);
            f32x2 l = (f32x2){0.f, 0.f};
#pragma unroll
            for (int i = 0; i < 32; ++i) l = l * sA[c0 + i] + y[i] * sB[c0 + i];
            *(f32x2*)(sTot + wave * 256 + lane * 2) = l;
            __syncthreads();
            l = (f32x2){0.f, 0.f};
            for (int j = 0; j < wave; ++j) l = l * sAseg[j] + *(const f32x2*)(sTot + j * 256 + lane * 2);
#pragma unroll
            for (int i = 0; i < 32; ++i) { *(f32x2*)(nb + (size_t)i * 512 + loff) = l; l = l * sA[c0 + i] + y[i] * sB[c0 + i]; }
        }
        __syncthreads();
    }
}

__device__ __forceinline__ void m3_phase(const Params& p, unsigned char* ldsg, int G) {
    const int tid = threadIdx.x, lane = tid & 63, wave = __builtin_amdgcn_readfirstlane(tid >> 6), fr = lane & 15, fq = lane >> 4;
    unsigned char* ws = p.ws;
    const bf16* PROJ = (const bf16*)(ws + WS_HB); const float* GATES = (const float*)(ws + WS_GATES); const bf16* QKC = (const bf16*)((const unsigned char*)p.out + 32 * MiB);
    const bf16* CPB = (const bf16*)p.out; const float* DN = (const float*)(ws + WS_DN); const float* MPREV = (const float*)(ws + WS_SC) + 2048;
    bf16* MIX = (bf16*)(ws + WS_MIX);
    bf16* Qs = (bf16*)(ldsg + L_QS); bf16* Ks = (bf16*)(ldsg + L_KS); bf16* VT = (bf16*)(ldsg + L_VT); bf16* CTs = (bf16*)(ldsg + L_CT); bf16* Ps = (bf16*)(ldsg + L_PS); bf16* Os = (bf16*)(ldsg + L_OS);
    float* sU = (float*)(ldsg + L_SM); float* sM = sU + 64; float* sIW = sU + 128; float* sEMT = sU + 192; float* sRS = sU + 256; float* sQN = sU + 320; float* sHS = sU + 384; float* sN = sU + 448;
    for (int u = blockIdx.x; u < NCH * NH; u += G) {
        const int c = u >> 2, h = u & 3, t0 = c * CL;
        {
            const int r = tid >> 4, cgp = tid & 15;
            u32x4 gq[2], gk[2], gv[2], go[2], gc[4];
#pragma unroll
            for (int pass = 0; pass < 2; ++pass) { const size_t t = t0 + r + 32 * pass;
                gq[pass] = *(const u32x4*)(QKC + t * DM + h * HD + cgp * 8); gk[pass] = *(const u32x4*)(QKC + t * DM + 512 + h * HD + cgp * 8);
                gv[pass] = *(const u32x4*)(PROJ + t * NPROJ + 1024 + h * HD + cgp * 8); go[pass] = *(const u32x4*)(PROJ + t * NPROJ + 1536 + h * HD + cgp * 8); }
#pragma unroll
            for (int i = 0; i < 4; ++i) { const int idx = tid + 512 * i; gc[i] = *(const u32x4*)(CPB + ((size_t)((h * 64 + (idx >> 5)) * NCH + c) << 8) + (idx & 31) * 8); }
            if (wave == 0) {
                const float ig = GATES[(size_t)(t0 + lane) * 8 + h], fp = GATES[(size_t)(t0 + lane) * 8 + 4 + h];
                const float b = wave_incl_sum(log_sigmoid_f(fp), lane);
                const float uu = ig - b;
                const float U = wave_incl_max(uu, lane);
                const float mp = MPREV[h * NCH + c];
                const float M = fmaxf(mp, U);
                sU[lane] = uu; sM[lane] = M; sIW[lane] = expf(mp - M); sEMT[lane] = expf(-(b + M)); sRS[lane] = 0.f; sHS[lane] = 0.f;
            } else if (wave == 1) {
                sN[lane] = DN[(size_t)(h * NCH + c) * 128 + lane]; sN[lane + 64] = DN[(size_t)(h * NCH + c) * 128 + 64 + lane];
            }
#pragma unroll
            for (int pass = 0; pass < 2; ++pass) { const int l = r + 32 * pass;
                *(u32x4*)(Qs + l * QP + cgp * 8) = gq[pass]; *(u32x4*)(Ks + l * QP + cgp * 8) = gk[pass]; *(u32x4*)(Os + l * QP + cgp * 8) = go[pass];
#pragma unroll
                for (int e = 0; e < 8; ++e) VT[tsw(cgp * 8 + e, l)] = (bf16)(gv[pass][e >> 1] >> ((e & 1) * 16)); }
#pragma unroll
            for (int i = 0; i < 4; ++i) { const int idx = tid + 512 * i, vd = idx >> 4, kc = (idx & 15) * 8; *(u32x4*)(CTs + vd * QP + kc) = gc[i]; }
        }
        __syncthreads();
        {
            const int l = tid >> 3, part = tid & 7; float s = 0.f;
#pragma unroll
            for (int e = 0; e < 16; ++e) s += bf2f(Qs[l * QP + part * 16 + e]) * sN[part * 16 + e];
            s += __shfl_xor(s, 1); s += __shfl_xor(s, 2); s += __shfl_xor(s, 4);
            if (part == 0) sQN[l] = s;
        }
        const int lt = wave >> 1;
        {
            bf16x8 aq[4];
#pragma unroll
            for (int ks = 0; ks < 4; ++ks) aq[ks] = *(const bf16x8*)(Qs + (16 * lt + fr) * QP + ks * 32 + fq * 8);
            float rs[4] = {0.f, 0.f, 0.f, 0.f};
#pragma unroll
            for (int si = 0; si < 2; ++si) {
                const int st = 2 * (wave & 1) + si;
                f32x4 acc = (f32x4){0.f, 0.f, 0.f, 0.f};
#pragma unroll
                for (int ks = 0; ks < 4; ++ks) { const bf16x8 b = *(const bf16x8*)(Ks + (16 * st + fr) * QP + ks * 32 + fq * 8); acc = __builtin_amdgcn_mfma_f32_16x16x32_bf16(aq[ks], b, acc, 0, 0, 0); }
                const int s = 16 * st + fr; const float us = sU[s];
#pragma unroll
                for (int j = 0; j < 4; ++j) { const int l = 16 * lt + fq * 4 + j; const float val = (s <= l) ? acc[j] * expf(us - sM[l]) : 0.f; Ps[l * TP + s] = (bf16)f2bf(val); rs[j] += val; }
            }
#pragma unroll
            for (int j = 0; j < 4; ++j) { float v = rs[j]; v += __shfl_xor(v, 1); v += __shfl_xor(v, 2); v += __shfl_xor(v, 4); v += __shfl_xor(v, 8); if (fr == 0) atomicAdd(&sRS[16 * lt + fq * 4 + j], v); }
        }
        __syncthreads();
        {
            f32x4 a1[4], a2[4];
#pragma unroll
            for (int n = 0; n < 4; ++n) { a1[n] = (f32x4){0.f, 0.f, 0.f, 0.f}; a2[n] = (f32x4){0.f, 0.f, 0.f, 0.f}; }
#pragma unroll
            for (int ks = 0; ks < 2; ++ks) { const bf16x8 a = *(const bf16x8*)(Ps + (16 * lt + fr) * TP + ks * 32 + fq * 8);
#pragma unroll
                for (int n = 0; n < 4; ++n) { const int nt = 4 * (wave & 1) + n; const bf16x8 b = *(const bf16x8*)(VT + tsw(16 * nt + fr, ks * 32 + fq * 8)); a1[n] = __builtin_amdgcn_mfma_f32_16x16x32_bf16(a, b, a1[n], 0, 0, 0); } }
#pragma unroll
            for (int ks = 0; ks < 4; ++ks) { const bf16x8 a = *(const bf16x8*)(Qs + (16 * lt + fr) * QP + ks * 32 + fq * 8);
#pragma unroll
                for (int n = 0; n < 4; ++n) { const int nt = 4 * (wave & 1) + n; const bf16x8 b = *(const bf16x8*)(CTs + (16 * nt + fr) * QP + ks * 32 + fq * 8); a2[n] = __builtin_amdgcn_mfma_f32_16x16x32_bf16(a, b, a2[n], 0, 0, 0); } }
#pragma unroll
            for (int j = 0; j < 4; ++j) {
                const int l = 16 * lt + fq * 4 + j; const float iw = sIW[l]; const float qn = sRS[l] + iw * sQN[l];
                const float den = fmaxf(fabsf(qn), sEMT[l]); const float inv = 1.0f / den; float hs = 0.f;
#pragma unroll
                for (int n = 0; n < 4; ++n) { const float v = (a1[n][j] + iw * a2[n][j]) * inv; hs += v * v; Ks[l * QP + 16 * (4 * (wave & 1) + n) + fr] = (bf16)f2bf(v); }
                hs += __shfl_xor(hs, 1); hs += __shfl_xor(hs, 2); hs += __shfl_xor(hs, 4); hs += __shfl_xor(hs, 8);
                if (fr == 0) atomicAdd(&sHS[l], hs);
            }
        }
        __syncthreads();
        {
            const int r = tid >> 4, cgp = tid & 15;
            const f32x4 n0 = *(const f32x4*)(p.mhn + h * HD + cgp * 8), n1 = *(const f32x4*)(p.mhn + h * HD + cgp * 8 + 4);
            const float nn[8] = {n0[0], n0[1], n0[2], n0[3], n1[0], n1[1], n1[2], n1[3]};
#pragma unroll
            for (int pass = 0; pass < 2; ++pass) { const int l = r + 32 * pass; const float rinv = 1.0f / sqrtf(sHS[l] * (1.0f / 128.0f) + EPS);
                float hv[8], ov[8], o[8]; unpack8(*(const u32x4*)(Ks + l * QP + cgp * 8), hv); unpack8(*(const u32x4*)(Os + l * QP + cgp * 8), ov);
#pragma unroll
                for (int e = 0; e < 8; ++e) o[e] = hv[e] * rinv * nn[e] * __builtin_amdgcn_rcpf(1.0f + __expf(-ov[e]));
                *(u32x4*)(MIX + (size_t)(t0 + l) * DM + h * HD + cgp * 8) = pack8(o); }
        }
        __syncthreads();
    }
}

#define XB_TMO      128
#define XB_XCNT(j)  (256  + 64 * (j))
#define XB_XSUB(j)  (1280 + 64 * (j))
#define XB_XGEN(j)  (2304 + 64 * (j))
#define XB_TOP      3328
#define XB_TOPGEN   3392
#define XCD_BAR_WORDS 3456
#define XB_SPIN_CAP (1u << 18)
__device__ __forceinline__ unsigned xb_ld(unsigned* p)              { return __hip_atomic_load(p, __ATOMIC_RELAXED, __HIP_MEMORY_SCOPE_AGENT); }
__device__ __forceinline__ unsigned xb_add(unsigned* p, unsigned v) { return __hip_atomic_fetch_add(p, v, __ATOMIC_RELAXED, __HIP_MEMORY_SCOPE_AGENT); }
__device__ __forceinline__ unsigned xb_xcc_id() { return (unsigned)__builtin_amdgcn_s_getreg((3 << 11) | 20) & 0xFu; }
#define XB_SPIN(cond, bar) do { unsigned _sp = 0; while (cond) { __builtin_amdgcn_s_sleep(1); \
    if ((++_sp & 255u) == 0u) { if (xb_ld(&(bar)[XB_TMO])) break; if (_sp > XB_SPIN_CAP) { atomicAdd(&(bar)[XB_TMO], 1u); break; } } } } while (0)
struct XcdBarrier { unsigned* bar; unsigned x; volatile LAS unsigned* st; };
__device__ __forceinline__ XcdBarrier xcd_barrier_post(unsigned* bar, volatile LAS unsigned* st) {
    XcdBarrier b; b.bar = bar; b.x = xb_xcc_id(); b.st = st;
    if (threadIdx.x == 0) (void)xb_add(&bar[XB_XCNT(b.x)], 1u);
    return b;
}
__device__ __forceinline__ void xcd_barrier_complete(unsigned* bar, unsigned x, unsigned& nloc, unsigned& nx) {
    const unsigned G = gridDim.x * gridDim.y * gridDim.z;
    unsigned sum, cnt, mine, sp = 0u;
    for (;;) {
        sum = 0u; cnt = 0u; mine = 0u;
#pragma unroll
        for (unsigned j = 0; j < 16; ++j) { const unsigned c = xb_ld(&bar[XB_XCNT(j)]); sum += c; cnt += (c > 0u) ? 1u : 0u; mine = (j == x) ? c : mine; }
        if (sum == G) break;
        __builtin_amdgcn_s_sleep(1);
        if ((++sp & 255u) == 0u) { if (xb_ld(&bar[XB_TMO])) break; if (sp > XB_SPIN_CAP) { atomicAdd(&bar[XB_TMO], 1u); break; } }
    }
    nloc = mine > 0u ? mine : 1u; nx = cnt > 0u ? cnt : 1u;
}
__device__ __forceinline__ void xcd_barrier(const XcdBarrier& b) {
    asm volatile("s_waitcnt vmcnt(0)" ::: "memory");
    __syncthreads();
    if (threadIdx.x == 0) {
        unsigned* bar = b.bar;
        __builtin_amdgcn_s_waitcnt(0);
        unsigned nloc = b.st[0], nx = b.st[1];
        if (nloc == 0u) { xcd_barrier_complete(bar, b.x, nloc, nx); b.st[0] = nloc; b.st[1] = nx; }
        const unsigned old = xb_add(&bar[XB_XSUB(b.x)], 1u);
        const unsigned gen = old / nloc;
        if (old + 1u == (gen + 1u) * nloc) {
            __builtin_amdgcn_fence(__ATOMIC_RELEASE, "agent");
            asm volatile("s_waitcnt vmcnt(0)" ::: "memory");
            const unsigned og = xb_add(&bar[XB_TOP], 1u);
            const unsigned tg = og / nx;
            if (og + 1u == (tg + 1u) * nx) xb_add(&bar[XB_TOPGEN], 1u);
            else XB_SPIN(xb_ld(&bar[XB_TOPGEN]) == tg, bar);
            __builtin_amdgcn_fence(__ATOMIC_ACQUIRE, "agent");
            xb_add(&bar[XB_XGEN(b.x)], 1u);
            asm volatile("s_waitcnt vmcnt(0)" ::: "memory");
        } else {
            XB_SPIN(xb_ld(&bar[XB_XGEN(b.x)]) == gen, bar);
            __builtin_amdgcn_fence(__ATOMIC_ACQUIRE, "agent");
            asm volatile("s_waitcnt vmcnt(0)" ::: "memory");
        }
    }
    __syncthreads();
}

__device__ __forceinline__ int fill_rtab(const pg8::StaticOrder& so, const float* ss, LAS float* rtab) {
    pg8::Unit u0; int pm0 = -1;
    if (so.next(0, u0)) { pm0 = u0.pm; if (threadIdx.x < 256) rtab[threadIdx.x] = pg8::row_rstd(ss, pm0 * 256 + (int)threadIdx.x); }
    __syncthreads();
    return pm0;
}
__global__ void __launch_bounds__(512, 2) fwd_megakernel(Params p) {
    extern __shared__ __attribute__((aligned(16))) unsigned char lds[];
    cg::grid_group grid = cg::this_grid();
    LAS unsigned char* ldsl = (LAS unsigned char*)lds;
    const int G = gridDim.x;
    unsigned char* ws = p.ws;
    bf16* XB = (bf16*)(ws + WS_XB); bf16* HB = (bf16*)(ws + WS_HB); bf16* MIX = (bf16*)(ws + WS_MIX);
    float* SS0 = (float*)(ws + WS_SS0); float* SS1 = (float*)(ws + WS_SS1); float* SS2 = (float*)(ws + WS_SS2); float* SS3 = (float*)(ws + WS_SS3);

    unsigned* barw = (unsigned*)(ws + WS_BAR);
    LAS float* rtab = (LAS float*)(ldsl + LDS_RTAB);
    volatile LAS unsigned* bst = (volatile LAS unsigned*)(ldsl + 131072);
    if (threadIdx.x < 2) bst[threadIdx.x] = 0u;
    if (p.ws == nullptr) grid.sync();
    {
        unsigned* flag = barw + 16384 - 64;
        constexpr unsigned MAGIC = 0x600DF1A6u;
        if (blockIdx.x == 0) {
            for (int i = threadIdx.x; i < 16384 - 64; i += 512) barw[i] = 0u;
            __threadfence(); __syncthreads();
            if (threadIdx.x == 0) { asm volatile("s_waitcnt vmcnt(0)" ::: "memory"); __hip_atomic_store(flag, MAGIC, __ATOMIC_RELEASE, __HIP_MEMORY_SCOPE_AGENT); }
        } else if (threadIdx.x == 0) {
            unsigned sp = 0; while (__hip_atomic_load(flag, __ATOMIC_RELAXED, __HIP_MEMORY_SCOPE_AGENT) != MAGIC) { __builtin_amdgcn_s_sleep(1); if (++sp > (1u << 22)) break; }
            __builtin_amdgcn_fence(__ATOMIC_ACQUIRE, "agent");
        }
        __syncthreads();
    }
    const XcdBarrier xb = xcd_barrier_post(barw, bst);
#define GSYNC() xcd_barrier(xb)
    p0_prologue(p, ldsl, G);
    GSYNC();
    if (blockIdx.x == 0 && threadIdx.x == 0) __hip_atomic_store(barw + 16384 - 64, 0u, __ATOMIC_RELAXED, __HIP_MEMORY_SCOPE_AGENT);
    { pg8::Gemm g{XB, (const bf16*)(ws + WS_WGU1), S, 2 * DFF, DM}; pg8::StaticOrder so; so.init(S, 2 * DFF, G, (int)blockIdx.x);
      const int pm0 = fill_rtab(so, SS0, rtab); pg8::EpiSwiGLU E{HB, DFF, SS0, rtab, pm0}; pg8::gemm_phase<pg8::EpiSwiGLU, pg8::StaticOrder, true, true>(ldsl, g, so, E); }
    { int sgw, sng; if (slack_rank((S / 256) * (2 * DFF / 256), G, sgw, sng)) { LAS float* scr = (LAS float*)(ldsl + (threadIdx.x >> 6) * 8448); const int lane = threadIdx.x & 63;
        slack1_items(p, scr, lane, sgw, sng); } }
    GSYNC();
    { pg8::Gemm g{HB, (const bf16*)(ws + WS_WD1), S, DM, DFF}; pg8::StaticOrder so; so.init(S, DM, G, (int)blockIdx.x);
      pg8::EpiResid<true> E{nullptr, XB, SS1, 0.5f}; pg8::gemm_phase<pg8::EpiResid<true>, pg8::StaticOrder, true, true>(ldsl, g, so, E); }
    GSYNC();
    { pg8::Gemm g{XB, (const bf16*)(ws + WS_WIN), S, NPROJ, DM}; pg8::StaticOrder so; so.init(S, NPROJ, G, (int)blockIdx.x);
      const int pm0 = fill_rtab(so, SS1, rtab); pg8::EpiProj E{HB, NPROJ, SS1, (float*)(ws + WS_GATES), p.bg, 10, rtab, pm0}; pg8::gemm_phase<pg8::EpiProj, pg8::StaticOrder, true, true>(ldsl, g, so, E); }
    { int sgw, sng; if (slack_rank((S / 256) * (NPROJ / 256), G, sgw, sng)) { LAS float* scr = (LAS float*)(ldsl + (threadIdx.x >> 6) * 8448); cvt_gu(p, 1, scr, threadIdx.x & 63, sgw, sng); } }
    GSYNC();
    m1_phase(p, lds, G);
    GSYNC();
    m2_phase(p, lds, G);
    GSYNC();
    m3_phase(p, lds, G);
    GSYNC();
    { pg8::Gemm g{MIX, (const bf16*)(ws + WS_WOUT), S, DM, DM}; pg8::StaticOrder so; so.init(S, DM, G, (int)blockIdx.x);
      pg8::EpiResid<true> E{nullptr, XB, SS2, 1.0f}; pg8::gemm_phase<pg8::EpiResid<true>, pg8::StaticOrder, true, true>(ldsl, g, so, E); }
    GSYNC();
    { pg8::Gemm g{XB, (const bf16*)(ws + WS_WGU2), S, 2 * DFF, DM}; pg8::StaticOrder so; so.init(S, 2 * DFF, G, (int)blockIdx.x);
      const int pm0 = fill_rtab(so, SS2, rtab); pg8::EpiSwiGLU E{HB, DFF, SS2, rtab, pm0}; pg8::gemm_phase<pg8::EpiSwiGLU, pg8::StaticOrder, true, true>(ldsl, g, so, E); }
    { int sgw, sng; if (slack_rank((S / 256) * (2 * DFF / 256), G, sgw, sng)) cvt_down(p, 1, (LAS float*)(ldsl + (threadIdx.x >> 6) * 8448), threadIdx.x & 63, sgw, sng); }
    GSYNC();
    { pg8::Gemm g{HB, (const bf16*)(ws + WS_WD2), S, DM, DFF}; pg8::StaticOrder so; so.init(S, DM, G, (int)blockIdx.x);
      pg8::EpiFinal E{XB, p.out, SS3, (unsigned*)(ws + WS_PCNT), p.nf, 0.5f}; pg8::gemm_phase<pg8::EpiFinal, pg8::StaticOrder, true, true>(ldsl, g, so, E); }
}

extern "C" void kernel_launch(void* const* d_in, const int* in_sizes, int n_in, void* d_out, int out_size, void* d_ws, size_t ws_size, hipStream_t stream) {
    static int grid_blocks = 0;
    if (grid_blocks == 0) {
        if (n_in != 19 || out_size != S * DM || ws_size < WS_END) { fprintf(stderr, "kernel_launch: unexpected problem (n_in %d, out %d, ws %zu)\n", n_in, out_size, ws_size); grid_blocks = -1; return; }
        int dev = 0, cus = 0, per_cu = 0;
        (void)hipGetDevice(&dev);
        (void)hipDeviceGetAttribute(&cus, hipDeviceAttributeMultiprocessorCount, dev);
        if (hipFuncSetAttribute((const void*)fwd_megakernel, hipFuncAttributeMaxDynamicSharedMemorySize, LDS_BYTES) != hipSuccess) { fprintf(stderr, "kernel_launch: hipFuncSetAttribute failed\n"); grid_blocks = -1; return; }
        if (hipOccupancyMaxActiveBlocksPerMultiprocessor(&per_cu, (const void*)fwd_megakernel, 512, LDS_BYTES) != hipSuccess || per_cu < 1) { fprintf(stderr, "kernel_launch: occupancy query gave %d\n", per_cu); per_cu = 1; }
        (void)hipGetLastError();
        grid_blocks = cus * 1;
        if (grid_blocks <= 0) grid_blocks = 256;
    }
    if (grid_blocks < 0) return;
    Params p{};
    p.x = (const float*)d_in[0]; p.n1 = (const float*)d_in[1]; p.wg1 = (const float*)d_in[2]; p.wu1 = (const float*)d_in[3]; p.wd1 = (const float*)d_in[4];
    p.nmix = (const float*)d_in[5]; p.win = (const float*)d_in[6]; p.bg = (const float*)d_in[7]; p.convw = (const float*)d_in[8]; p.convb = (const float*)d_in[9]; p.mhn = (const float*)d_in[10];
    p.poolw = (const float*)d_in[11]; p.pools = (const float*)d_in[12]; p.wout = (const float*)d_in[13]; p.n2 = (const float*)d_in[14]; p.wg2 = (const float*)d_in[15]; p.wu2 = (const float*)d_in[16]; p.wd2 = (const float*)d_in[17]; p.nf = (const float*)d_in[18];
    p.out = (float*)d_out; p.ws = (unsigned char*)d_ws;
    void* args[] = {&p};
    hipError_t e = hipLaunchCooperativeKernel((const void*)fwd_megakernel, dim3(grid_blocks), dim3(512), args, LDS_BYTES, stream);
    if (e != hipSuccess) fprintf(stderr, "cooperative launch failed: %s (grid %d)\n", hipGetErrorString(e), grid_blocks);
}
```

```cpp
#include <hip/hip_runtime.h>
#include <hip/hip_cooperative_groups.h>
#include <cstdio>
#include <cstdint>
namespace cg = cooperative_groups;

#define LAS __attribute__((address_space(3)))
typedef unsigned short bf16;
typedef short bf16x8 __attribute__((ext_vector_type(8)));
typedef float f32x4 __attribute__((ext_vector_type(4)));
typedef unsigned u32x4 __attribute__((ext_vector_type(4)));
typedef unsigned u32x2 __attribute__((ext_vector_type(2)));

constexpr int S = 16384, DM = 1024, DFF = 2816, NPROJ = 2816  , DINP = 2568;
constexpr int NCH = 256, CL = 64, NH = 4, HD = 128;
constexpr float EPS = 1e-6f;

constexpr size_t MiB = 1u << 20;
constexpr size_t WS_SS0 = 0 * MiB, WS_SS1 = 1 * MiB, WS_SS2 = 2 * MiB, WS_SS3 = 3 * MiB;
constexpr size_t WS_GATES = 4 * MiB;
constexpr size_t WS_DN = 4 * MiB + 512 * 1024;
constexpr size_t WS_BAR = 5 * MiB + 512 * 1024;
constexpr size_t WS_PCNT = WS_BAR + 16384;
constexpr size_t WS_SC = 5 * MiB;
constexpr size_t WS_WGU1 = 6 * MiB;
constexpr size_t WS_WD1 = 17 * MiB;
constexpr size_t WS_WGU2 = 23 * MiB;
constexpr size_t WS_WD2 = 34 * MiB;
constexpr size_t WS_WIN = 40 * MiB;
constexpr size_t WS_WOUT = 46 * MiB;
constexpr size_t WS_HB = 48 * MiB;
constexpr size_t WS_MIX = 136 * MiB;
constexpr size_t WS_XB = 168 * MiB;
constexpr size_t WS_END = 200 * MiB;

constexpr int LDS_RTAB = 131072 + 256;
constexpr int LDS_BYTES = 131072 + 256 + 1024;

namespace pg8 {
#define PG8_LAS __attribute__((address_space(3)))
typedef unsigned short bf16_t;
constexpr int BM = 256, BK = 64, HALF = 128, HTB = HALF * BK * 2, STAGE_BYTES = 8 * HTB, NXCD = 8, WGM = 8;

__host__ __device__ __forceinline__ int lds_byte(int r, int c) { const int st = (r >> 4) * 2 + (c >> 5), rr = r & 15, cc = c & 31, ob = rr * 64 + cc * 2; return st * 1024 + (ob ^ (((ob >> 9) & 1) << 5)); }
__host__ __device__ __forceinline__ void stage_rc(int b, int& R, int& C) { const int st = b / 1024, sb = b % 1024, swz = sb ^ (((sb >> 9) & 1) << 5); R = (st >> 1) * 16 + swz / 64; C = (st & 1) * 32 + (swz % 64) / 2; }
__host__ __device__ __forceinline__ int perm32(int rho) { const int n = rho >> 4, i = rho & 15; return 8 * (i >> 2) + 4 * n + (i & 3); }

struct Unit { int pm, pn; };
struct Gemm { const bf16_t* A; const bf16_t* Bt; int M, N, K; };

struct StaticOrder {
    int nM, nN, nwg, G, c;
    __host__ __device__ void init(int M, int N, int G_, int c_) { nM = M / BM; nN = N / BM; nwg = nM * nN; G = G_; c = c_; }
    __host__ __device__ bool next(int i, Unit& u) const {
        const long L = (long)i * G + c; if (L >= nwg) return false;
        int wgid = (int)L; { const int q = nwg / NXCD, r = nwg % NXCD, xcd = wgid % NXCD, off = wgid / NXCD; wgid = (xcd < r ? xcd * (q + 1) : r * (q + 1) + (xcd - r) * q) + off; }
        const int nig = WGM * nN, gid = wgid / nig, fm = gid * WGM, gsz = (nM - fm) < WGM ? (nM - fm) : WGM;
        u.pm = fm + ((wgid % nig) % gsz); u.pn = (wgid % nig) / gsz; return true;
    }
    __device__ __forceinline__ void a_ready(const Unit&) const {}
    __device__ __forceinline__ void done(const Unit&) const {}
};

__device__ __forceinline__ unsigned cvt_pk_bf16(float lo, float hi) { unsigned r; asm volatile("v_cvt_pk_bf16_f32 %0, %1, %2" : "=v"(r) : "v"(lo), "v"(hi)); return r; }

__device__ __forceinline__ float row_rstd(const float* ss, int row) {
    const f32x4* p = (const f32x4*)(ss + (size_t)row * 16);
    const f32x4 a = p[0], b = p[1], c = p[2], d = p[3];
    const float s = (((a[0] + a[1]) + (a[2] + a[3])) + ((b[0] + b[1]) + (b[2] + b[3]))) + (((c[0] + c[1]) + (c[2] + c[3])) + ((d[0] + d[1]) + (d[2] + d[3])));
    return 1.0f / sqrtf(s * (1.0f / 1024.0f) + 1e-6f);
}
__device__ __forceinline__ float silu_f(float g) { return g * __builtin_amdgcn_rcpf(1.0f + __expf(-g)); }
typedef float f32x2 __attribute__((ext_vector_type(2)));
__device__ __forceinline__ f32x2 swiglu_pk(f32x2 g, f32x2 u, float c, float r2) {
    const f32x2 t = g * c;
    f32x2 e; e.x = __builtin_amdgcn_exp2f(t.x); e.y = __builtin_amdgcn_exp2f(t.y);
    const f32x2 d = e + 1.0f;
    f32x2 s; s.x = __builtin_amdgcn_rcpf(d.x); s.y = __builtin_amdgcn_rcpf(d.y);
    return (g * u) * (s * r2);
}

struct EpiSwiGLU {
    static constexpr bool PERM = true, AFTER_DRAIN = false;
    bf16_t* H; int ldh; const float* ss; const PG8_LAS float* rtab; int rt_pm;
    __device__ __forceinline__ void operator()(const f32x4 (&acc)[2][2][4][2], const Unit& u, int wr, int wc, int fr, int fq) const {
        const int row0 = u.pm * BM + wr * 64 + fr, col0 = u.pn * HALF + wc * 32 + 8 * fq; const bool tab = (u.pm == rt_pm);
#pragma unroll
        for (int ai = 0; ai < 2; ++ai)
#pragma unroll
            for (int m = 0; m < 4; ++m) {
                const int row = row0 + ai * HALF + m * 16; const float r = tab ? rtab[row - u.pm * BM] : row_rstd(ss, row);
                const float c = r * -1.4426950408889634f, r2 = r * r;
                const f32x4 G0 = acc[ai][0][m][0], G1 = acc[ai][0][m][1], U0 = acc[ai][1][m][0], U1 = acc[ai][1][m][1];
                const f32x2 h0 = swiglu_pk((f32x2){G0[0], G0[1]}, (f32x2){U0[0], U0[1]}, c, r2), h1 = swiglu_pk((f32x2){G0[2], G0[3]}, (f32x2){U0[2], U0[3]}, c, r2);
                const f32x2 h2 = swiglu_pk((f32x2){G1[0], G1[1]}, (f32x2){U1[0], U1[1]}, c, r2), h3 = swiglu_pk((f32x2){G1[2], G1[3]}, (f32x2){U1[2], U1[3]}, c, r2);
                u32x4 w;
                w.x = cvt_pk_bf16(h0.x, h0.y); w.y = cvt_pk_bf16(h1.x, h1.y); w.z = cvt_pk_bf16(h2.x, h2.y); w.w = cvt_pk_bf16(h3.x, h3.y);
                *(u32x4*)(H + (size_t)row * ldh + col0) = w;
            }
    }
};
struct EpiProj {
    static constexpr bool PERM = true, AFTER_DRAIN = false;
    bf16_t* P; int ldp; const float* ss; float* gates; const float* bg; int gate_tile; const PG8_LAS float* rtab; int rt_pm;
    __device__ __forceinline__ void operator()(const f32x4 (&acc)[2][2][4][2], const Unit& u, int wr, int wc, int fr, int fq) const {
        const int row0 = u.pm * BM + wr * 64 + fr, col0 = u.pn * BM + wc * 32 + 8 * fq; const bool tab = (u.pm == rt_pm);
        if (u.pn < gate_tile) {
#pragma unroll
            for (int ai = 0; ai < 2; ++ai)
#pragma unroll
                for (int m = 0; m < 4; ++m) {
                    const int row = row0 + ai * HALF + m * 16; const float r = tab ? rtab[row - u.pm * BM] : row_rstd(ss, row);
#pragma unroll
                    for (int bj = 0; bj < 2; ++bj) {
                        const f32x4 v0 = acc[ai][bj][m][0] * r, v1 = acc[ai][bj][m][1] * r;
                        u32x4 w; w.x = cvt_pk_bf16(v0[0], v0[1]); w.y = cvt_pk_bf16(v0[2], v0[3]); w.z = cvt_pk_bf16(v1[0], v1[1]); w.w = cvt_pk_bf16(v1[2], v1[3]);
                        *(u32x4*)(P + (size_t)row * ldp + col0 + bj * HALF) = w;
                    }
                }
        } else if (wc == 0 && fq == 0) {
            const f32x4 b0 = *(const f32x4*)bg, b1 = *(const f32x4*)(bg + 4);
#pragma unroll
            for (int ai = 0; ai < 2; ++ai)
#pragma unroll
                for (int m = 0; m < 4; ++m) {
                    const int row = row0 + ai * HALF + m * 16; const float r = tab ? rtab[row - u.pm * BM] : row_rstd(ss, row);
                    *(f32x4*)(gates + (size_t)row * 8) = acc[ai][0][m][0] * r + b0;
                    *(f32x4*)(gates + (size_t)row * 8 + 4) = acc[ai][0][m][1] * r + b1;
                }
        }
    }
};
__device__ __forceinline__ void bf8_to_f32(const u32x4 v, f32x4& lo, f32x4& hi) {
    lo = (f32x4){__uint_as_float(v.x << 16), __uint_as_float(v.x & 0xffff0000u), __uint_as_float(v.y << 16), __uint_as_float(v.y & 0xffff0000u)};
    hi = (f32x4){__uint_as_float(v.z << 16), __uint_as_float(v.z & 0xffff0000u), __uint_as_float(v.w << 16), __uint_as_float(v.w & 0xffff0000u)};
}
template <bool XI_BF16> struct EpiResid {
    static constexpr bool PERM = true, AFTER_DRAIN = false;
    const float* xi; bf16_t* xb; float* ssout; float scale;
    __device__ __forceinline__ void operator()(const f32x4 (&acc)[2][2][4][2], const Unit& u, int wr, int wc, int fr, int fq) const {
        const int row0 = u.pm * BM + wr * 64 + fr, col0 = u.pn * BM + wc * 32 + 8 * fq;
#pragma unroll
        for (int ai = 0; ai < 2; ++ai) {
        u32x4 xin[1][4][2];
        if (XI_BF16) {
#pragma unroll
                for (int m = 0; m < 4; ++m)
#pragma unroll
                    for (int bj = 0; bj < 2; ++bj) xin[0][m][bj] = *(const u32x4*)(xb + (size_t)(row0 + ai * HALF + m * 16) * DM + col0 + bj * HALF);
        }
#pragma unroll
            for (int m = 0; m < 4; ++m) {
                const int row = row0 + ai * HALF + m * 16; const size_t off = (size_t)row * DM + col0; float q = 0.f;
#pragma unroll
                for (int bj = 0; bj < 2; ++bj) {
                    const size_t o2 = off + bj * HALF; f32x4 b0, b1;
                    if (XI_BF16) bf8_to_f32(xin[0][m][bj], b0, b1); else { b0 = *(const f32x4*)(xi + o2); b1 = *(const f32x4*)(xi + o2 + 4); }
                    const f32x4 o0 = b0 + acc[ai][bj][m][0] * scale, o1 = b1 + acc[ai][bj][m][1] * scale;
                    u32x4 w; w.x = cvt_pk_bf16(o0[0], o0[1]); w.y = cvt_pk_bf16(o0[2], o0[3]); w.z = cvt_pk_bf16(o1[0], o1[1]); w.w = cvt_pk_bf16(o1[2], o1[3]);
                    *(u32x4*)(xb + o2) = w;
                    q += ((o0[0] * o0[0] + o0[1] * o0[1]) + (o0[2] * o0[2] + o0[3] * o0[3])) + ((o1[0] * o1[0] + o1[1] * o1[1]) + (o1[2] * o1[2] + o1[3] * o1[3]));
                }
                q += __shfl_xor(q, 16); q += __shfl_xor(q, 32);
                if (fq == 0) ssout[(size_t)row * 16 + u.pn * 4 + wc] = q;
                if (!XI_BF16) asm volatile("" ::: "memory");
            }
            asm volatile("" ::: "memory");
        }
    }
};
struct EpiFinal {
    static constexpr bool PERM = true, AFTER_DRAIN = false;
    const bf16_t* xb; float* out; float* ss; unsigned* cnt; const float* gf; float scale;
    __device__ __forceinline__ void operator()(f32x4 (&acc)[2][2][4][2], const Unit& u, int wr, int wc, int fr, int fq) const {
        const int row0 = u.pm * BM + wr * 64 + fr, col0 = u.pn * BM + wc * 32 + 8 * fq;
#pragma unroll
        for (int ai = 0; ai < 2; ++ai) {
        u32x4 xin[4][2];
#pragma unroll
            for (int m = 0; m < 4; ++m)
#pragma unroll
                for (int bj = 0; bj < 2; ++bj) xin[m][bj] = *(const u32x4*)(xb + (size_t)(row0 + ai * HALF + m * 16) * DM + col0 + bj * HALF);
#pragma unroll
            for (int m = 0; m < 4; ++m) {
                const int row = row0 + ai * HALF + m * 16; float q = 0.f;
#pragma unroll
                for (int bj = 0; bj < 2; ++bj) {
                    f32x4 b0, b1; bf8_to_f32(xin[m][bj], b0, b1);
                    const f32x4 o0 = b0 + acc[ai][bj][m][0] * scale, o1 = b1 + acc[ai][bj][m][1] * scale;
                    acc[ai][bj][m][0] = o0; acc[ai][bj][m][1] = o1;
                    q += ((o0[0] * o0[0] + o0[1] * o0[1]) + (o0[2] * o0[2] + o0[3] * o0[3])) + ((o1[0] * o1[0] + o1[1] * o1[1]) + (o1[2] * o1[2] + o1[3] * o1[3]));
                }
                q += __shfl_xor(q, 16); q += __shfl_xor(q, 32);
                if (fq == 0) __hip_atomic_store((unsigned*)(ss + (size_t)row * 16 + u.pn * 4 + wc), __float_as_uint(q), __ATOMIC_RELAXED, __HIP_MEMORY_SCOPE_AGENT);
            }
            asm volatile("" ::: "memory");
        }
        asm volatile("s_waitcnt vmcnt(0)" ::: "memory");
        unsigned* pc = cnt + 64 * u.pm;
        if ((threadIdx.x & 63) == 0) __hip_atomic_fetch_add(pc, 1u, __ATOMIC_RELAXED, __HIP_MEMORY_SCOPE_AGENT);
        { unsigned sp = 0; while ((unsigned)__builtin_amdgcn_readfirstlane(__hip_atomic_load(pc, __ATOMIC_RELAXED, __HIP_MEMORY_SCOPE_AGENT)) < 32u) { __builtin_amdgcn_s_sleep(2); if (++sp > (1u << 20)) break; } }
        __builtin_amdgcn_fence(__ATOMIC_ACQUIRE, "agent");
        f32x4 gv[2][2];
#pragma unroll
        for (int bj = 0; bj < 2; ++bj) { gv[bj][0] = *(const f32x4*)(gf + col0 + bj * HALF); gv[bj][1] = *(const f32x4*)(gf + col0 + bj * HALF + 4); }
        f32x4 ptv[2][4];
#pragma unroll
        for (int ai = 0; ai < 2; ++ai)
#pragma unroll
            for (int m = 0; m < 4; ++m) ptv[ai][m] = *(const f32x4*)(ss + (size_t)(row0 + ai * HALF + m * 16) * 16 + fq * 4);
#pragma unroll
        for (int ai = 0; ai < 2; ++ai)
#pragma unroll
            for (int m = 0; m < 4; ++m) {
                const int row = row0 + ai * HALF + m * 16; const size_t off = (size_t)row * DM + col0;
                const f32x4 pt = ptv[ai][m];
                float s = (pt[0] + pt[1]) + (pt[2] + pt[3]); s += __shfl_xor(s, 16); s += __shfl_xor(s, 32);
                const float r = 1.0f / sqrtf(s * (1.0f / 1024.0f) + 1e-6f);
#pragma unroll
                for (int bj = 0; bj < 2; ++bj) { *(f32x4*)(out + off + bj * HALF) = acc[ai][bj][m][0] * r * gv[bj][0]; *(f32x4*)(out + off + bj * HALF + 4) = acc[ai][bj][m][1] * r * gv[bj][1]; }
            }
    }
};

template <class Epi, class Sched, bool ALIGN_EPI = false, bool SP2 = false>
__device__ __forceinline__ void gemm_phase(PG8_LAS unsigned char* lds, const Gemm g, const Sched& S, const Epi& E) {
    const int tid = threadIdx.x, wid = __builtin_amdgcn_readfirstlane(tid >> 6), lane = tid & 63, wr = wid >> 2, wc = wid & 3, fr = lane & 15, fq = lane >> 4;
    const int K = g.K, nt = K / BK;
    unsigned voffA[2], voffB[2];
#pragma unroll
    for (int i = 0; i < 2; ++i) { int R, C; stage_rc(tid * 16 + i * 8192, R, C); const int Rb = Epi::PERM ? ((R & ~31) + perm32(R & 31)) : R;
        voffA[i] = (unsigned)(R * K + C) * 2u; voffB[i] = (unsigned)(Rb * K + C) * 2u; }
    const size_t kstep = (size_t)(BK * 2);
    const size_t hstep = (size_t)HALF * K * 2;
    const size_t tstep = 2 * hstep;
    const unsigned ldsw = (unsigned)wid * 1024u;
    const int aoff = lds_byte(wr * 64 + fr, fq * 8), boff = lds_byte(wc * 32 + fr, fq * 8);
#define PG8_SA(b, h) (((b) * 2 + (h)) * HTB)
#define PG8_SB(b, h) ((4 + (b) * 2 + (h)) * HTB)
#define PG8_STAGE(bufoff, gbase, voff) do { _Pragma("unroll") for (int _i = 0; _i < 2; ++_i) \
        __builtin_amdgcn_global_load_lds((const unsigned*)((const char*)(gbase) + (voff)[_i]), (PG8_LAS unsigned*)(lds + (bufoff) + ldsw + _i * 8192), 16, 0, 0); } while (0)
#define PG8_LDA(dst, b, h) do { _Pragma("unroll") for (int m = 0; m < 4; ++m) _Pragma("unroll") for (int k = 0; k < 2; ++k) dst[m][k] = *(const PG8_LAS bf16x8*)(lds + PG8_SA(b, h) + aoff + m * 2048 + k * 1024); } while (0)
#define PG8_LDB(dst, b, h) do { _Pragma("unroll") for (int n = 0; n < 2; ++n) _Pragma("unroll") for (int k = 0; k < 2; ++k) dst[n][k] = *(const PG8_LAS bf16x8*)(lds + PG8_SB(b, h) + boff + n * 2048 + k * 1024); } while (0)
#define PG8_MMA(ai, bj, At, Bt) do { __builtin_amdgcn_s_setprio(1); _Pragma("unroll") for (int m = 0; m < 4; ++m) _Pragma("unroll") for (int n = 0; n < 2; ++n) _Pragma("unroll") for (int k = 0; k < 2; ++k) \
        acc[ai][bj][m][n] = __builtin_amdgcn_mfma_f32_16x16x32_bf16(Bt[n][k], At[m][k], acc[ai][bj][m][n], 0, 0, 0); __builtin_amdgcn_s_setprio(0); } while (0)
#define PG8_WAIT_V(n) asm volatile("s_waitcnt vmcnt(" #n ")" ::: "memory")
#define PG8_WAIT_L(n) asm volatile("s_waitcnt lgkmcnt(" #n ")" ::: "memory")
#define PG8_BAR __builtin_amdgcn_s_barrier()
#define PG8_SCHED __builtin_amdgcn_sched_barrier(0)
    Unit cur, nxt; int ui = 0;
    if (!S.next(0, cur)) return;
    f32x4 acc[2][2][4][2];
#pragma unroll
    for (int a = 0; a < 2; ++a)
#pragma unroll
        for (int b = 0; b < 2; ++b)
#pragma unroll
            for (int m = 0; m < 4; ++m)
#pragma unroll
                for (int n = 0; n < 2; ++n) acc[a][b][m][n] = (f32x4){0.f, 0.f, 0.f, 0.f};
    bf16x8 At[4][2], B0[2][2], B1[2][2];
    const char* cA = (const char*)g.A + (size_t)cur.pm * tstep; const char* cB = (const char*)g.Bt + (size_t)cur.pn * tstep;
    S.a_ready(cur);
    if constexpr (SP2) {
        PG8_STAGE(PG8_SB(0, 0), cB, voffB); PG8_STAGE(PG8_SB(0, 1), cB + hstep, voffB); PG8_STAGE(PG8_SA(0, 0), cA, voffA); PG8_STAGE(PG8_SA(0, 1), cA + hstep, voffA);
        if (wr == 1) PG8_BAR;
        PG8_WAIT_V(2); PG8_BAR;
        PG8_STAGE(PG8_SB(1, 0), cB + kstep, voffB); PG8_STAGE(PG8_SA(1, 0), cA + kstep, voffA); PG8_STAGE(PG8_SB(1, 1), cB + hstep + kstep, voffB);
        PG8_WAIT_V(6); PG8_BAR;
    } else {
        PG8_STAGE(PG8_SB(0, 0), cB, voffB); PG8_STAGE(PG8_SA(0, 0), cA, voffA); PG8_STAGE(PG8_SB(0, 1), cB + hstep, voffB); PG8_STAGE(PG8_SA(0, 1), cA + hstep, voffA);
        if (wr == 1) PG8_BAR;
        PG8_WAIT_V(4); PG8_BAR;
        PG8_STAGE(PG8_SB(1, 0), cB + kstep, voffB); PG8_STAGE(PG8_SA(1, 0), cA + kstep, voffA); PG8_STAGE(PG8_SB(1, 1), cB + hstep + kstep, voffB);
        PG8_WAIT_V(6); PG8_BAR;
    }
    for (;;) {
        const bool has_next = S.next(ui + 1, nxt);
        const char* nA = has_next ? (const char*)g.A + (size_t)nxt.pm * tstep : cA; const char* nB = has_next ? (const char*)g.Bt + (size_t)nxt.pn * tstep : cB;
        for (int t = 0; t < nt; t += 2) {
            const bool last = (t == nt - 2);
            const char* a1 = cA + (size_t)(t + 1) * kstep;
            const char* a2 = last ? nA : cA + (size_t)(t + 2) * kstep; const char* b2 = last ? nB : cB + (size_t)(t + 2) * kstep;
            const char* a3 = a2 + kstep; const char* b3 = b2 + kstep;
            if (last && has_next) S.a_ready(nxt);
            if constexpr (SP2) {
            PG8_LDB(B0, 0, 0); PG8_LDB(B1, 0, 1); PG8_SCHED; PG8_LDA(At, 0, 0); PG8_STAGE(PG8_SA(1, 1), a1 + hstep, voffA);
            PG8_WAIT_V(8); PG8_WAIT_L(0); PG8_BAR; PG8_MMA(0, 0, At, B0); PG8_MMA(0, 1, At, B1); PG8_BAR; PG8_SCHED;
            PG8_LDA(At, 0, 1); PG8_STAGE(PG8_SB(0, 0), b2, voffB); PG8_STAGE(PG8_SB(0, 1), b2 + hstep, voffB); PG8_STAGE(PG8_SA(0, 0), a2, voffA);
            PG8_WAIT_V(8); PG8_WAIT_L(0); PG8_BAR; PG8_MMA(1, 0, At, B0); PG8_MMA(1, 1, At, B1); PG8_BAR; PG8_SCHED;
            PG8_LDB(B0, 1, 0); PG8_LDB(B1, 1, 1); PG8_SCHED; PG8_LDA(At, 1, 0); PG8_STAGE(PG8_SA(0, 1), a2 + hstep, voffA);
            PG8_WAIT_V(8); PG8_WAIT_L(0); PG8_BAR; PG8_MMA(0, 0, At, B0); PG8_MMA(0, 1, At, B1); PG8_BAR; PG8_SCHED;
            PG8_LDA(At, 1, 1); PG8_STAGE(PG8_SB(1, 0), b3, voffB); PG8_STAGE(PG8_SB(1, 1), b3 + hstep, voffB); PG8_STAGE(PG8_SA(1, 0), a3, voffA);
            PG8_WAIT_V(8); PG8_WAIT_L(0); PG8_BAR; PG8_MMA(1, 0, At, B0); PG8_MMA(1, 1, At, B1); PG8_BAR; PG8_SCHED;
            } else {
            PG8_LDB(B0, 0, 0); PG8_SCHED; PG8_LDA(At, 0, 0); PG8_STAGE(PG8_SA(1, 1), a1 + hstep, voffA);
            PG8_WAIT_L(8); PG8_BAR; PG8_WAIT_L(0); PG8_MMA(0, 0, At, B0); PG8_BAR; PG8_SCHED;
            PG8_LDB(B1, 0, 1); PG8_STAGE(PG8_SB(0, 0), b2, voffB);
            PG8_BAR; PG8_WAIT_L(0); PG8_MMA(0, 1, At, B1); PG8_BAR;
            PG8_LDA(At, 0, 1); PG8_STAGE(PG8_SA(0, 0), a2, voffA);
            PG8_BAR; PG8_WAIT_L(0); PG8_MMA(1, 0, At, B0); PG8_BAR; PG8_SCHED;
            PG8_STAGE(PG8_SB(0, 1), b2 + hstep, voffB);
            PG8_WAIT_V(6); PG8_BAR; PG8_MMA(1, 1, At, B1); PG8_BAR;
            PG8_LDB(B0, 1, 0); PG8_SCHED; PG8_LDA(At, 1, 0); PG8_STAGE(PG8_SA(0, 1), a2 + hstep, voffA);
            PG8_WAIT_L(8); PG8_BAR; PG8_WAIT_L(0); PG8_MMA(0, 0, At, B0); PG8_BAR; PG8_SCHED;
            PG8_LDB(B1, 1, 1); PG8_STAGE(PG8_SB(1, 0), b3, voffB);
            PG8_BAR; PG8_WAIT_L(0); PG8_MMA(0, 1, At, B1); PG8_BAR;
            PG8_LDA(At, 1, 1); PG8_STAGE(PG8_SA(1, 0), a3, voffA);
            PG8_BAR; PG8_WAIT_L(0); PG8_MMA(1, 0, At, B0); PG8_BAR; PG8_SCHED;
            PG8_STAGE(PG8_SB(1, 1), b3 + hstep, voffB);
            PG8_WAIT_V(6); PG8_BAR; PG8_MMA(1, 1, At, B1); PG8_BAR;
            }
        }
        if constexpr (ALIGN_EPI) { if (wr == 0) PG8_BAR; }
        if constexpr (!Epi::AFTER_DRAIN) { E(acc, cur, wr, wc, fr, fq); S.done(cur); }
        if (!has_next) break;
#pragma unroll
        for (int a = 0; a < 2; ++a)
#pragma unroll
            for (int b = 0; b < 2; ++b)
#pragma unroll
                for (int m = 0; m < 4; ++m)
#pragma unroll
                    for (int n = 0; n < 2; ++n) acc[a][b][m][n] = (f32x4){0.f, 0.f, 0.f, 0.f};
        cur = nxt; cA = nA; cB = nB; ++ui;
        if constexpr (ALIGN_EPI) { if (wr == 1) PG8_BAR; }
    }
    PG8_WAIT_V(0);
    if constexpr (!ALIGN_EPI) { if (wr == 0) PG8_BAR; }
    PG8_BAR;
#undef PG8_SA
#undef PG8_SB
#undef PG8_STAGE
#undef PG8_LDA
#undef PG8_LDB
#undef PG8_MMA
#undef PG8_WAIT_V
#undef PG8_WAIT_L
#undef PG8_BAR
#undef PG8_SCHED
}
}

#define LDS_WAIT() asm volatile("s_waitcnt lgkmcnt(0)" ::: "memory")
__device__ __forceinline__ unsigned f2bf(float f) { unsigned u = __builtin_bit_cast(unsigned, f); return (u + 0x7fffu + ((u >> 16) & 1u)) >> 16; }
__device__ __forceinline__ unsigned pk2(float lo, float hi) { return f2bf(lo) | (f2bf(hi) << 16); }
__device__ __forceinline__ float bf2f(unsigned b) { return __uint_as_float(b << 16); }
__device__ __forceinline__ float wave_sum(float v) {
#pragma unroll
    for (int o = 1; o < 64; o <<= 1) v += __shfl_xor(v, o);
    return v;
}
__device__ __forceinline__ float wave_max(float v) {
#pragma unroll
    for (int o = 1; o < 64; o <<= 1) v = fmaxf(v, __shfl_xor(v, o));
    return v;
}
__device__ __forceinline__ float wave_incl_sum(float v, int lane) {
#pragma unroll
    for (int o = 1; o < 64; o <<= 1) { const float t = __shfl_up(v, o); if (lane >= o) v += t; }
    return v;
}
__device__ __forceinline__ float wave_incl_max(float v, int lane) {
#pragma unroll
    for (int o = 1; o < 64; o <<= 1) { const float t = __shfl_up(v, o); if (lane >= o) v = fmaxf(v, t); }
    return v;
}
__device__ __forceinline__ float log_sigmoid_f(float x) { return fminf(x, 0.f) - log1pf(expf(-fabsf(x))); }

struct TItem { const float* W; int ldw, src_col0; bf16* WT; int K, dst_row0, k0; const float* gk; };
__device__ __forceinline__ void titem_load(const TItem& t, float (&wv)[32], f32x4 (&gv)[2], int lane) {
    const float* wp = t.W + (size_t)(t.k0 + (lane >> 5)) * t.ldw + t.src_col0 + (lane & 31);
#pragma unroll
    for (int i = 0; i < 32; ++i) wv[i] = __builtin_nontemporal_load(wp + (size_t)(2 * i) * t.ldw);
    if (t.gk) { gv[0] = *(const f32x4*)(t.gk + t.k0 + 8 * (lane & 7)); gv[1] = *(const f32x4*)(t.gk + t.k0 + 8 * (lane & 7) + 4); }
    else { gv[0] = (f32x4){1.f, 1.f, 1.f, 1.f}; gv[1] = gv[0]; }
}
__device__ __forceinline__ void titem_finish(const TItem& t, const float (&wv)[32], const f32x4 (&gv)[2], LAS float* scr, int lane) {
#pragma unroll
    for (int i = 0; i < 32; ++i) scr[(2 * i + (lane >> 5)) * 33 + (lane & 31)] = wv[i];
    LDS_WAIT(); asm volatile("" ::: "memory");
    const int c = lane & 7;
#pragma unroll
    for (int j = 0; j < 4; ++j) { const int n = (lane >> 3) + 8 * j; const LAS float* s = scr + (8 * c) * 33 + n;
        u32x4 o; o.x = pk2(s[0 * 33] * gv[0][0], s[1 * 33] * gv[0][1]); o.y = pk2(s[2 * 33] * gv[0][2], s[3 * 33] * gv[0][3]);
        o.z = pk2(s[4 * 33] * gv[1][0], s[5 * 33] * gv[1][1]); o.w = pk2(s[6 * 33] * gv[1][2], s[7 * 33] * gv[1][3]);
        *(u32x4*)(t.WT + (size_t)(t.dst_row0 + n) * t.K + t.k0 + 8 * c) = o; }
    LDS_WAIT(); asm volatile("" ::: "memory");
}
__device__ __forceinline__ void p0_item(const float* W, int ldw, int src_col0, bf16* WT, int K, int dst_row0, int k0, const float* gk, LAS float* scr, int lane) {
    const TItem t{W, ldw, src_col0, WT, K, dst_row0, k0, gk}; float wv[32]; f32x4 gv[2];
    titem_load(t, wv, gv, lane); titem_finish(t, wv, gv, scr, lane);
}
__device__ __forceinline__ void titem_triple(const TItem& a, const TItem& b, const TItem& c, LAS float* scr, int lane) {
    float wa[32], wb[32], wc[32]; f32x4 ga[2], gb[2], gc[2];
    titem_load(a, wa, ga, lane); titem_load(b, wb, gb, lane); titem_load(c, wc, gc, lane);
    titem_finish(a, wa, ga, scr, lane); titem_finish(b, wb, gb, scr, lane); titem_finish(c, wc, gc, scr, lane);
}
__device__ __forceinline__ void titem_pair(const TItem& a, const TItem& b, LAS float* scr, int lane) {
    float wa[32], wb[32]; f32x4 ga[2], gb[2];
    titem_load(a, wa, ga, lane); titem_load(b, wb, gb, lane);
    titem_finish(a, wa, ga, scr, lane); titem_finish(b, wb, gb, scr, lane);
}

struct Params {
    const float* x; const float* n1; const float* wg1; const float* wu1; const float* wd1;
    const float* nmix; const float* win; const float* bg; const float* convw; const float* convb; const float* mhn;
    const float* poolw; const float* pools; const float* wout; const float* n2; const float* wg2; const float* wu2; const float* wd2; const float* nf;
    float* out; unsigned char* ws;
};

__device__ __forceinline__ void cvt_gu(const Params& p, int set, LAS float* scr, int lane, int gw, int NGW) {
    constexpr int I_GU = 16 * 88;
    bf16* WT = (bf16*)(p.ws + (set ? WS_WGU2 : WS_WGU1)); const float* gk = set ? p.n2 : p.n1;
    auto mk = [&](int it) { const int up = it / I_GU, r = it - up * I_GU, kb = r / 88, nb = r % 88, n0 = 32 * nb;
        const float* W = set ? (up ? p.wu2 : p.wg2) : (up ? p.wu1 : p.wg1);
        return TItem{W, DFF, n0, WT, DM, (n0 >> 7) * 256 + (n0 & 127) + up * 128, 64 * kb, gk}; };
    int it = gw;
    for (; it + NGW < 2 * I_GU; it += 2 * NGW) titem_pair(mk(it), mk(it + NGW), scr, lane);
    if (it < 2 * I_GU) { const TItem t = mk(it); p0_item(t.W, t.ldw, t.src_col0, t.WT, t.K, t.dst_row0, t.k0, t.gk, scr, lane); }
}
__device__ __forceinline__ void cvt_down(const Params& p, int set, LAS float* scr, int lane, int gw, int NGW) {
    auto mk = [&](int it) { const int kb = it / 32, nb = it % 32; return TItem{set ? p.wd2 : p.wd1, DM, 32 * nb, (bf16*)(p.ws + (set ? WS_WD2 : WS_WD1)), DFF, 32 * nb, 64 * kb, nullptr}; };
    int it = gw;
    for (; it + NGW < 44 * 32; it += 2 * NGW) titem_pair(mk(it), mk(it + NGW), scr, lane);
    if (it < 44 * 32) { const TItem t = mk(it); p0_item(t.W, t.ldw, t.src_col0, t.WT, t.K, t.dst_row0, t.k0, t.gk, scr, lane); }
}
__device__ __forceinline__ void cvt_in(const Params& p, LAS float* scr, int lane, int gw, int NGW) {
    bf16* WIN = (bf16*)(p.ws + WS_WIN);
    for (int it = gw; it < 16 * 64 + 16 * 16; it += NGW) {
        if (it < 16 * 64) { const int kb = it / 64, nb = it % 64; p0_item(p.win, DINP, 32 * nb, WIN, DM, 32 * nb, 64 * kb, p.nmix, scr, lane); }
        else { const int r = it - 16 * 64, kb = r / 16, nb = r % 16; p0_item(p.win, DINP, 2056 + 32 * nb, WIN, DM, 2048 + 32 * nb, 64 * kb, p.nmix, scr, lane); }
    }
    for (int wi = gw; wi < 512; wi += NGW) {
        const int idx = wi * 64 + lane, rr = idx >> 7, kc = (idx & 127) * 8;
        u32x4 o = (u32x4){0u, 0u, 0u, 0u};
        if (rr < 8) {
            float v[8];
#pragma unroll
            for (int e = 0; e < 8; ++e) v[e] = p.win[(size_t)(kc + e) * DINP + 2048 + rr] * p.nmix[kc + e];
            o.x = pk2(v[0], v[1]); o.y = pk2(v[2], v[3]); o.z = pk2(v[4], v[5]); o.w = pk2(v[6], v[7]);
        }
        *(u32x4*)(WIN + (size_t)(2560 + rr) * DM + kc) = o;
    }
}
__device__ __forceinline__ void cvt_out(const Params& p, LAS float* scr, int lane, int gw, int NGW) {
    bf16* WOUT = (bf16*)(p.ws + WS_WOUT);
    for (int it = gw; it < 8 * 32; it += NGW) { const int kb = it / 32, nb = it % 32; p0_item(p.wout, DM, 32 * nb, WOUT, DM, 32 * nb, 64 * kb, nullptr, scr, lane); }
    for (int wi = gw; wi < 1024; wi += NGW) {
        const int nblk = wi & 15, cgp = (wi >> 4) & 15, g = wi >> 8, n = nblk * 64 + lane, c0 = cgp * 8;
        float a[8];
#pragma unroll
        for (int e = 0; e < 8; ++e) a[e] = 0.f;
        const float* pw = p.poolw + (size_t)(g * 128 + c0) * 128; const float* ps = p.pools + g * 128; const float* wo = p.wout + (size_t)(512 + g * 128) * DM + n;
        for (int d0 = 0; d0 < 128; d0 += 32) {
            float wv[32];
#pragma unroll
            for (int dd = 0; dd < 32; ++dd) wv[dd] = wo[(size_t)(d0 + dd) * DM];
#pragma unroll
            for (int dd = 0; dd < 32; ++dd) { const float w = wv[dd] * ps[d0 + dd];
#pragma unroll
                for (int e = 0; e < 8; ++e) a[e] += pw[e * 128 + d0 + dd] * w; }
        }
        u32x4 o; o.x = pk2(a[0], a[1]); o.y = pk2(a[2], a[3]); o.z = pk2(a[4], a[5]); o.w = pk2(a[6], a[7]);
        *(u32x4*)(WOUT + (size_t)n * DM + 512 + g * 128 + c0) = o;
    }
}
__device__ __forceinline__ void slack1_items(const Params& p, LAS float* scr, int lane, int gw, int NGW) {
    constexpr int N_D = 44 * 32, N_IN = 16 * 64 + 16 * 16, N_O = 8 * 32, N_T = N_D + N_IN + N_O, N_F = 1024, N_G = 512;
    bf16* WIN = (bf16*)(p.ws + WS_WIN); bf16* WOUT = (bf16*)(p.ws + WS_WOUT);
    auto mkt = [&](int it) {
        if (it < N_D) { const int kb = it / 32, nb = it % 32; return TItem{p.wd1, DM, 32 * nb, (bf16*)(p.ws + WS_WD1), DFF, 32 * nb, 64 * kb, nullptr}; }
        it -= N_D;
        if (it < 16 * 64) { const int kb = it / 64, nb = it % 64; return TItem{p.win, DINP, 32 * nb, WIN, DM, 32 * nb, 64 * kb, p.nmix}; }
        if (it < N_IN) { const int r = it - 16 * 64, kb = r / 16, nb = r % 16; return TItem{p.win, DINP, 2056 + 32 * nb, WIN, DM, 2048 + 32 * nb, 64 * kb, p.nmix}; }
        it -= N_IN;
        { const int kb = it / 32, nb = it % 32; return TItem{p.wout, DM, 32 * nb, WOUT, DM, 32 * nb, 64 * kb, nullptr}; } };
    int it0 = gw;
    if (it0 + 2 * NGW < N_T) { titem_triple(mkt(it0), mkt(it0 + NGW), mkt(it0 + 2 * NGW), scr, lane); it0 += 3 * NGW; }
    else if (it0 + NGW < N_T) { titem_pair(mkt(it0), mkt(it0 + NGW), scr, lane); it0 += 2 * NGW; }
    for (; it0 < N_T + N_F + N_G; it0 += NGW) {
        int it = it0;
        if (it < N_T) { const TItem t = mkt(it); p0_item(t.W, t.ldw, t.src_col0, t.WT, t.K, t.dst_row0, t.k0, t.gk, scr, lane); continue; }
        it -= N_T;
        if (it < N_F) {
            const int wi = it, nblk = wi & 15, cgp = (wi >> 4) & 15, g = wi >> 8, n = nblk * 64 + lane, c0 = cgp * 8;
            float a[8];
#pragma unroll
            for (int e = 0; e < 8; ++e) a[e] = 0.f;
            const float* pw = p.poolw + (size_t)(g * 128 + c0) * 128; const float* ps = p.pools + g * 128; const float* wo = p.wout + (size_t)(512 + g * 128) * DM + n;
            for (int d0 = 0; d0 < 128; d0 += 32) {
                float wv[32];
#pragma unroll
                for (int dd = 0; dd < 32; ++dd) wv[dd] = wo[(size_t)(d0 + dd) * DM];
#pragma unroll
                for (int dd = 0; dd < 32; ++dd) { const float w = wv[dd] * ps[d0 + dd];
#pragma unroll
                    for (int e = 0; e < 8; ++e) a[e] += pw[e * 128 + d0 + dd] * w; }
            }
            u32x4 o; o.x = pk2(a[0], a[1]); o.y = pk2(a[2], a[3]); o.z = pk2(a[4], a[5]); o.w = pk2(a[6], a[7]);
            *(u32x4*)(WOUT + (size_t)n * DM + 512 + g * 128 + c0) = o;
            continue;
        }
        it -= N_F;
        {
            const int idx = it * 64 + lane, rr = idx >> 7, kc = (idx & 127) * 8;
            u32x4 o = (u32x4){0u, 0u, 0u, 0u};
            if (rr < 8) {
                float v[8];
#pragma unroll
                for (int e = 0; e < 8; ++e) v[e] = p.win[(size_t)(kc + e) * DINP + 2048 + rr] * p.nmix[kc + e];
                o.x = pk2(v[0], v[1]); o.y = pk2(v[2], v[3]); o.z = pk2(v[4], v[5]); o.w = pk2(v[6], v[7]);
            }
            *(u32x4*)(WIN + (size_t)(2560 + rr) * DM + kc) = o;
        }
    }
}
__device__ __forceinline__ void p0_prologue(const Params& p, LAS unsigned char* lds, int G) {
    const int tid = threadIdx.x, lane = tid & 63, wave = __builtin_amdgcn_readfirstlane(tid >> 6);
    LAS float* scr = (LAS float*)(lds + wave * 8448);
    const int gw = blockIdx.x * 8 + wave, NGW = G * 8;
    cvt_gu(p, 0, scr, lane, gw, NGW);
    bf16* XB = (bf16*)(p.ws + WS_XB); float* SS0 = (float*)(p.ws + WS_SS0);
    for (int m0 = gw * 4; m0 < S; m0 += NGW * 4) {
        f32x4 v[4][4];
#pragma unroll
        for (int rr = 0; rr < 4; ++rr) { const f32x4* xr = (const f32x4*)(p.x + (size_t)(m0 + rr) * DM) + lane;
#pragma unroll
            for (int j = 0; j < 4; ++j) v[rr][j] = __builtin_nontemporal_load(xr + 64 * j); }
#pragma unroll
        for (int rr = 0; rr < 4; ++rr) {
            float s = 0.f;
#pragma unroll
            for (int j = 0; j < 4; ++j) s += (v[rr][j][0] * v[rr][j][0] + v[rr][j][1] * v[rr][j][1]) + (v[rr][j][2] * v[rr][j][2] + v[rr][j][3] * v[rr][j][3]);
            s = wave_sum(s);
            u32x2* o8 = (u32x2*)(XB + (size_t)(m0 + rr) * DM) + lane;
#pragma unroll
            for (int j = 0; j < 4; ++j) { u32x2 w; w.x = pk2(v[rr][j][0], v[rr][j][1]); w.y = pk2(v[rr][j][2], v[rr][j][3]); o8[64 * j] = w; }
            if (lane < 16) SS0[(size_t)(m0 + rr) * 16 + lane] = lane == 0 ? s : 0.f;
        }
    }
}
__device__ __forceinline__ bool slack_rank(int nwg, int G, int& gw, int& NGW) {
    const int imax = (nwg - 1) / G, cb = nwg - imax * G;
    if ((int)blockIdx.x < cb || cb >= G) return false;
    gw = ((int)blockIdx.x - cb) * 8 + (int)__builtin_amdgcn_readfirstlane(threadIdx.x >> 6); NGW = (G - cb) * 8; return true;
}

constexpr int L_QS = 0, L_KS = 17408, L_VT = 34816, L_CT = 53248, L_PS = 88064, L_OS = 97280, L_SM = 114688;
constexpr int QP = 136, TP = 72;

__device__ __forceinline__ int tsw(int row, int col) { return row * TP + (col ^ (((row >> 3) & 7) << 3)); }
__device__ __forceinline__ void unpack8(const u32x4 v, float (&f)[8]) {
    f[0] = __uint_as_float(v.x << 16); f[1] = __uint_as_float(v.x & 0xffff0000u); f[2] = __uint_as_float(v.y << 16); f[3] = __uint_as_float(v.y & 0xffff0000u);
    f[4] = __uint_as_float(v.z << 16); f[5] = __uint_as_float(v.z & 0xffff0000u); f[6] = __uint_as_float(v.w << 16); f[7] = __uint_as_float(v.w & 0xffff0000u);
}
__device__ __forceinline__ void conv8(const bf16* proj, int t, int ch, const float* cw, const float* cb, float sc, float (&o)[8]) {
    { const f32x4 b0 = *(const f32x4*)(cb + ch), b1 = *(const f32x4*)(cb + ch + 4);
      o[0] = b0[0]; o[1] = b0[1]; o[2] = b0[2]; o[3] = b0[3]; o[4] = b1[0]; o[5] = b1[1]; o[6] = b1[2]; o[7] = b1[3]; }
#pragma unroll
    for (int w = 0; w < 4; ++w) {
        const int tr = t - 3 + w;
        if (tr >= 0) {
            const u32x4 raw = *(const u32x4*)(proj + (size_t)tr * NPROJ + ch); float xv[8]; unpack8(raw, xv);
            const f32x4 w0 = *(const f32x4*)(cw + w * 1024 + ch), w1 = *(const f32x4*)(cw + w * 1024 + ch + 4);
            o[0] += w0[0] * xv[0]; o[1] += w0[1] * xv[1]; o[2] += w0[2] * xv[2]; o[3] += w0[3] * xv[3];
            o[4] += w1[0] * xv[4]; o[5] += w1[1] * xv[5]; o[6] += w1[2] * xv[6]; o[7] += w1[3] * xv[7];
        }
    }
#pragma unroll
    for (int e = 0; e < 8; ++e) o[e] = o[e] * sc * __builtin_amdgcn_rcpf(1.0f + __expf(-o[e]));
}
__device__ __forceinline__ void conv4x8(const bf16* proj, int t, int ch, const float* cw, const float* cb, float sc, float (&o)[4][8]) {
    u32x4 raw[7];
#pragma unroll
    for (int i = 0; i < 7; ++i) { const int tr = t - 3 + i; raw[i] = tr >= 0 ? *(const u32x4*)(proj + (size_t)tr * NPROJ + ch) : (u32x4){0u, 0u, 0u, 0u}; }
    { const f32x4 b0 = *(const f32x4*)(cb + ch), b1 = *(const f32x4*)(cb + ch + 4);
#pragma unroll
      for (int j = 0; j < 4; ++j) { o[j][0] = b0[0]; o[j][1] = b0[1]; o[j][2] = b0[2]; o[j][3] = b0[3]; o[j][4] = b1[0]; o[j][5] = b1[1]; o[j][6] = b1[2]; o[j][7] = b1[3]; } }
#pragma unroll
    for (int w = 0; w < 4; ++w) {
        const f32x4 w0 = *(const f32x4*)(cw + w * 1024 + ch), w1 = *(const f32x4*)(cw + w * 1024 + ch + 4);
        const float wv[8] = {w0[0], w0[1], w0[2], w0[3], w1[0], w1[1], w1[2], w1[3]};
#pragma unroll
        for (int j = 0; j < 4; ++j) { float xv[8]; unpack8(raw[j + w], xv);
#pragma unroll
            for (int e = 0; e < 8; ++e) o[j][e] += wv[e] * xv[e]; }
    }
#pragma unroll
    for (int j = 0; j < 4; ++j)
#pragma unroll
        for (int e = 0; e < 8; ++e) o[j][e] = o[j][e] * sc * __builtin_amdgcn_rcpf(1.0f + __expf(-o[j][e]));
}
__device__ __forceinline__ u32x4 pack8(const float (&v)[8]) { u32x4 o; o.x = pk2(v[0], v[1]); o.y = pk2(v[2], v[3]); o.z = pk2(v[4], v[5]); o.w = pk2(v[6], v[7]); return o; }

__device__ __forceinline__ void m1_phase(const Params& p, unsigned char* ldsg, int G) {
    const int tid = threadIdx.x, lane = tid & 63, wave = __builtin_amdgcn_readfirstlane(tid >> 6), fr = lane & 15, fq = lane >> 4;
    const int half = wave >> 2, hw = wave & 3, htid = tid & 255;
    unsigned char* ws = p.ws;
    const bf16* PROJ = (const bf16*)(ws + WS_HB); const float* GATES = (const float*)(ws + WS_GATES);
    bf16* DCB = (bf16*)p.out; bf16* QKC = (bf16*)((unsigned char*)p.out + 32 * MiB); float* DN = (float*)(ws + WS_DN); float* GARR = (float*)(ws + WS_SC); float* AMAXARR = GARR + 1024;
    bf16* KT = (bf16*)(ldsg + half * 40960); bf16* VT = KT + 128 * TP; float* sW = (float*)(ldsg + half * 40960 + 36864);
    for (int r = blockIdx.x; r < NCH * NH / 2; r += G) {
        const int c = r >> 1, h = 2 * (r & 1) + half, u = c * 4 + h, t0 = c * CL;
        if (hw == 0) {
            const float ig = GATES[(size_t)(t0 + lane) * 8 + h], fp = GATES[(size_t)(t0 + lane) * 8 + 4 + h];
            const float b = wave_incl_sum(log_sigmoid_f(fp), lane);
            const float g = __shfl(b, 63);
            const float a = g - b + ig;
            const float amax = wave_max(a);
            sW[lane] = expf(a - amax);
            if (lane == 0) { GARR[h * NCH + c] = g; AMAXARR[h * NCH + c] = amax; }
        }
        const int rg = htid >> 4, cgp = htid & 15, l0 = 4 * rg;
        float kk[4][8];
        {
            float qv[4][8];
            conv4x8(PROJ, t0 + l0, h * HD + cgp * 8, p.convw, p.convb, 1.0f, qv);
#pragma unroll
            for (int j = 0; j < 4; ++j) *(u32x4*)(QKC + (size_t)(t0 + l0 + j) * DM + h * HD + cgp * 8) = pack8(qv[j]);
        }
        asm volatile("" ::: "memory");
        conv4x8(PROJ, t0 + l0, 512 + h * HD + cgp * 8, p.convw, p.convb, 0.08838834764831845f, kk);
#pragma unroll
        for (int j = 0; j < 4; ++j) *(u32x4*)(QKC + (size_t)(t0 + l0 + j) * DM + 512 + h * HD + cgp * 8) = pack8(kk[j]);
        {
            u32x4 rv[4];
#pragma unroll
            for (int j = 0; j < 4; ++j) rv[j] = *(const u32x4*)(PROJ + (size_t)(t0 + l0 + j) * NPROJ + 1024 + h * HD + cgp * 8);
#pragma unroll
            for (int e = 0; e < 8; ++e) {
                const unsigned sh = (e & 1) * 16;
                u32x2 o; o.x = ((rv[0][e >> 1] >> sh) & 0xffffu) | (((rv[1][e >> 1] >> sh) & 0xffffu) << 16); o.y = ((rv[2][e >> 1] >> sh) & 0xffffu) | (((rv[3][e >> 1] >> sh) & 0xffffu) << 16);
                *(u32x2*)(VT + tsw(cgp * 8 + e, l0)) = o;
            }
        }
        __syncthreads();
        {
            const f32x4 w4 = *(const f32x4*)(sW + l0);
#pragma unroll
            for (int e = 0; e < 8; ++e) { u32x2 o; o.x = pk2(kk[0][e] * w4[0], kk[1][e] * w4[1]); o.y = pk2(kk[2][e] * w4[2], kk[3][e] * w4[3]); *(u32x2*)(KT + tsw(cgp * 8 + e, l0)) = o; }
        }
        __syncthreads();
        {
            bf16x8 av[2][2];
#pragma unroll
            for (int mi = 0; mi < 2; ++mi)
#pragma unroll
                for (int ks = 0; ks < 2; ++ks) av[mi][ks] = *(const bf16x8*)(VT + tsw(16 * (2 * hw + mi) + fr, ks * 32 + fq * 8));
#pragma unroll
            for (int nt = 0; nt < 8; ++nt) {
                bf16x8 bk[2];
#pragma unroll
                for (int ks = 0; ks < 2; ++ks) bk[ks] = *(const bf16x8*)(KT + tsw(16 * nt + fr, ks * 32 + fq * 8));
#pragma unroll
                for (int mi = 0; mi < 2; ++mi) {
                    f32x4 acc = (f32x4){0.f, 0.f, 0.f, 0.f};
#pragma unroll
                    for (int ks = 0; ks < 2; ++ks) acc = __builtin_amdgcn_mfma_f32_16x16x32_bf16(bk[ks], av[mi][ks], acc, 0, 0, 0);
                    u32x2 o; o.x = pk2(acc[0], acc[1]); o.y = pk2(acc[2], acc[3]);
                    { const int vd = 16 * (2 * hw + mi) + fr; *(u32x2*)(DCB + ((size_t)((h * 64 + (vd >> 1)) * NCH + c) << 8) + (vd & 1) * 128 + 16 * nt + fq * 4) = o; }
                }
            }
            if (htid < 128) { float s = 0.f;
#pragma unroll 8
                for (int l = 0; l < 64; ++l) s += bf2f(KT[htid * TP + l]);
                DN[(size_t)(h * NCH + c) * 128 + htid] = s; }
        }
        __syncthreads();
    }
    bf16* MIX = (bf16*)(ws + WS_MIX);
    for (int rb = blockIdx.x; rb < S / 64; rb += G) {
        const int cg8 = tid & 63, rg = tid >> 6, ch0 = cg8 * 8, gi = ch0 >> 7, win = 2 << gi, tq = rb * 64 + rg * 8;
        const bf16* up = PROJ + 2048 + ch0;
        u32x4 slot[23];
#pragma unroll
        for (int s = 0; s < 23; ++s) { const int row = tq - 15 + s; slot[s] = (s + win >= 16 && row >= 0) ? *(const u32x4*)(up + (size_t)row * NPROJ) : (u32x4){0u, 0u, 0u, 0u}; }
        float sum[8];
#pragma unroll
        for (int e = 0; e < 8; ++e) sum[e] = 0.f;
#pragma unroll
        for (int s = 0; s < 15; ++s) { float xv[8]; unpack8(slot[s], xv); const bool in = (s + win > 15);
#pragma unroll
            for (int e = 0; e < 8; ++e) sum[e] += in ? xv[e] : 0.f; }
#pragma unroll
        for (int i = 0; i < 8; ++i) {
            float ut[8]; unpack8(slot[15 + i], ut);
#pragma unroll
            for (int e = 0; e < 8; ++e) sum[e] += ut[e];
            const int t = tq + i; const float inv = 1.0f / (float)((t + 1) < win ? (t + 1) : win);
            float o[8];
#pragma unroll
            for (int e = 0; e < 8; ++e) o[e] = sum[e] * inv - ut[e];
            *(u32x4*)(MIX + (size_t)t * DM + 512 + ch0) = pack8(o);
            if (i < 7) {
                u32x4 d;
#pragma unroll
                for (int q = 0; q < 4; ++q) d[q] = gi == 0 ? slot[14 + i][q] : gi == 1 ? slot[12 + i][q] : gi == 2 ? slot[8 + i][q] : slot[i][q];
                float dv[8]; unpack8(d, dv);
#pragma unroll
                for (int e = 0; e < 8; ++e) sum[e] -= dv[e];
            }
        }
    }
}

__device__ __forceinline__ void m2_phase(const Params& p, unsigned char* ldsg, int G) {
    const int tid = threadIdx.x, lane = tid & 63, wave = __builtin_amdgcn_readfirstlane(tid >> 6);
    unsigned char* ws = p.ws;
    bf16* DCB = (bf16*)p.out; float* DN = (float*)(ws + WS_DN); const float* GARR = (const float*)(ws + WS_SC); const float* AMAXARR = GARR + 1024; float* MPREV = (float*)(ws + WS_SC) + 2048;
    float* sA = (float*)ldsg; float* sB = sA + 256; float* sAseg = sA + 512; float* sTot = sA + 1024;
    for (int it = blockIdx.x; it < 256; it += G) {
        const int h = it >> 6, slice = it & 63, c0 = 32 * wave;
        u32x2 x[32];
        char* ub = (char*)DCB + (((size_t)((h * 64 + slice) * NCH + c0) << 8) * 2);
        const unsigned loff = (unsigned)lane * 8u;
#pragma unroll
        for (int i = 0; i < 32; ++i) x[i] = *(const u32x2*)(ub + (size_t)i * 512 + loff);
        if (wave == 0) {
            const f32x4 g4 = *(const f32x4*)(GARR + h * NCH + 4 * lane), a4 = *(const f32x4*)(AMAXARR + h * NCH + 4 * lane);
            const float tot = (g4[0] + g4[1]) + (g4[2] + g4[3]);
            const float inc = wave_incl_sum(tot, lane); const float pbase = inc - tot;
            float P[5]; P[0] = pbase; P[1] = P[0] + g4[0]; P[2] = P[1] + g4[1]; P[3] = P[2] + g4[2]; P[4] = P[3] + g4[3];
            float z[4];
#pragma unroll
            for (int i = 0; i < 4; ++i) z[i] = a4[i] - P[i + 1];
            const float zl = fmaxf(fmaxf(z[0], z[1]), fmaxf(z[2], z[3]));
            const float zi = wave_incl_max(zl, lane); float zprev = __shfl_up(zi, 1); if (lane == 0) zprev = 0.f; zprev = fmaxf(zprev, 0.f);
            float Z = zprev;
#pragma unroll
            for (int i = 0; i < 4; ++i) {
                const float m = P[i] + Z; const float Zn = fmaxf(Z, z[i]); const float mn = P[i + 1] + Zn;
                sA[4 * lane + i] = expf(g4[i] + m - mn); sB[4 * lane + i] = expf(a4[i] - mn);
                if (slice == 0) MPREV[h * NCH + 4 * lane + i] = m;
                Z = Zn;
            }
        }
        __syncthreads();
        {
            float l0 = 0.f, l1 = 0.f, l2 = 0.f, l3 = 0.f, ap = 1.f;
#pragma unroll
            for (int i = 0; i < 32; ++i) { const float a = sA[c0 + i], b = sB[c0 + i];
                l0 = a * l0 + b * __uint_as_float(x[i].x << 16); l1 = a * l1 + b * __uint_as_float(x[i].x & 0xffff0000u);
                l2 = a * l2 + b * __uint_as_float(x[i].y << 16); l3 = a * l3 + b * __uint_as_float(x[i].y & 0xffff0000u); ap *= a; }
            *(f32x4*)(sTot + wave * 256 + lane * 4) = (f32x4){l0, l1, l2, l3};
            if (lane == 0) sAseg[wave] = ap;
        }
        __syncthreads();
        {
            float l0 = 0.f, l1 = 0.f, l2 = 0.f, l3 = 0.f;
            for (int j = 0; j < wave; ++j) { const float a = sAseg[j]; const f32x4 tv = *(const f32x4*)(sTot + j * 256 + lane * 4);
                l0 = a * l0 + tv[0]; l1 = a * l1 + tv[1]; l2 = a * l2 + tv[2]; l3 = a * l3 + tv[3]; }
#pragma unroll
            for (int i = 0; i < 32; ++i) { const float a = sA[c0 + i], b = sB[c0 + i];
                u32x2 o; o.x = pk2(l0, l1); o.y = pk2(l2, l3); *(u32x2*)(ub + (size_t)i * 512 + loff) = o;
                l0 = a * l0 + b * __uint_as_float(x[i].x << 16); l1 = a * l1 + b * __uint_as_float(x[i].x & 0xffff0000u);
                l2 = a * l2 + b * __uint_as_float(x[i].y << 16); l3 = a * l3 + b * __uint_as_float(x[i].y & 0xffff0000u); }
        }
        if (slice == 0) {
            __syncthreads();
            typedef float f32x2 __attribute__((ext_vector_type(2)));
            char* nb = (char*)DN + ((size_t)(h * NCH + c0) * 128) * 4;
            f32x2 y[32];
#pragma unroll
            for (int i = 0; i < 32; ++i) y[i] = *(const f32x2*)(nb + (size_t)i * 512 + loff);
            f32x2 l = (f32x2){0.f, 0.f};
#pragma unroll
            for (int i = 0; i < 32; ++i) l = l * sA[c0 + i] + y[i] * sB[c0 + i];
            *(f32x2*)(sTot + wave * 256 + lane * 2) = l;
            __syncthreads();
            l = (f32x2){0.f, 0.f};
            for (int j = 0; j < wave; ++j) l = l * sAseg[j] + *(const f32x2*)(sTot + j * 256 + lane * 2);
#pragma unroll
            for (int i = 0; i < 32; ++i) { *(f32x2*)(nb + (size_t)i * 512 + loff) = l; l = l * sA[c0 + i] + y[i] * sB[c0 + i]; }
        }
        __syncthreads();
    }
}

__device__ __forceinline__ void m3_phase(const Params& p, unsigned char* ldsg, int G) {
    const int tid = threadIdx.x, lane = tid & 63, wave = __builtin_amdgcn_readfirstlane(tid >> 6), fr = lane & 15, fq = lane >> 4;
    unsigned char* ws = p.ws;
    const bf16* PROJ = (const bf16*)(ws + WS_HB); const float* GATES = (const float*)(ws + WS_GATES); const bf16* QKC = (const bf16*)((const unsigned char*)p.out + 32 * MiB);
    const bf16* CPB = (const bf16*)p.out; const float* DN = (const float*)(ws + WS_DN); const float* MPREV = (const float*)(ws + WS_SC) + 2048;
    bf16* MIX = (bf16*)(ws + WS_MIX);
    bf16* Qs = (bf16*)(ldsg + L_QS); bf16* Ks = (bf16*)(ldsg + L_KS); bf16* VT = (bf16*)(ldsg + L_VT); bf16* CTs = (bf16*)(ldsg + L_CT); bf16* Ps = (bf16*)(ldsg + L_PS); bf16* Os = (bf16*)(ldsg + L_OS);
    float* sU = (float*)(ldsg + L_SM); float* sM = sU + 64; float* sIW = sU + 128; float* sEMT = sU + 192; float* sRS = sU + 256; float* sQN = sU + 320; float* sHS = sU + 384; float* sN = sU + 448;
#define LBAR() do { asm volatile("s_waitcnt lgkmcnt(0)" ::: "memory"); __builtin_amdgcn_s_barrier(); asm volatile("" ::: "memory"); } while (0)
    u32x4 gq[2], gk[2], gv[2], go[2], gc[4]; float g_ig = 0.f, g_fp = 0.f, g_mp = 0.f, g_n0 = 0.f, g_n1 = 0.f;
#define M3_ISSUE(uu) do { const int c_ = (uu) >> 2, h_ = (uu) & 3, t0_ = c_ * CL, r_ = tid >> 4, cgp_ = tid & 15; \
        _Pragma("unroll") for (int pass = 0; pass < 2; ++pass) { const size_t t = t0_ + r_ + 32 * pass; \
            gq[pass] = *(const u32x4*)(QKC + t * DM + h_ * HD + cgp_ * 8); gk[pass] = *(const u32x4*)(QKC + t * DM + 512 + h_ * HD + cgp_ * 8); \
            gv[pass] = *(const u32x4*)(PROJ + t * NPROJ + 1024 + h_ * HD + cgp_ * 8); go[pass] = *(const u32x4*)(PROJ + t * NPROJ + 1536 + h_ * HD + cgp_ * 8); } \
        _Pragma("unroll") for (int i = 0; i < 4; ++i) { const int idx = tid + 512 * i; gc[i] = *(const u32x4*)(CPB + ((size_t)((h_ * 64 + (idx >> 5)) * NCH + c_) << 8) + (idx & 31) * 8); } \
        g_ig = GATES[(size_t)(t0_ + lane) * 8 + h_]; g_fp = GATES[(size_t)(t0_ + lane) * 8 + 4 + h_]; g_mp = MPREV[h_ * NCH + c_]; \
        g_n0 = DN[(size_t)(h_ * NCH + c_) * 128 + lane]; g_n1 = DN[(size_t)(h_ * NCH + c_) * 128 + 64 + lane]; } while (0)
    if ((int)blockIdx.x < NCH * NH) M3_ISSUE((int)blockIdx.x);
    for (int u = blockIdx.x; u < NCH * NH; u += G) {
        const int c = u >> 2, h = u & 3, t0 = c * CL;
        {
            const int r = tid >> 4, cgp = tid & 15;
            if (wave == 0) {
                const float b = wave_incl_sum(log_sigmoid_f(g_fp), lane);
                const float uu = g_ig - b;
                const float U = wave_incl_max(uu, lane);
                const float mp = g_mp;
                const float M = fmaxf(mp, U);
                sU[lane] = uu; sM[lane] = M; sIW[lane] = expf(mp - M); sEMT[lane] = expf(-(b + M)); sRS[lane] = 0.f; sHS[lane] = 0.f;
            } else if (wave == 1) {
                sN[lane] = g_n0; sN[lane + 64] = g_n1;
            }
#pragma unroll
            for (int pass = 0; pass < 2; ++pass) { const int l = r + 32 * pass;
                *(u32x4*)(Qs + l * QP + cgp * 8) = gq[pass]; *(u32x4*)(Ks + l * QP + cgp * 8) = gk[pass]; *(u32x4*)(Os + l * QP + cgp * 8) = go[pass];
#pragma unroll
                for (int e = 0; e < 8; ++e) VT[tsw(cgp * 8 + e, l)] = (bf16)(gv[pass][e >> 1] >> ((e & 1) * 16)); }
#pragma unroll
            for (int i = 0; i < 4; ++i) { const int idx = tid + 512 * i, vd = idx >> 4, kc = (idx & 15) * 8; *(u32x4*)(CTs + vd * QP + kc) = gc[i]; }
            { const int un = (u + G < NCH * NH) ? u + G : u; M3_ISSUE(un); }
        }
        LBAR();
        {
            const int l = tid >> 3, part = tid & 7; float s = 0.f;
            float qa[8], qb[8]; unpack8(*(const u32x4*)(Qs + l * QP + part * 16), qa); unpack8(*(const u32x4*)(Qs + l * QP + part * 16 + 8), qb);
            const f32x4 n0 = *(const f32x4*)(sN + part * 16), n1 = *(const f32x4*)(sN + part * 16 + 4), n2 = *(const f32x4*)(sN + part * 16 + 8), n3 = *(const f32x4*)(sN + part * 16 + 12);
            s = ((qa[0] * n0[0] + qa[1] * n0[1]) + (qa[2] * n0[2] + qa[3] * n0[3])) + ((qa[4] * n1[0] + qa[5] * n1[1]) + (qa[6] * n1[2] + qa[7] * n1[3]))
              + ((qb[0] * n2[0] + qb[1] * n2[1]) + (qb[2] * n2[2] + qb[3] * n2[3])) + ((qb[4] * n3[0] + qb[5] * n3[1]) + (qb[6] * n3[2] + qb[7] * n3[3]));
            s += __shfl_xor(s, 1); s += __shfl_xor(s, 2); s += __shfl_xor(s, 4);
            if (part == 0) sQN[l] = s;
        }
        const int lt = wave >> 1;
        {
            bf16x8 aq[4];
#pragma unroll
            for (int ks = 0; ks < 4; ++ks) aq[ks] = *(const bf16x8*)(Qs + (16 * lt + fr) * QP + ks * 32 + fq * 8);
            float rs[4] = {0.f, 0.f, 0.f, 0.f};
#pragma unroll
            for (int si = 0; si < 2; ++si) {
                const int st = 2 * (wave & 1) + si;
                f32x4 acc = (f32x4){0.f, 0.f, 0.f, 0.f};
#pragma unroll
                for (int ks = 0; ks < 4; ++ks) { const bf16x8 b = *(const bf16x8*)(Ks + (16 * st + fr) * QP + ks * 32 + fq * 8); acc = __builtin_amdgcn_mfma_f32_16x16x32_bf16(aq[ks], b, acc, 0, 0, 0); }
                const int s = 16 * st + fr; const float us = sU[s];
#pragma unroll
                for (int j = 0; j < 4; ++j) { const int l = 16 * lt + fq * 4 + j; const float val = (s <= l) ? acc[j] * __expf(us - sM[l]) : 0.f; Ps[l * TP + s] = (bf16)f2bf(val); rs[j] += val; }
            }
#pragma unroll
            for (int j = 0; j < 4; ++j) { float v = rs[j]; v += __shfl_xor(v, 1); v += __shfl_xor(v, 2); v += __shfl_xor(v, 4); v += __shfl_xor(v, 8); if (fr == 0) atomicAdd(&sRS[16 * lt + fq * 4 + j], v); }
        }
        LBAR();
        {
            f32x4 a1[4], a2[4];
#pragma unroll
            for (int n = 0; n < 4; ++n) { a1[n] = (f32x4){0.f, 0.f, 0.f, 0.f}; a2[n] = (f32x4){0.f, 0.f, 0.f, 0.f}; }
#pragma unroll
            for (int ks = 0; ks < 2; ++ks) { const bf16x8 a = *(const bf16x8*)(Ps + (16 * lt + fr) * TP + ks * 32 + fq * 8);
#pragma unroll
                for (int n = 0; n < 4; ++n) { const int nt = 4 * (wave & 1) + n; const bf16x8 b = *(const bf16x8*)(VT + tsw(16 * nt + fr, ks * 32 + fq * 8)); a1[n] = __builtin_amdgcn_mfma_f32_16x16x32_bf16(a, b, a1[n], 0, 0, 0); } }
#pragma unroll
            for (int ks = 0; ks < 4; ++ks) { const bf16x8 a = *(const bf16x8*)(Qs + (16 * lt + fr) * QP + ks * 32 + fq * 8);
#pragma unroll
                for (int n = 0; n < 4; ++n) { const int nt = 4 * (wave & 1) + n; const bf16x8 b = *(const bf16x8*)(CTs + (16 * nt + fr) * QP + ks * 32 + fq * 8); a2[n] = __builtin_amdgcn_mfma_f32_16x16x32_bf16(a, b, a2[n], 0, 0, 0); } }
#pragma unroll
            for (int j = 0; j < 4; ++j) {
                const int l = 16 * lt + fq * 4 + j; const float iw = sIW[l]; const float qn = sRS[l] + iw * sQN[l];
                const float den = fmaxf(fabsf(qn), sEMT[l]); const float inv = __builtin_amdgcn_rcpf(den); float hs = 0.f;
#pragma unroll
                for (int n = 0; n < 4; ++n) { const float v = (a1[n][j] + iw * a2[n][j]) * inv; hs += v * v; Ks[l * QP + 16 * (4 * (wave & 1) + n) + fr] = (bf16)f2bf(v); }
                hs += __shfl_xor(hs, 1); hs += __shfl_xor(hs, 2); hs += __shfl_xor(hs, 4); hs += __shfl_xor(hs, 8);
                if (fr == 0) atomicAdd(&sHS[l], hs);
            }
        }
        LBAR();
        {
            const int r = tid >> 4, cgp = tid & 15;
            const f32x4 n0 = *(const f32x4*)(p.mhn + h * HD + cgp * 8), n1 = *(const f32x4*)(p.mhn + h * HD + cgp * 8 + 4);
            const float nn[8] = {n0[0], n0[1], n0[2], n0[3], n1[0], n1[1], n1[2], n1[3]};
#pragma unroll
            for (int pass = 0; pass < 2; ++pass) { const int l = r + 32 * pass; const float rinv = __builtin_amdgcn_rsqf(sHS[l] * (1.0f / 128.0f) + EPS);
                float hv[8], ov[8], o[8]; unpack8(*(const u32x4*)(Ks + l * QP + cgp * 8), hv); unpack8(*(const u32x4*)(Os + l * QP + cgp * 8), ov);
#pragma unroll
                for (int e = 0; e < 8; ++e) o[e] = hv[e] * rinv * nn[e] * __builtin_amdgcn_rcpf(1.0f + __expf(-ov[e]));
                *(u32x4*)(MIX + (size_t)(t0 + l) * DM + h * HD + cgp * 8) = pack8(o); }
        }
        LBAR();
    }
}
#undef M3_ISSUE
#undef LBAR

#define XB_TMO      128
#define XB_XCNT(j)  (256  + 64 * (j))
#define XB_XSUB(j)  (1280 + 64 * (j))
#define XB_XGEN(j)  (2304 + 64 * (j))
#define XB_TOP      3328
#define XB_TOPGEN   3392
#define XCD_BAR_WORDS 3456
#define XB_SPIN_CAP (1u << 18)
__device__ __forceinline__ unsigned xb_ld(unsigned* p)              { return __hip_atomic_load(p, __ATOMIC_RELAXED, __HIP_MEMORY_SCOPE_AGENT); }
__device__ __forceinline__ unsigned xb_add(unsigned* p, unsigned v) { return __hip_atomic_fetch_add(p, v, __ATOMIC_RELAXED, __HIP_MEMORY_SCOPE_AGENT); }
__device__ __forceinline__ unsigned xb_xcc_id() { return (unsigned)__builtin_amdgcn_s_getreg((3 << 11) | 20) & 0xFu; }
#define XB_SPIN(cond, bar) do { unsigned _sp = 0; while (cond) { __builtin_amdgcn_s_sleep(1); \
    if ((++_sp & 255u) == 0u) { if (xb_ld(&(bar)[XB_TMO])) break; if (_sp > XB_SPIN_CAP) { atomicAdd(&(bar)[XB_TMO], 1u); break; } } } } while (0)
struct XcdBarrier { unsigned* bar; unsigned x; volatile LAS unsigned* st; };
__device__ __forceinline__ XcdBarrier xcd_barrier_post(unsigned* bar, volatile LAS unsigned* st) {
    XcdBarrier b; b.bar = bar; b.x = xb_xcc_id(); b.st = st;
    if (threadIdx.x == 0) (void)xb_add(&bar[XB_XCNT(b.x)], 1u);
    return b;
}
__device__ __forceinline__ void xcd_barrier_complete(unsigned* bar, unsigned x, unsigned& nloc, unsigned& nx) {
    const unsigned G = gridDim.x * gridDim.y * gridDim.z;
    unsigned sum, cnt, mine, sp = 0u;
    for (;;) {
        sum = 0u; cnt = 0u; mine = 0u;
#pragma unroll
        for (unsigned j = 0; j < 16; ++j) { const unsigned c = xb_ld(&bar[XB_XCNT(j)]); sum += c; cnt += (c > 0u) ? 1u : 0u; mine = (j == x) ? c : mine; }
        if (sum == G) break;
        __builtin_amdgcn_s_sleep(1);
        if ((++sp & 255u) == 0u) { if (xb_ld(&bar[XB_TMO])) break; if (sp > XB_SPIN_CAP) { atomicAdd(&bar[XB_TMO], 1u); break; } }
    }
    nloc = mine > 0u ? mine : 1u; nx = cnt > 0u ? cnt : 1u;
}
__device__ __forceinline__ void xcd_barrier(const XcdBarrier& b) {
    asm volatile("s_waitcnt vmcnt(0)" ::: "memory");
    __syncthreads();
    if (threadIdx.x == 0) {
        unsigned* bar = b.bar;
        __builtin_amdgcn_s_waitcnt(0);
        unsigned nloc = b.st[0], nx = b.st[1];
        if (nloc == 0u) { xcd_barrier_complete(bar, b.x, nloc, nx); b.st[0] = nloc; b.st[1] = nx; }
        const unsigned old = xb_add(&bar[XB_XSUB(b.x)], 1u);
        const unsigned gen = old / nloc;
        if (old + 1u == (gen + 1u) * nloc) {
            __builtin_amdgcn_fence(__ATOMIC_RELEASE, "agent");
            asm volatile("s_waitcnt vmcnt(0)" ::: "memory");
            const unsigned og = xb_add(&bar[XB_TOP], 1u);
            const unsigned tg = og / nx;
            if (og + 1u == (tg + 1u) * nx) xb_add(&bar[XB_TOPGEN], 1u);
            else XB_SPIN(xb_ld(&bar[XB_TOPGEN]) == tg, bar);
            __builtin_amdgcn_fence(__ATOMIC_ACQUIRE, "agent");
            xb_add(&bar[XB_XGEN(b.x)], 1u);
            asm volatile("s_waitcnt vmcnt(0)" ::: "memory");
        } else {
            XB_SPIN(xb_ld(&bar[XB_XGEN(b.x)]) == gen, bar);
            __builtin_amdgcn_fence(__ATOMIC_ACQUIRE, "agent");
            asm volatile("s_waitcnt vmcnt(0)" ::: "memory");
        }
    }
    __syncthreads();
}

__device__ __forceinline__ int fill_rtab(const pg8::StaticOrder& so, const float* ss, LAS float* rtab) {
    pg8::Unit u0; int pm0 = -1;
    if (so.next(0, u0)) { pm0 = u0.pm; if (threadIdx.x < 256) rtab[threadIdx.x] = pg8::row_rstd(ss, pm0 * 256 + (int)threadIdx.x); }
    __syncthreads();
    return pm0;
}
__global__ void __launch_bounds__(512, 2) fwd_megakernel(Params p) {
    extern __shared__ __attribute__((aligned(16))) unsigned char lds[];
    cg::grid_group grid = cg::this_grid();
    LAS unsigned char* ldsl = (LAS unsigned char*)lds;
    const int G = gridDim.x;
    unsigned char* ws = p.ws;
    bf16* XB = (bf16*)(ws + WS_XB); bf16* HB = (bf16*)(ws + WS_HB); bf16* MIX = (bf16*)(ws + WS_MIX);
    float* SS0 = (float*)(ws + WS_SS0); float* SS1 = (float*)(ws + WS_SS1); float* SS2 = (float*)(ws + WS_SS2); float* SS3 = (float*)(ws + WS_SS3);

    unsigned* barw = (unsigned*)(ws + WS_BAR);
    LAS float* rtab = (LAS float*)(ldsl + LDS_RTAB);
    volatile LAS unsigned* bst = (volatile LAS unsigned*)(ldsl + 131072);
    if (threadIdx.x < 2) bst[threadIdx.x] = 0u;
    if (p.ws == nullptr) grid.sync();
    {
        unsigned* flag = barw + 16384 - 64;
        constexpr unsigned MAGIC = 0x600DF1A6u;
        if (blockIdx.x == 0) {
            for (int i = threadIdx.x; i < 16384 - 64; i += 512) barw[i] = 0u;
            __threadfence(); __syncthreads();
            if (threadIdx.x == 0) { asm volatile("s_waitcnt vmcnt(0)" ::: "memory"); __hip_atomic_store(flag, MAGIC, __ATOMIC_RELEASE, __HIP_MEMORY_SCOPE_AGENT); }
        } else if (threadIdx.x == 0) {
            unsigned sp = 0; while (__hip_atomic_load(flag, __ATOMIC_RELAXED, __HIP_MEMORY_SCOPE_AGENT) != MAGIC) { __builtin_amdgcn_s_sleep(1); if (++sp > (1u << 22)) break; }
            __builtin_amdgcn_fence(__ATOMIC_ACQUIRE, "agent");
        }
        __syncthreads();
    }
    const XcdBarrier xb = xcd_barrier_post(barw, bst);
#define GSYNC() xcd_barrier(xb)
    p0_prologue(p, ldsl, G);
    GSYNC();
    if (blockIdx.x == 0 && threadIdx.x == 0) __hip_atomic_store(barw + 16384 - 64, 0u, __ATOMIC_RELAXED, __HIP_MEMORY_SCOPE_AGENT);
    { pg8::Gemm g{XB, (const bf16*)(ws + WS_WGU1), S, 2 * DFF, DM}; pg8::StaticOrder so; so.init(S, 2 * DFF, G, (int)blockIdx.x);
      const int pm0 = fill_rtab(so, SS0, rtab); pg8::EpiSwiGLU E{HB, DFF, SS0, rtab, pm0}; pg8::gemm_phase<pg8::EpiSwiGLU, pg8::StaticOrder, true, true>(ldsl, g, so, E); }
    { int sgw, sng; if (slack_rank((S / 256) * (2 * DFF / 256), G, sgw, sng)) { LAS float* scr = (LAS float*)(ldsl + (threadIdx.x >> 6) * 8448); const int lane = threadIdx.x & 63;
        slack1_items(p, scr, lane, sgw, sng); } }
    GSYNC();
    { pg8::Gemm g{HB, (const bf16*)(ws + WS_WD1), S, DM, DFF}; pg8::StaticOrder so; so.init(S, DM, G, (int)blockIdx.x);
      pg8::EpiResid<true> E{nullptr, XB, SS1, 0.5f}; pg8::gemm_phase<pg8::EpiResid<true>, pg8::StaticOrder, true, true>(ldsl, g, so, E); }
    GSYNC();
    { pg8::Gemm g{XB, (const bf16*)(ws + WS_WIN), S, NPROJ, DM}; pg8::StaticOrder so; so.init(S, NPROJ, G, (int)blockIdx.x);
      const int pm0 = fill_rtab(so, SS1, rtab); pg8::EpiProj E{HB, NPROJ, SS1, (float*)(ws + WS_GATES), p.bg, 10, rtab, pm0}; pg8::gemm_phase<pg8::EpiProj, pg8::StaticOrder, true, true>(ldsl, g, so, E); }
    { int sgw, sng; if (slack_rank((S / 256) * (NPROJ / 256), G, sgw, sng)) { LAS float* scr = (LAS float*)(ldsl + (threadIdx.x >> 6) * 8448); cvt_gu(p, 1, scr, threadIdx.x & 63, sgw, sng); } }
    GSYNC();
    m1_phase(p, lds, G);
    GSYNC();
    m2_phase(p, lds, G);
    GSYNC();
    m3_phase(p, lds, G);
    GSYNC();
    { pg8::Gemm g{MIX, (const bf16*)(ws + WS_WOUT), S, DM, DM}; pg8::StaticOrder so; so.init(S, DM, G, (int)blockIdx.x);
      pg8::EpiResid<true> E{nullptr, XB, SS2, 1.0f}; pg8::gemm_phase<pg8::EpiResid<true>, pg8::StaticOrder, true, true>(ldsl, g, so, E); }
    GSYNC();
    { pg8::Gemm g{XB, (const bf16*)(ws + WS_WGU2), S, 2 * DFF, DM}; pg8::StaticOrder so; so.init(S, 2 * DFF, G, (int)blockIdx.x);
      const int pm0 = fill_rtab(so, SS2, rtab); pg8::EpiSwiGLU E{HB, DFF, SS2, rtab, pm0}; pg8::gemm_phase<pg8::EpiSwiGLU, pg8::StaticOrder, true, true>(ldsl, g, so, E); }
    { int sgw, sng; if (slack_rank((S / 256) * (2 * DFF / 256), G, sgw, sng)) cvt_down(p, 1, (LAS float*)(ldsl + (threadIdx.x >> 6) * 8448), threadIdx.x & 63, sgw, sng); }
    GSYNC();
    { pg8::Gemm g{HB, (const bf16*)(ws + WS_WD2), S, DM, DFF}; pg8::StaticOrder so; so.init(S, DM, G, (int)blockIdx.x);
      pg8::EpiFinal E{XB, p.out, SS3, (unsigned*)(ws + WS_PCNT), p.nf, 0.5f}; pg8::gemm_phase<pg8::EpiFinal, pg8::StaticOrder, true, true>(ldsl, g, so, E); }
}

extern "C" void kernel_launch(void* const* d_in, const int* in_sizes, int n_in, void* d_out, int out_size, void* d_ws, size_t ws_size, hipStream_t stream) {
    static int grid_blocks = 0;
    if (grid_blocks == 0) {
        if (n_in != 19 || out_size != S * DM || ws_size < WS_END) { fprintf(stderr, "kernel_launch: unexpected problem (n_in %d, out %d, ws %zu)\n", n_in, out_size, ws_size); grid_blocks = -1; return; }
        int dev = 0, cus = 0, per_cu = 0;
        (void)hipGetDevice(&dev);
        (void)hipDeviceGetAttribute(&cus, hipDeviceAttributeMultiprocessorCount, dev);
        if (hipFuncSetAttribute((const void*)fwd_megakernel, hipFuncAttributeMaxDynamicSharedMemorySize, LDS_BYTES) != hipSuccess) { fprintf(stderr, "kernel_launch: hipFuncSetAttribute failed\n"); grid_blocks = -1; return; }
        if (hipOccupancyMaxActiveBlocksPerMultiprocessor(&per_cu, (const void*)fwd_megakernel, 512, LDS_BYTES) != hipSuccess || per_cu < 1) { fprintf(stderr, "kernel_launch: occupancy query gave %d\n", per_cu); per_cu = 1; }
        (void)hipGetLastError();
        grid_blocks = cus * 1;
        if (grid_blocks <= 0) grid_blocks = 256;
    }
    if (grid_blocks < 0) return;
    Params p{};
    p.x = (const float*)d_in[0]; p.n1 = (const float*)d_in[1]; p.wg1 = (const float*)d_in[2]; p.wu1 = (const float*)d_in[3]; p.wd1 = (const float*)d_in[4];
    p.nmix = (const float*)d_in[5]; p.win = (const float*)d_in[6]; p.bg = (const float*)d_in[7]; p.convw = (const float*)d_in[8]; p.convb = (const float*)d_in[9]; p.mhn = (const float*)d_in[10];
    p.poolw = (const float*)d_in[11]; p.pools = (const float*)d_in[12]; p.wout = (const float*)d_in[13]; p.n2 = (const float*)d_in[14]; p.wg2 = (const float*)d_in[15]; p.wu2 = (const float*)d_in[16]; p.wd2 = (const float*)d_in[17]; p.nf = (const float*)d_in[18];
    p.out = (float*)d_out; p.ws = (unsigned char*)d_ws;
    void* args[] = {&p};
    hipError_t e = hipLaunchCooperativeKernel((const void*)fwd_megakernel, dim3(grid_blocks), dim3(512), args, LDS_BYTES, stream);
    if (e != hipSuccess) fprintf(stderr, "cooperative launch failed: %s (grid %d)\n", hipGetErrorString(e), grid_blocks);
}
```
